# Optimizing an MI355X kernel written in HIP

```python
import math
import jax, jax.numpy as jnp
from jax import lax
import numpy as np

D_MODEL = 1024
BATCH = 4
SEQ = 4096
DEPTH = 1

CHUNK = 64
RMS_EPS = 1e-6
RW_HEADS = 8
RW_HEAD_DIM = 64
RW_WIDTH = RW_HEADS * RW_HEAD_DIM
RW_DECAY_LORA = 64
RW_AAA_LORA = 64
RW_GATE_LORA = 128
RW_GN_EPS = 64e-5
ML_HEADS = 4
ML_HEAD_DIM = 128
ML_WIDTH = ML_HEADS * ML_HEAD_DIM
ML_CONV = 4
ML_NORM_EPS = 1e-5
N_BRANCH = 2
PEER_HEADS = 8
PEER_KEYS = 128
PEER_EXPERTS = PEER_KEYS * PEER_KEYS
PEER_QDIM = 256
PEER_HALF = PEER_QDIM // 2
PEER_TOPK = 16
PEER_TOKEN_BLOCK = 128
RW_COLS = 3 * RW_WIDTH + RW_DECAY_LORA + RW_AAA_LORA + RW_GATE_LORA
ML_COLS = 4 * ML_WIDTH + 2 * ML_HEADS
GATE_COLS = N_BRANCH * D_MODEL
IN_COLS = RW_COLS + ML_COLS + GATE_COLS

kernel_name = "hybrid_rwkv7_mlstm_peer_block"

F32 = jnp.float32


def _rmsnorm(x, g):
    xf = x.astype(F32)
    y = xf * lax.rsqrt(jnp.mean(xf * xf, axis=-1, keepdims=True) + RMS_EPS)
    return (y * g.astype(F32)).astype(x.dtype)


def _causal_conv(x, w, b):
    c = x.shape[-1]
    y = lax.conv_general_dilated(x, w[:, None, :], window_strides=(1,), padding=[(w.shape[0] - 1, 0)],
                                 dimension_numbers=('NWC', 'WIO', 'NWC'), feature_group_count=c)
    return y + b


def _rwkv7(z, mu, w0, w_up, a0, a_up, g_up, k_k, k_a, r_k, gn_w, gn_b):
    bsz, t_len, _ = z.shape
    z = z.astype(F32)
    z_prev = jnp.pad(z, ((0, 0), (1, 0), (0, 0)))[:, :-1]
    zs = z + (z_prev - z) * mu.astype(F32)
    o1 = RW_WIDTH; o2 = 2 * RW_WIDTH; o3 = 3 * RW_WIDTH
    o4 = o3 + RW_DECAY_LORA; o5 = o4 + RW_AAA_LORA
    r, k, v = zs[..., :o1], zs[..., o1:o2], zs[..., o2:o3]
    zw, za, zg = zs[..., o3:o4], zs[..., o4:o5], zs[..., o5:]
    w_log = -jax.nn.softplus(-(w0.astype(F32) + jnp.tanh(zw) @ w_up.astype(F32))) - 0.5
    decay = jnp.exp(-jnp.exp(w_log))
    a = jax.nn.sigmoid(a0.astype(F32) + za @ a_up.astype(F32))
    g = jax.nn.sigmoid(zg) @ g_up.astype(F32)
    hs = lambda t: t.reshape(bsz, t_len, RW_HEADS, RW_HEAD_DIM)
    r, k, v, decay, a = hs(r), hs(k), hs(v), hs(decay), hs(a)
    kk = k * k_k.astype(F32).reshape(RW_HEADS, RW_HEAD_DIM)
    kk = kk / jnp.maximum(jnp.sqrt(jnp.sum(kk * kk, axis=-1, keepdims=True)), 1e-12)
    k = k * (1.0 + (a - 1.0) * k_a.astype(F32).reshape(RW_HEADS, RW_HEAD_DIM))

    def step(S, inp):
        r_t, w_t, k_t, v_t, kk_t, b_t = inp
        sa = jnp.einsum('bhvk,bhk->bhv', S, -kk_t)
        S = S * w_t[:, :, None, :] + sa[..., None] * b_t[:, :, None, :] + v_t[..., None] * k_t[:, :, None, :]
        return S, jnp.einsum('bhvk,bhk->bhv', S, r_t)

    tm = lambda t: jnp.moveaxis(t, 1, 0)
    s0 = jnp.zeros((bsz, RW_HEADS, RW_HEAD_DIM, RW_HEAD_DIM), F32)
    _, y = lax.scan(step, s0, (tm(r), tm(decay), tm(k), tm(v), tm(kk), tm(kk * a)))
    y = jnp.moveaxis(y, 0, 1)
    mean = jnp.mean(y, axis=-1, keepdims=True)
    var = jnp.mean(jnp.square(y - mean), axis=-1, keepdims=True)
    y = (y - mean) * lax.rsqrt(var + RW_GN_EPS) * gn_w.astype(F32).reshape(RW_HEADS, RW_HEAD_DIM) \
        + gn_b.astype(F32).reshape(RW_HEADS, RW_HEAD_DIM)
    y = y + jnp.sum(r * k * r_k.astype(F32), axis=-1, keepdims=True) * v
    return y.reshape(bsz, t_len, RW_WIDTH) * g


def _mlstm(z, cq_w, cq_b, ck_w, ck_b, b_i, b_f, norm_w):
    bsz, t_len, _ = z.shape
    z = z.astype(F32)
    w1 = ML_WIDTH; w2 = 2 * ML_WIDTH; w3 = 3 * ML_WIDTH; w4 = 4 * ML_WIDTH
    q_pre, k_pre, v, o_pre = z[..., :w1], z[..., w1:w2], z[..., w2:w3], z[..., w3:w4]
    i_pre, f_pre = z[..., w4:w4 + ML_HEADS], z[..., w4 + ML_HEADS:]
    q = jax.nn.silu(_causal_conv(q_pre, cq_w.astype(F32), cq_b.astype(F32)))
    k = jax.nn.silu(_causal_conv(k_pre, ck_w.astype(F32), ck_b.astype(F32)))
    n_chunks = t_len // CHUNK
    chunked = lambda t: t.reshape(bsz, n_chunks, CHUNK, ML_HEADS, ML_HEAD_DIM).transpose(0, 3, 1, 2, 4)
    gate_c = lambda t: t.reshape(bsz, n_chunks, CHUNK, ML_HEADS).transpose(0, 3, 1, 2)
    q = chunked(q)
    k = chunked(k) * (ML_HEAD_DIM ** -0.5)
    v = chunked(v)
    ig = gate_c(i_pre + b_i.astype(F32))
    lf = jax.nn.log_sigmoid(gate_c(f_pre + b_f.astype(F32)))
    bcum = jnp.cumsum(lf, axis=-1)
    causal = jnp.tril(jnp.ones((CHUNK, CHUNK), dtype=bool))
    d_log = jnp.where(causal, bcum[..., :, None] - bcum[..., None, :] + ig[..., None, :], -jnp.inf)
    g_end = bcum[..., -1]
    a_s = g_end[..., None] - bcum + ig
    m_loc = jnp.max(a_s, axis=-1)
    wts = jnp.exp(a_s - m_loc[..., None])
    c_loc = jnp.einsum('bhcl,bhclv,bhclk->bhcvk', wts, v, k)
    n_loc = jnp.einsum('bhcl,bhclk->bhck', wts, k)

    def step(carry, inp):
        c_st, n_st, m_st = carry
        c_l, n_l, m_l, g_c = inp
        m_new = jnp.maximum(g_c + m_st, m_l)
        s_old = jnp.exp(g_c + m_st - m_new)
        s_new = jnp.exp(m_l - m_new)
        c_next = s_old[..., None, None] * c_st + s_new[..., None, None] * c_l
        n_next = s_old[..., None] * n_st + s_new[..., None] * n_l
        return (c_next, n_next, m_new), (c_st, n_st, m_st)

    init = (jnp.zeros((bsz, ML_HEADS, ML_HEAD_DIM, ML_HEAD_DIM), F32),
            jnp.zeros((bsz, ML_HEADS, ML_HEAD_DIM), F32),
            jnp.zeros((bsz, ML_HEADS), F32))
    mv = lambda t: jnp.moveaxis(t, 2, 0)
    _, (c_in, n_in, m_in) = lax.scan(step, init, (mv(c_loc), mv(n_loc), mv(m_loc), mv(g_end)))
    c_in = jnp.moveaxis(c_in, 0, 2)
    n_in = jnp.moveaxis(n_in, 0, 2)
    m_in = jnp.moveaxis(m_in, 0, 2)
    inter_log = bcum + m_in[..., None]
    m_t = jnp.maximum(jnp.max(d_log, axis=-1), inter_log)
    scores = jnp.einsum('bhcld,bhcsd->bhcls', q, k) * jnp.exp(d_log - m_t[..., None])
    inter_w = jnp.exp(inter_log - m_t)
    num = jnp.einsum('bhcls,bhcsd->bhcld', scores, v) + inter_w[..., None] * jnp.einsum('bhcvk,bhclk->bhclv', c_in, q)
    den = jnp.sum(scores, axis=-1) + inter_w * jnp.einsum('bhck,bhclk->bhcl', n_in, q)
    h = num / jnp.maximum(jnp.abs(den), jnp.exp(-m_t))[..., None]
    h = h.transpose(0, 2, 3, 1, 4).reshape(bsz, t_len, ML_HEADS, ML_HEAD_DIM)
    mean = jnp.mean(h, axis=-1, keepdims=True)
    var = jnp.mean(jnp.square(h - mean), axis=-1, keepdims=True)
    h = (h - mean) * lax.rsqrt(var + ML_NORM_EPS)
    h = h.reshape(bsz, t_len, ML_WIDTH) * norm_w.astype(F32)
    return h * jax.nn.sigmoid(o_pre)


def _peer(h, w_q, sub_keys, u_emb, v_emb):
    bsz, t_len, d = h.shape
    tok = h.reshape(-1, d)
    n_tok = tok.shape[0]
    q = (tok @ w_q).astype(F32).reshape(n_tok, PEER_HEADS, 2, PEER_HALF)
    s = jnp.einsum('nhpc,hpkc->nhpk', q, sub_keys.astype(F32))
    s_top, i_top = lax.top_k(s, PEER_TOPK)
    cand = (s_top[:, :, 0, :, None] + s_top[:, :, 1, None, :]).reshape(n_tok, PEER_HEADS, PEER_TOPK * PEER_TOPK)
    cand_idx = (i_top[:, :, 0, :, None] * PEER_KEYS + i_top[:, :, 1, None, :]).reshape(n_tok, PEER_HEADS, PEER_TOPK * PEER_TOPK)
    best, pos = lax.top_k(cand, PEER_TOPK)
    expert = jnp.take_along_axis(cand_idx, pos, axis=-1)
    gate = jax.nn.softmax(best, axis=-1)
    n_blk = n_tok // PEER_TOKEN_BLOCK
    sel = PEER_HEADS * PEER_TOPK

    def retrieve(args):
        tb, eb, gb = args
        act = jax.nn.gelu(jnp.einsum('tkd,td->tk', u_emb[eb], tb), approximate=False) * gb
        return jnp.einsum('tk,tkd->td', act, v_emb[eb])

    out = lax.map(retrieve, (tok.reshape(n_blk, PEER_TOKEN_BLOCK, d),
                             expert.reshape(n_blk, PEER_TOKEN_BLOCK, sel),
                             gate.astype(tok.dtype).reshape(n_blk, PEER_TOKEN_BLOCK, sel)))
    return out.reshape(bsz, t_len, d)


def setup_inputs(seed: int = 0) -> dict:
    key = jax.random.key(seed)
    ks = jax.random.split(key, 40)
    nrm = lambda k, shape, scale: jax.random.normal(k, shape, F32) * scale
    L = DEPTH
    return {
        "x": nrm(ks[0], (BATCH, SEQ, D_MODEL), 1.0),
        "norm1_g": 1.0 + nrm(ks[1], (L, D_MODEL), 0.02),
        "w_in": nrm(ks[2], (L, D_MODEL, IN_COLS), D_MODEL ** -0.5),
        "rw_mu": jax.random.uniform(ks[3], (L, RW_COLS), F32, 0.0, 1.0),
        "rw_w0": jnp.broadcast_to(jnp.linspace(-6.0, -1.0, RW_WIDTH, dtype=F32), (L, RW_WIDTH)) + nrm(ks[4], (L, RW_WIDTH), 0.1),
        "rw_w_up": nrm(ks[5], (L, RW_DECAY_LORA, RW_WIDTH), 0.1),
        "rw_a0": nrm(ks[6], (L, RW_WIDTH), 0.1),
        "rw_a_up": nrm(ks[7], (L, RW_AAA_LORA, RW_WIDTH), 0.1),
        "rw_g_up": nrm(ks[8], (L, RW_GATE_LORA, RW_WIDTH), RW_GATE_LORA ** -0.5),
        "rw_k_k": 0.85 + nrm(ks[9], (L, RW_WIDTH), 0.02),
        "rw_k_a": 1.0 + nrm(ks[10], (L, RW_WIDTH), 0.02),
        "rw_r_k": nrm(ks[11], (L, RW_HEADS, RW_HEAD_DIM), 0.1),
        "rw_gn_w": 1.0 + nrm(ks[12], (L, RW_WIDTH), 0.02),
        "rw_gn_b": nrm(ks[13], (L, RW_WIDTH), 0.02),
        "ml_conv_q_w": nrm(ks[14], (L, ML_CONV, ML_WIDTH), 0.5),
        "ml_conv_q_b": nrm(ks[15], (L, ML_WIDTH), 0.02),
        "ml_conv_k_w": nrm(ks[16], (L, ML_CONV, ML_WIDTH), 0.5),
        "ml_conv_k_b": nrm(ks[17], (L, ML_WIDTH), 0.02),
        "ml_b_i": nrm(ks[18], (L, ML_HEADS), 0.1),
        "ml_b_f": jnp.broadcast_to(jnp.linspace(3.0, 6.0, ML_HEADS, dtype=F32), (L, ML_HEADS)) + nrm(ks[19], (L, ML_HEADS), 0.1),
        "ml_norm_w": 1.0 + nrm(ks[20], (L, ML_WIDTH), 0.02),
        "gate_b": nrm(ks[21], (L, GATE_COLS), 0.02),
        "p_rw": nrm(ks[22], (L, RW_WIDTH, D_MODEL), RW_WIDTH ** -0.5),
        "p_ml": nrm(ks[23], (L, ML_WIDTH, D_MODEL), ML_WIDTH ** -0.5),
        "w_out": nrm(ks[24], (L, D_MODEL, D_MODEL), D_MODEL ** -0.5),
        "norm2_g": 1.0 + nrm(ks[25], (L, D_MODEL), 0.02),
        "peer_w_q": nrm(ks[26], (L, D_MODEL, PEER_HEADS * PEER_QDIM), D_MODEL ** -0.5),
        "peer_sub_keys": nrm(ks[27], (L, PEER_HEADS, 2, PEER_KEYS, PEER_HALF), PEER_HALF ** -0.5),
        "peer_u": nrm(ks[28], (L, PEER_EXPERTS, D_MODEL), D_MODEL ** -0.5),
        "peer_v": nrm(ks[29], (L, PEER_EXPERTS, D_MODEL), 0.25),
        "final_g": 1.0 + nrm(ks[30], (D_MODEL,), 0.02),
    }


def reference(x, norm1_g, w_in, rw_mu, rw_w0, rw_w_up, rw_a0, rw_a_up, rw_g_up, rw_k_k, rw_k_a, rw_r_k,
              rw_gn_w, rw_gn_b, ml_conv_q_w, ml_conv_q_b, ml_conv_k_w, ml_conv_k_b, ml_b_i, ml_b_f, ml_norm_w,
              gate_b, p_rw, p_ml, w_out, norm2_g, peer_w_q, peer_sub_keys, peer_u, peer_v, final_g):
    bsz, t_len, d = x.shape
    for l in range(DEPTH):
        h = _rmsnorm(x, norm1_g[l])
        z = h @ w_in[l]
        z_rw = z[..., :RW_COLS]
        z_ml = z[..., RW_COLS:RW_COLS + ML_COLS]
        z_gate = z[..., RW_COLS + ML_COLS:]
        y_rw = _rwkv7(z_rw, rw_mu[l], rw_w0[l], rw_w_up[l], rw_a0[l], rw_a_up[l], rw_g_up[l],
                      rw_k_k[l], rw_k_a[l], rw_r_k[l], rw_gn_w[l], rw_gn_b[l]).astype(x.dtype)
        y_ml = _mlstm(z_ml, ml_conv_q_w[l], ml_conv_q_b[l], ml_conv_k_w[l], ml_conv_k_b[l],
                      ml_b_i[l], ml_b_f[l], ml_norm_w[l]).astype(x.dtype)
        gate = jax.nn.sigmoid((z_gate + gate_b[l]).astype(F32)).astype(x.dtype).reshape(bsz, t_len, N_BRANCH, d)
        merged = gate[:, :, 0, :] * (y_rw @ p_rw[l]) + gate[:, :, 1, :] * (y_ml @ p_ml[l])
        x = x + merged @ w_out[l]
        x = x + _peer(_rmsnorm(x, norm2_g[l]), peer_w_q[l], peer_sub_keys[l], peer_u[l], peer_v[l])
    return _rmsnorm(x, final_g)
```

```cpp
#include <hip/hip_runtime.h>
#include <hip/hip_cooperative_groups.h>
#include <cstdio>
namespace cg = cooperative_groups;
namespace pg8 {
#define PG8_LAS __attribute__((address_space(3)))
typedef unsigned short bf16_t;
typedef short bf16x8 __attribute__((ext_vector_type(8)));
typedef float f32x4 __attribute__((ext_vector_type(4)));
typedef unsigned u32x4 __attribute__((ext_vector_type(4)));
constexpr int BM = 256, BK = 64, HALF = 128, HTB = HALF * BK * 2  , STAGE_BYTES = 8 * HTB, NXCD = 8, WGM = 8;

__host__ __device__ __forceinline__ int lds_byte(int r, int c) { const int st = (r >> 4) * 2 + (c >> 5), rr = r & 15, cc = c & 31, ob = rr * 64 + cc * 2; return st * 1024 + (ob ^ (((ob >> 9) & 1) << 5)); }
__host__ __device__ __forceinline__ void stage_rc(int b, int& R, int& C) { const int st = b / 1024, sb = b % 1024, swz = sb ^ (((sb >> 9) & 1) << 5); R = (st >> 1) * 16 + swz / 64; C = (st & 1) * 32 + (swz % 64) / 2; }
__host__ __device__ __forceinline__ int perm32(int rho) { const int n = rho >> 4, i = rho & 15; return 8 * (i >> 2) + 4 * n + (i & 3); }

struct Unit { int pm, pn; };
struct Gemm { const bf16_t* A; const bf16_t* Bt; int M, N, K; };

struct StaticOrder {
    int nM, nN, nwg, G, c;
    __host__ __device__ void init(int M, int N, int G_, int c_) { nM = M / BM; nN = N / BM; nwg = nM * nN; G = G_; c = c_; }
    __host__ __device__ bool next(int i, Unit& u) const {
        const long L = (long)i * G + c; if (L >= nwg) return false;
        int wgid = (int)L; { const int q = nwg / NXCD, r = nwg % NXCD, xcd = wgid % NXCD, off = wgid / NXCD; wgid = (xcd < r ? xcd * (q + 1) : r * (q + 1) + (xcd - r) * q) + off; }
        const int nig = WGM * nN, gid = wgid / nig, fm = gid * WGM, gsz = (nM - fm) < WGM ? (nM - fm) : WGM;
        u.pm = fm + ((wgid % nig) % gsz); u.pn = (wgid % nig) / gsz; return true;
    }
    __device__ __forceinline__ void a_ready(const Unit&) const {}
    __device__ __forceinline__ void done(const Unit&) const {}
};
__device__ __forceinline__ unsigned cvt_pk_bf16(float lo, float hi) { unsigned r; asm volatile("v_cvt_pk_bf16_f32 %0, %1, %2" : "=v"(r) : "v"(lo), "v"(hi)); return r; }
typedef float f32x2 __attribute__((ext_vector_type(2)));
template <class Epi, class Sched, bool STAMP = false>
__device__ __forceinline__ void gemm_phase(PG8_LAS unsigned char* lds, const Gemm g, const Sched& S, const Epi& E, unsigned long long* stamps) {
    const int tid = threadIdx.x, wid = __builtin_amdgcn_readfirstlane(tid >> 6), lane = tid & 63, wr = wid >> 2, wc = wid & 3, fr = lane & 15, fq = lane >> 4;
    const int K = g.K, nt = K / BK;
    int ts_lo = 0, ts_hi = 0, nts = 0; const unsigned long long rt_entry = STAMP ? (unsigned long long)wall_clock64() : 0ull;
#define PG8_STAMP() do { if (STAMP && wid == 0 && nts < 64) { const unsigned long long _c = (unsigned long long)clock64(); \
        ts_lo = (lane == nts) ? (int)(unsigned)_c : ts_lo; ts_hi = (lane == nts) ? (int)(unsigned)(_c >> 32) : ts_hi; ++nts; } } while (0)
    PG8_STAMP();
    unsigned voffA[2], voffB[2];
#pragma unroll
    for (int i = 0; i < 2; ++i) { int R, C; stage_rc(tid * 16 + i * 8192, R, C); const int Rb = Epi::PERM ? ((R & ~31) + perm32(R & 31)) : R;
        voffA[i] = (unsigned)(R * K + C) * 2u; voffB[i] = (unsigned)(Rb * K + C) * 2u; }
    const size_t kstep = (size_t)(BK * 2);
    const size_t hstep = (size_t)HALF * K * 2;
    const size_t tstep = 2 * hstep;
    const unsigned ldsw = (unsigned)wid * 1024u;
    const int aoff = lds_byte(wr * 64 + fr, fq * 8), boff = lds_byte(wc * 32 + fr, fq * 8);
#define PG8_SA(b, h) (((b) * 2 + (h)) * HTB)
#define PG8_SB(b, h) ((4 + (b) * 2 + (h)) * HTB)
#define PG8_STAGE(bufoff, gbase, voff) do { _Pragma("unroll") for (int _i = 0; _i < 2; ++_i) \
        __builtin_amdgcn_global_load_lds((const unsigned*)((const char*)(gbase) + (voff)[_i]), (PG8_LAS unsigned*)(lds + (bufoff) + ldsw + _i * 8192), 16, 0, 0); } while (0)
#define PG8_LDA(dst, b, h) do { _Pragma("unroll") for (int m = 0; m < 4; ++m) _Pragma("unroll") for (int k = 0; k < 2; ++k) dst[m][k] = *(const PG8_LAS bf16x8*)(lds + PG8_SA(b, h) + aoff + m * 2048 + k * 1024); } while (0)
#define PG8_LDB(dst, b, h) do { _Pragma("unroll") for (int n = 0; n < 2; ++n) _Pragma("unroll") for (int k = 0; k < 2; ++k) dst[n][k] = *(const PG8_LAS bf16x8*)(lds + PG8_SB(b, h) + boff + n * 2048 + k * 1024); } while (0)
#define PG8_MMA(ai, bj, At, Bt) do { __builtin_amdgcn_s_setprio(1); _Pragma("unroll") for (int m = 0; m < 4; ++m) _Pragma("unroll") for (int n = 0; n < 2; ++n) _Pragma("unroll") for (int k = 0; k < 2; ++k) \
        acc[ai][bj][m][n] = __builtin_amdgcn_mfma_f32_16x16x32_bf16(Bt[n][k], At[m][k], acc[ai][bj][m][n], 0, 0, 0); __builtin_amdgcn_s_setprio(0); } while (0)
#define PG8_WAIT_V(n) asm volatile("s_waitcnt vmcnt(" #n ")" ::: "memory")
#define PG8_WAIT_L(n) asm volatile("s_waitcnt lgkmcnt(" #n ")" ::: "memory")
#define PG8_BAR __builtin_amdgcn_s_barrier()
#define PG8_SCHED __builtin_amdgcn_sched_barrier(0)
    Unit cur, nxt; int ui = 0;
    if (!S.next(0, cur)) return;
    f32x4 acc[2][2][4][2];
#pragma unroll
    for (int a = 0; a < 2; ++a)
#pragma unroll
        for (int b = 0; b < 2; ++b)
#pragma unroll
            for (int m = 0; m < 4; ++m)
#pragma unroll
                for (int n = 0; n < 2; ++n) acc[a][b][m][n] = (f32x4){0.f, 0.f, 0.f, 0.f};
    bf16x8 At[4][2], B0[2][2], B1[2][2];
    const char* cA = (const char*)g.A + (size_t)cur.pm * tstep; const char* cB = (const char*)g.Bt + (size_t)cur.pn * tstep;
    S.a_ready(cur);
    PG8_STAGE(PG8_SB(0, 0), cB, voffB); PG8_STAGE(PG8_SA(0, 0), cA, voffA); PG8_STAGE(PG8_SB(0, 1), cB + hstep, voffB); PG8_STAGE(PG8_SA(0, 1), cA + hstep, voffA);
    if (wr == 1) PG8_BAR;
    PG8_WAIT_V(4); PG8_BAR;
    PG8_STAGE(PG8_SB(1, 0), cB + kstep, voffB); PG8_STAGE(PG8_SA(1, 0), cA + kstep, voffA); PG8_STAGE(PG8_SB(1, 1), cB + hstep + kstep, voffB);
    PG8_WAIT_V(6); PG8_BAR;
    PG8_STAMP();
    for (;;) {
        const bool has_next = S.next(ui + 1, nxt);
        const char* nA = has_next ? (const char*)g.A + (size_t)nxt.pm * tstep : cA; const char* nB = has_next ? (const char*)g.Bt + (size_t)nxt.pn * tstep : cB;
        for (int t = 0; t < nt; t += 2) {
            const bool last = (t == nt - 2);
            const char* a1 = cA + (size_t)(t + 1) * kstep;
            const char* a2 = last ? nA : cA + (size_t)(t + 2) * kstep; const char* b2 = last ? nB : cB + (size_t)(t + 2) * kstep;
            const char* a3 = a2 + kstep; const char* b3 = b2 + kstep;
            if (last && has_next) S.a_ready(nxt);
            PG8_LDB(B0, 0, 0); PG8_SCHED; PG8_LDA(At, 0, 0); PG8_STAGE(PG8_SA(1, 1), a1 + hstep, voffA);
            PG8_WAIT_L(8); PG8_BAR; PG8_WAIT_L(0); PG8_MMA(0, 0, At, B0); PG8_BAR; PG8_SCHED;
            PG8_LDB(B1, 0, 1); PG8_STAGE(PG8_SB(0, 0), b2, voffB);
            PG8_BAR; PG8_WAIT_L(0); PG8_MMA(0, 1, At, B1); PG8_BAR;
            PG8_LDA(At, 0, 1); PG8_STAGE(PG8_SA(0, 0), a2, voffA);
            PG8_BAR; PG8_WAIT_L(0); PG8_MMA(1, 0, At, B0); PG8_BAR; PG8_SCHED;
            PG8_STAGE(PG8_SB(0, 1), b2 + hstep, voffB);
            PG8_WAIT_V(6); PG8_BAR; PG8_MMA(1, 1, At, B1); PG8_BAR;
            PG8_LDB(B0, 1, 0); PG8_SCHED; PG8_LDA(At, 1, 0); PG8_STAGE(PG8_SA(0, 1), a2 + hstep, voffA);
            PG8_WAIT_L(8); PG8_BAR; PG8_WAIT_L(0); PG8_MMA(0, 0, At, B0); PG8_BAR; PG8_SCHED;
            PG8_LDB(B1, 1, 1); PG8_STAGE(PG8_SB(1, 0), b3, voffB);
            PG8_BAR; PG8_WAIT_L(0); PG8_MMA(0, 1, At, B1); PG8_BAR;
            PG8_LDA(At, 1, 1); PG8_STAGE(PG8_SA(1, 0), a3, voffA);
            PG8_BAR; PG8_WAIT_L(0); PG8_MMA(1, 0, At, B0); PG8_BAR; PG8_SCHED;
            PG8_STAGE(PG8_SB(1, 1), b3 + hstep, voffB);
            PG8_WAIT_V(6); PG8_BAR; PG8_MMA(1, 1, At, B1); PG8_BAR;
        }
        PG8_STAMP();
        if constexpr (!Epi::AFTER_DRAIN) { E(acc, cur, wr, wc, fr, fq); S.done(cur); }
        PG8_STAMP();
        if (!has_next) break;
#pragma unroll
        for (int a = 0; a < 2; ++a)
#pragma unroll
            for (int b = 0; b < 2; ++b)
#pragma unroll
                for (int m = 0; m < 4; ++m)
#pragma unroll
                    for (int n = 0; n < 2; ++n) acc[a][b][m][n] = (f32x4){0.f, 0.f, 0.f, 0.f};
        cur = nxt; cA = nA; cB = nB; ++ui;
    }
    PG8_WAIT_V(0);
    if (wr == 0) PG8_BAR;
    PG8_BAR;
    if constexpr (Epi::AFTER_DRAIN) { E.fused(acc, cur, wr, wc, fr, fq, lds, wid, lane); S.done(cur); }
    PG8_STAMP();
    if (STAMP && wid == 0) { stamps[lane] = lane < nts ? (((unsigned long long)(unsigned)ts_hi << 32) | (unsigned)ts_lo) : 0ull;
        if (lane == 62) stamps[62] = rt_entry; if (lane == 63) stamps[63] = (unsigned long long)wall_clock64(); }
#undef PG8_STAMP
#undef PG8_SA
#undef PG8_SB
#undef PG8_STAGE
#undef PG8_LDA
#undef PG8_LDB
#undef PG8_MMA
#undef PG8_WAIT_V
#undef PG8_WAIT_L
#undef PG8_BAR
#undef PG8_SCHED
}
}
#ifndef PHMASK
#define PHMASK 4095
#endif

using pg8::bf16_t; using pg8::bf16x8; using pg8::f32x4; using pg8::u32x4;
#define LAS __attribute__((address_space(3)))
typedef unsigned u32x2 __attribute__((ext_vector_type(2)));

constexpr int NTOK = 16384, DM = 1024, SEQ = 4096;
constexpr size_t MiB = 1ull << 20;
constexpr size_t OFF_RSTD1 = 0, OFF_IFG = 64 * 1024, OFF_SS2 = 576 * 1024, OFF_BONUS = 640 * 1024, OFF_NLOC = 1152 * 1024, OFF_GEND = 1664 * 1024;
constexpr size_t OFF_WINT = 2 * MiB, OFF_PRWT = OFF_WINT + 5888ull * 1024 * 2, OFF_PMLT = OFF_PRWT + MiB, OFF_WOUTT = OFF_PMLT + MiB, OFF_WQT = OFF_WOUTT + 2 * MiB, OFF_SKT = OFF_WQT + 4 * MiB;
static_assert(OFF_SKT + MiB / 2 == 22 * MiB, "weights map");
constexpr size_t OFF_ZRW = 22 * MiB, OFF_ZML = 78 * MiB, OFF_ZG = 142 * MiB, OFF_XB = 206 * MiB;
constexpr size_t OFF_R = 206 * MiB, OFF_KM = 222 * MiB, OFF_V = 238 * MiB;
constexpr size_t OOF_KK = 0, OOF_BB = 16 * MiB, OOF_LW = 32 * MiB, OOF_G = 48 * MiB;
constexpr size_t OFF_CLOC = 22 * MiB, OFF_Y = 54 * MiB;
constexpr size_t OFF_YML = 206 * MiB, OFF_T = 78 * MiB, OFF_MERGED = 222 * MiB, OFF_X1B = 22 * MiB, OFF_Q = 142 * MiB, OFF_KEYS = 78 * MiB;

struct Params {
    const float* in[31];
    float* out;
    unsigned char* ws;
};

__device__ __forceinline__ float bf2f(bf16_t v) { return __uint_as_float(((unsigned)v) << 16); }
__device__ __forceinline__ unsigned f2bf(float f) { unsigned u = __float_as_uint(f); return (u + 0x7fffu + ((u >> 16) & 1u)) >> 16; }
__device__ __forceinline__ unsigned pk2(float lo, float hi) { return f2bf(lo) | (f2bf(hi) << 16); }
__device__ __forceinline__ float wave_sum(float v) {
#pragma unroll
    for (int o = 1; o < 64; o <<= 1) v += __shfl_xor(v, o);
    return v;
}
template <int CTRL> __device__ __forceinline__ float dpp_mov(float v) {
    return __builtin_bit_cast(float, __builtin_amdgcn_update_dpp(0, __builtin_bit_cast(int, v), CTRL, 0xf, 0xf, true));
}
__device__ __forceinline__ float sum8(float v) { v += dpp_mov<0xB1>(v); v += dpp_mov<0x4E>(v); v += dpp_mov<0x141>(v); return v; }
__device__ __forceinline__ float sum16(float v) { v = sum8(v); v += dpp_mov<0x140>(v); return v; }
__device__ __forceinline__ float max16(float v) { v = fmaxf(v, dpp_mov<0xB1>(v)); v = fmaxf(v, dpp_mov<0x4E>(v)); v = fmaxf(v, dpp_mov<0x141>(v)); v = fmaxf(v, dpp_mov<0x140>(v)); return v; }
__device__ __forceinline__ float sigmoidf_(float x) { return 1.f / (1.f + __expf(-x)); }
__device__ __forceinline__ float softplusf_(float x) { return fmaxf(x, 0.f) + log1pf(__expf(-fabsf(x))); }

struct EpiZ {
    static constexpr bool PERM = true, AFTER_DRAIN = false;
    bf16_t* zrw; bf16_t* zml; bf16_t* zg; const float* rstd;
    __device__ __forceinline__ void operator()(const f32x4 (&acc)[2][2][4][2], const pg8::Unit& u, int wr, int wc, int fr, int fq) const {
        const int row0 = u.pm * 256 + wr * 64 + fr;
        bf16_t* base; int ldc, colt;
        if (u.pn < 7) { base = zrw; ldc = 1792; colt = u.pn * 256; }
        else if (u.pn < 15) { base = zml; ldc = 2048; colt = (u.pn - 7) * 256; }
        else { base = zg; ldc = 2048; colt = (u.pn - 15) * 256; }
        const int col0 = colt + wc * 32 + 8 * fq;
#pragma unroll
        for (int ai = 0; ai < 2; ++ai)
#pragma unroll
            for (int m = 0; m < 4; ++m) {
                const int row = row0 + ai * 128 + m * 16; const float s = rstd[row];
                bf16_t* rowp = base + (size_t)row * ldc + col0;
#pragma unroll
                for (int bj = 0; bj < 2; ++bj) {
                    const f32x4 v0 = acc[ai][bj][m][0] * s, v1 = acc[ai][bj][m][1] * s;
                    u32x4 w; w.x = pk2(v0[0], v0[1]); w.y = pk2(v0[2], v0[3]); w.z = pk2(v1[0], v1[1]); w.w = pk2(v1[2], v1[3]);
                    *(u32x4*)(rowp + bj * 128) = w;
                }
            }
    }
};
struct EpiMerge1 {
    static constexpr bool PERM = false, AFTER_DRAIN = false;
    const bf16_t* zg; const float* gb; float* T;
    __device__ __forceinline__ void operator()(const f32x4 (&acc)[2][2][4][2], const pg8::Unit& u, int wr, int wc, int fr, int fq) const {
        const int row0 = u.pm * 256 + wr * 64 + fr, col0 = u.pn * 256 + wc * 32 + 4 * fq;
#pragma unroll
        for (int ai = 0; ai < 2; ++ai)
#pragma unroll
            for (int m = 0; m < 4; ++m) {
                const int row = row0 + ai * 128 + m * 16;
#pragma unroll
                for (int bj = 0; bj < 2; ++bj)
#pragma unroll
                    for (int n = 0; n < 2; ++n) {
                        const int col = col0 + bj * 128 + n * 16;
                        const u32x2 zr = *(const u32x2*)(zg + (size_t)row * 2048 + col);
                        const f32x4 b = *(const f32x4*)(gb + col);
                        f32x4 g;
                        g[0] = sigmoidf_(__uint_as_float(zr.x << 16) + b[0]); g[1] = sigmoidf_(__uint_as_float(zr.x & 0xffff0000u) + b[1]);
                        g[2] = sigmoidf_(__uint_as_float(zr.y << 16) + b[2]); g[3] = sigmoidf_(__uint_as_float(zr.y & 0xffff0000u) + b[3]);
                        *(f32x4*)(T + (size_t)row * 1024 + col) = g * acc[ai][bj][m][n];
                    }
            }
    }
};
struct EpiMerge2 {
    static constexpr bool PERM = false, AFTER_DRAIN = false;
    const bf16_t* zg; const float* gb; const float* T; bf16_t* merged;
    __device__ __forceinline__ void operator()(const f32x4 (&acc)[2][2][4][2], const pg8::Unit& u, int wr, int wc, int fr, int fq) const {
        const int row0 = u.pm * 256 + wr * 64 + fr, col0 = u.pn * 256 + wc * 32 + 4 * fq;
#pragma unroll
        for (int ai = 0; ai < 2; ++ai)
#pragma unroll
            for (int m = 0; m < 4; ++m) {
                const int row = row0 + ai * 128 + m * 16;
#pragma unroll
                for (int bj = 0; bj < 2; ++bj)
#pragma unroll
                    for (int n = 0; n < 2; ++n) {
                        const int col = col0 + bj * 128 + n * 16;
                        const u32x2 zr = *(const u32x2*)(zg + (size_t)row * 2048 + 1024 + col);
                        const f32x4 b = *(const f32x4*)(gb + 1024 + col);
                        const f32x4 t = *(const f32x4*)(T + (size_t)row * 1024 + col);
                        f32x4 g;
                        g[0] = sigmoidf_(__uint_as_float(zr.x << 16) + b[0]); g[1] = sigmoidf_(__uint_as_float(zr.x & 0xffff0000u) + b[1]);
                        g[2] = sigmoidf_(__uint_as_float(zr.y << 16) + b[2]); g[3] = sigmoidf_(__uint_as_float(zr.y & 0xffff0000u) + b[3]);
                        const f32x4 o = t + g * acc[ai][bj][m][n];
                        u32x2 w; w.x = pk2(o[0], o[1]); w.y = pk2(o[2], o[3]);
                        *(u32x2*)(merged + (size_t)row * 1024 + col) = w;
                    }
            }
    }
};
struct EpiOut {
    static constexpr bool PERM = false, AFTER_DRAIN = false;
    const float* x; float* x1; bf16_t* x1b; float* ss2;
    __device__ __forceinline__ void operator()(const f32x4 (&acc)[2][2][4][2], const pg8::Unit& u, int wr, int wc, int fr, int fq) const {
        const int row0 = u.pm * 256 + wr * 64 + fr, col0 = u.pn * 256 + wc * 32 + 4 * fq;
#pragma unroll
        for (int ai = 0; ai < 2; ++ai)
#pragma unroll
            for (int m = 0; m < 4; ++m) {
                const int row = row0 + ai * 128 + m * 16; float s = 0.f;
#pragma unroll
                for (int bj = 0; bj < 2; ++bj)
#pragma unroll
                    for (int n = 0; n < 2; ++n) {
                        const int col = col0 + bj * 128 + n * 16;
                        const f32x4 o = *(const f32x4*)(x + (size_t)row * 1024 + col) + acc[ai][bj][m][n];
                        *(f32x4*)(x1 + (size_t)row * 1024 + col) = o;
                        u32x2 w; w.x = pk2(o[0], o[1]); w.y = pk2(o[2], o[3]);
                        *(u32x2*)(x1b + (size_t)row * 1024 + col) = w;
                        s += (o[0] * o[0] + o[1] * o[1]) + (o[2] * o[2] + o[3] * o[3]);
                    }
                s += __shfl_xor(s, 16); s += __shfl_xor(s, 32);
                if (fq == 0) atomicAdd(ss2 + row, s);
            }
    }
};
struct EpiQ {
    static constexpr bool PERM = true, AFTER_DRAIN = false;
    bf16_t* q; const float* ss2;
    __device__ __forceinline__ void operator()(const f32x4 (&acc)[2][2][4][2], const pg8::Unit& u, int wr, int wc, int fr, int fq) const {
        const int row0 = u.pm * 256 + wr * 64 + fr, col0 = u.pn * 256 + wc * 32 + 8 * fq;
#pragma unroll
        for (int ai = 0; ai < 2; ++ai)
#pragma unroll
            for (int m = 0; m < 4; ++m) {
                const int row = row0 + ai * 128 + m * 16; const float s = 1.f / sqrtf(ss2[row] * (1.f / 1024.f) + 1e-6f);
                bf16_t* rowp = q + (size_t)row * 2048 + col0;
#pragma unroll
                for (int bj = 0; bj < 2; ++bj) {
                    const f32x4 v0 = acc[ai][bj][m][0] * s, v1 = acc[ai][bj][m][1] * s;
                    u32x4 w; w.x = pk2(v0[0], v0[1]); w.y = pk2(v0[2], v0[3]); w.z = pk2(v1[0], v1[1]); w.w = pk2(v1[2], v1[3]);
                    *(u32x4*)(rowp + bj * 128) = w;
                }
            }
    }
};

__device__ __forceinline__ void p0_tile(const float* src, int ld, int K, bf16_t* dst, const float* ks, int skip_from, int skip, int kb, int nb, float* lds) {
    const int tid = threadIdx.x;
    { const int nl = tid & 63, kl0 = tid >> 6; const int n = nb * 64 + nl; const int col = n >= skip_from ? n + skip : n;
#pragma unroll
      for (int i = 0; i < 8; ++i) { const int k = kl0 + 8 * i; float v = src[(size_t)(kb * 64 + k) * ld + col]; if (ks) v *= ks[kb * 64 + k]; lds[k * 65 + nl] = v; } }
    __syncthreads();
    { const int kl = tid & 63, nl0 = tid >> 6;
#pragma unroll
      for (int i = 0; i < 8; ++i) { const int n2 = nl0 + 8 * i; dst[(size_t)(nb * 64 + n2) * K + kb * 64 + kl] = (bf16_t)f2bf(lds[kl * 65 + n2]); } }
    __syncthreads();
}
__device__ __forceinline__ void phase0(const Params& p, float* lds) {
    unsigned char* ws = p.ws;
    for (int t = blockIdx.x; t < 2496; t += gridDim.x) {
        int r = t;
        if (r < 1472) { p0_tile(p.in[2], 5896, 1024, (bf16_t*)(ws + OFF_WINT), p.in[1], 3840, 8, r / 92, r % 92, lds); continue; } r -= 1472;
        if (r < 128) { p0_tile(p.in[22], 1024, 512, (bf16_t*)(ws + OFF_PRWT), nullptr, 1 << 30, 0, r / 16, r % 16, lds); continue; } r -= 128;
        if (r < 128) { p0_tile(p.in[23], 1024, 512, (bf16_t*)(ws + OFF_PMLT), nullptr, 1 << 30, 0, r / 16, r % 16, lds); continue; } r -= 128;
        if (r < 256) { p0_tile(p.in[24], 1024, 1024, (bf16_t*)(ws + OFF_WOUTT), nullptr, 1 << 30, 0, r / 16, r % 16, lds); continue; } r -= 256;
        p0_tile(p.in[26], 2048, 1024, (bf16_t*)(ws + OFF_WQT), p.in[25], 1 << 30, 0, r / 32, r % 32, lds);
    }
    { bf16_t* skt = (bf16_t*)(ws + OFF_SKT); const float* sk = p.in[27];
      for (int i = blockIdx.x * 512 + threadIdx.x; i < 262144; i += gridDim.x * 512) skt[i] = (bf16_t)f2bf(sk[i]); }
    { const float* w_in = p.in[2]; const float* g1 = p.in[1];
      for (int i = threadIdx.x; i < 8192; i += 512) { const int c = i >> 10, k = i & 1023; lds[i] = w_in[(size_t)k * 5896 + 3840 + c] * g1[k]; }
      __syncthreads();
      const int wave = threadIdx.x >> 6, lane = threadIdx.x & 63;
      float* rstd1 = (float*)(ws + OFF_RSTD1); float* ifg = (float*)(ws + OFF_IFG); float* ss2 = (float*)(ws + OFF_SS2); bf16_t* xb = (bf16_t*)(ws + OFF_XB);
      for (int row = blockIdx.x * 8 + wave; row < NTOK; row += gridDim.x * 8) {
          const f32x4* xr = (const f32x4*)(p.in[0] + (size_t)row * 1024);
          float ss = 0.f; float d[8];
#pragma unroll
          for (int c = 0; c < 8; ++c) d[c] = 0.f;
#pragma unroll
          for (int j = 0; j < 4; ++j) {
              const f32x4 v = xr[lane + 64 * j]; ss += (v[0] * v[0] + v[1] * v[1]) + (v[2] * v[2] + v[3] * v[3]);
              u32x2 o; o.x = pk2(v[0], v[1]); o.y = pk2(v[2], v[3]);
              ((u32x2*)(xb + (size_t)row * 1024))[lane + 64 * j] = o;
#pragma unroll
              for (int c = 0; c < 8; ++c) { const f32x4 w = *(const f32x4*)(lds + c * 1024 + (lane + 64 * j) * 4); d[c] += (v[0] * w[0] + v[1] * w[1]) + (v[2] * w[2] + v[3] * w[3]); }
          }
          ss = wave_sum(ss);
#pragma unroll
          for (int c = 0; c < 8; ++c) d[c] = wave_sum(d[c]);
          const float rs = 1.f / sqrtf(ss * (1.f / 1024.f) + 1e-6f);
          if (lane == 0) { rstd1[row] = rs; ss2[row] = 0.f; }
          float mine = d[0];
#pragma unroll
          for (int c = 1; c < 8; ++c) mine = (lane == c) ? d[c] : mine;
          if (lane < 8) ifg[row * 8 + lane] = mine * rs;
      }
      __syncthreads();
    }
}

__device__ __forceinline__ void phase_rwkv_pre(const Params& p, float* lds) {
    float* INW = lds; float* INA = INW + 64 * 68; float* ING = INA + 64 * 68;
    const int tid = threadIdx.x, lane = tid & 63, tg = tid >> 6;
    const bf16_t* zrw = (const bf16_t*)(p.ws + OFF_ZRW);
    bf16_t* R = (bf16_t*)(p.ws + OFF_R); bf16_t* KM = (bf16_t*)(p.ws + OFF_KM); bf16_t* V = (bf16_t*)(p.ws + OFF_V);
    unsigned char* ob = (unsigned char*)p.out;
    bf16_t* KK = (bf16_t*)(ob + OOF_KK); bf16_t* BB = (bf16_t*)(ob + OOF_BB); bf16_t* LW = (bf16_t*)(ob + OOF_LW); bf16_t* G = (bf16_t*)(ob + OOF_G);
    float* bonus = (float*)(p.ws + OFF_BONUS);
    const float* mu = p.in[3]; const float* w_up = p.in[5]; const float* a_up = p.in[7]; const float* g_up = p.in[8];
    for (int u = blockIdx.x; u < 2048; u += gridDim.x) {
        const int h = u & 7, bc = u >> 3; const int n0 = bc * 64, t0 = (bc & 63) * 64;
        for (int idx = tid; idx < 64 * 256; idx += 512) {
            const int t = idx >> 8, cc = idx & 255, col = 1536 + cc;
            const float z0 = bf2f(zrw[(size_t)(n0 + t) * 1792 + col]);
            const float zp = (t0 + t > 0) ? bf2f(zrw[(size_t)(n0 + t - 1) * 1792 + col]) : 0.f;
            const float zs = z0 + (zp - z0) * mu[col];
            if (cc < 64) INW[t * 68 + cc] = tanhf(zs);
            else if (cc < 128) INA[t * 68 + cc - 64] = zs;
            else ING[t * 132 + cc - 128] = sigmoidf_(zs);
        }
        __syncthreads();
        float aw[8], aa[8], ag[8];
#pragma unroll
        for (int i = 0; i < 8; ++i) { aw[i] = 0.f; aa[i] = 0.f; ag[i] = 0.f; }
        const int hc = h * 64 + lane;
        for (int k = 0; k < 64; k += 4) {
            const float w0 = w_up[(k + 0) * 512 + hc], w1 = w_up[(k + 1) * 512 + hc], w2 = w_up[(k + 2) * 512 + hc], w3 = w_up[(k + 3) * 512 + hc];
            const float a0 = a_up[(k + 0) * 512 + hc], a1 = a_up[(k + 1) * 512 + hc], a2 = a_up[(k + 2) * 512 + hc], a3 = a_up[(k + 3) * 512 + hc];
#pragma unroll
            for (int i = 0; i < 8; ++i) {
                const f32x4 xw = *(const f32x4*)(INW + (tg * 8 + i) * 68 + k); aw[i] += (xw[0] * w0 + xw[1] * w1) + (xw[2] * w2 + xw[3] * w3);
                const f32x4 xa = *(const f32x4*)(INA + (tg * 8 + i) * 68 + k); aa[i] += (xa[0] * a0 + xa[1] * a1) + (xa[2] * a2 + xa[3] * a3);
            }
        }
        for (int k = 0; k < 128; k += 4) {
            const float g0 = g_up[(k + 0) * 512 + hc], g1 = g_up[(k + 1) * 512 + hc], g2 = g_up[(k + 2) * 512 + hc], g3 = g_up[(k + 3) * 512 + hc];
#pragma unroll
            for (int i = 0; i < 8; ++i) { const f32x4 xg = *(const f32x4*)(ING + (tg * 8 + i) * 132 + k); ag[i] += (xg[0] * g0 + xg[1] * g1) + (xg[2] * g2 + xg[3] * g3); }
        }
        const float w0c = p.in[4][hc], a0c = p.in[6][hc], kkc = p.in[9][hc], kac = p.in[10][hc], rkc = p.in[11][hc];
        const float mur = mu[hc], muk = mu[512 + hc], muv = mu[1024 + hc];
        float zrp = 0.f, zkp = 0.f, zvp = 0.f;
        if (t0 + tg * 8 > 0) { const size_t o = (size_t)(n0 + tg * 8 - 1) * 1792; zrp = bf2f(zrw[o + hc]); zkp = bf2f(zrw[o + 512 + hc]); zvp = bf2f(zrw[o + 1024 + hc]); }
#pragma unroll
        for (int i = 0; i < 8; ++i) {
            const int n = n0 + tg * 8 + i; const size_t o = (size_t)n * 1792;
            const float zr = bf2f(zrw[o + hc]), zk = bf2f(zrw[o + 512 + hc]), zv = bf2f(zrw[o + 1024 + hc]);
            const float r = zr + (zrp - zr) * mur, k = zk + (zkp - zk) * muk, v = zv + (zvp - zv) * muv;
            zrp = zr; zkp = zk; zvp = zv;
            const float lw = w0c + aw[i];
            const float wlog = -softplusf_(-lw) - 0.5f;
            const float logdec = -__expf(wlog);
            const float a = sigmoidf_(a0c + aa[i]);
            float kk = k * kkc; const float n2 = wave_sum(kk * kk); kk = kk / fmaxf(sqrtf(n2), 1e-12f);
            const float km = k * (1.f + (a - 1.f) * kac);
            const float bb = kk * a;
            const float bon = wave_sum(r * km * rkc);
            const size_t oo = (size_t)n * 512 + hc;
            R[oo] = (bf16_t)f2bf(r); KM[oo] = (bf16_t)f2bf(km); V[oo] = (bf16_t)f2bf(v); KK[oo] = (bf16_t)f2bf(kk); BB[oo] = (bf16_t)f2bf(bb); LW[oo] = (bf16_t)f2bf(logdec); G[oo] = (bf16_t)f2bf(ag[i]);
            if (lane == 0) bonus[n * 8 + h] = bon;
        }
        __syncthreads();
    }
}

__device__ __forceinline__ void phase_rwkv_scan(const Params& p, float* lds, int bh) {
    constexpr int TS = 32;
    const int tid = threadIdx.x, v = tid >> 3, ks = tid & 7;
    const int b = bh >> 3, h = bh & 7;
    const bf16_t* R = (const bf16_t*)(p.ws + OFF_R); const bf16_t* KM = (const bf16_t*)(p.ws + OFF_KM); const bf16_t* V = (const bf16_t*)(p.ws + OFF_V);
    const unsigned char* ob = (const unsigned char*)p.out;
    const bf16_t* KK = (const bf16_t*)(ob + OOF_KK); const bf16_t* BB = (const bf16_t*)(ob + OOF_BB); const bf16_t* LW = (const bf16_t*)(ob + OOF_LW);
    bf16_t* Y = (bf16_t*)(p.ws + OFF_Y);
    float s[8];
#pragma unroll
    for (int j = 0; j < 8; ++j) s[j] = 0.f;
    float reg[6][4];
    const size_t base = ((size_t)b * SEQ) * 512 + h * 64;
#define RW_LOAD(ch) do { _Pragma("unroll") for (int j = 0; j < 4; ++j) { const int idx = tid + 512 * j; const int st = idx >> 6, c = idx & 63; \
        const size_t o = base + (size_t)((ch) * TS + st) * 512 + c; \
        reg[0][j] = bf2f(R[o]); reg[1][j] = bf2f(LW[o]); reg[2][j] = bf2f(KM[o]); reg[3][j] = bf2f(KK[o]); reg[4][j] = bf2f(BB[o]); reg[5][j] = bf2f(V[o]); } } while (0)
#define RW_WRITE(bufi) do { float* B = lds + (bufi) * 6 * TS * 64; _Pragma("unroll") for (int j = 0; j < 4; ++j) { const int idx = tid + 512 * j; \
        B[0 * TS * 64 + idx] = reg[0][j]; B[1 * TS * 64 + idx] = __expf(reg[1][j]); B[2 * TS * 64 + idx] = reg[2][j]; B[3 * TS * 64 + idx] = reg[3][j]; B[4 * TS * 64 + idx] = reg[4][j]; B[5 * TS * 64 + idx] = reg[5][j]; } } while (0)
    RW_LOAD(0); RW_WRITE(0);
    __syncthreads();
    constexpr int NCH = SEQ / TS;
    for (int ch = 0; ch < NCH; ++ch) {
        if (ch + 1 < NCH) RW_LOAD(ch + 1);
        const float* B = lds + (ch & 1) * 6 * TS * 64;
        for (int st = 0; st < TS; ++st) {
            const float* rp = B + st * 64 + ks * 8;
            const f32x4 r0 = *(const f32x4*)(rp), r1 = *(const f32x4*)(rp + 4);
            const f32x4 w0 = *(const f32x4*)(rp + 1 * TS * 64), w1 = *(const f32x4*)(rp + 1 * TS * 64 + 4);
            const f32x4 k0 = *(const f32x4*)(rp + 2 * TS * 64), k1 = *(const f32x4*)(rp + 2 * TS * 64 + 4);
            const f32x4 q0 = *(const f32x4*)(rp + 3 * TS * 64), q1 = *(const f32x4*)(rp + 3 * TS * 64 + 4);
            const f32x4 b0 = *(const f32x4*)(rp + 4 * TS * 64), b1 = *(const f32x4*)(rp + 4 * TS * 64 + 4);
            const float vv = B[5 * TS * 64 + st * 64 + v];
            float sa = ((s[0] * q0[0] + s[1] * q0[1]) + (s[2] * q0[2] + s[3] * q0[3])) + ((s[4] * q1[0] + s[5] * q1[1]) + (s[6] * q1[2] + s[7] * q1[3]));
            sa = -sum8(sa);
            s[0] = s[0] * w0[0] + sa * b0[0] + vv * k0[0]; s[1] = s[1] * w0[1] + sa * b0[1] + vv * k0[1];
            s[2] = s[2] * w0[2] + sa * b0[2] + vv * k0[2]; s[3] = s[3] * w0[3] + sa * b0[3] + vv * k0[3];
            s[4] = s[4] * w1[0] + sa * b1[0] + vv * k1[0]; s[5] = s[5] * w1[1] + sa * b1[1] + vv * k1[1];
            s[6] = s[6] * w1[2] + sa * b1[2] + vv * k1[2]; s[7] = s[7] * w1[3] + sa * b1[3] + vv * k1[3];
            float y = ((s[0] * r0[0] + s[1] * r0[1]) + (s[2] * r0[2] + s[3] * r0[3])) + ((s[4] * r1[0] + s[5] * r1[1]) + (s[6] * r1[2] + s[7] * r1[3]));
            y = sum8(y);
            if (ks == 0) Y[base + (size_t)(ch * TS + st) * 512 + v] = (bf16_t)f2bf(y);
        }
        if (ch + 1 < NCH) RW_WRITE((ch + 1) & 1);
        __syncthreads();
    }
#undef RW_LOAD
#undef RW_WRITE
}

__device__ __forceinline__ void ml_gates(const Params& p, int n0, int h, float* bcum_s, float* ig_s) {
    if (threadIdx.x < 64) {
        const int lane = threadIdx.x; const float* ifg = (const float*)(p.ws + OFF_IFG);
        const float ig = ifg[(n0 + lane) * 8 + h] + p.in[18][h];
        const float fp = ifg[(n0 + lane) * 8 + 4 + h] + p.in[19][h];
        float c = -softplusf_(-fp);
#pragma unroll
        for (int o = 1; o < 64; o <<= 1) { const float t = __shfl_up(c, o); if (lane >= o) c += t; }
        bcum_s[lane] = c; ig_s[lane] = ig;
    }
}
__device__ __forceinline__ float siluf_(float x) { return x * sigmoidf_(x); }

__device__ __forceinline__ void phase_ml_cloc(const Params& p, float* lds, int first, int stride) {
    float* Ks = lds; float* Vw = Ks + 64 * 128; float* bcum_s = Vw + 64 * 128; float* ig_s = bcum_s + 64; float* wts_s = ig_s + 64;
    const int tid = threadIdx.x;
    const bf16_t* zml = (const bf16_t*)(p.ws + OFF_ZML);
    bf16_t* CLOC = (bf16_t*)(p.ws + OFF_CLOC); float* nloc = (float*)(p.ws + OFF_NLOC); float* gend = (float*)(p.ws + OFF_GEND);
    for (int u = first; u < 1024; u += stride) {
        const int h = u & 3, bc = u >> 2; const int n0 = bc * 64, t0 = (bc & 63) * 64;
        ml_gates(p, n0, h, bcum_s, ig_s);
        __syncthreads();
        const float ge = bcum_s[63];
        if (tid < 64) wts_s[tid] = __expf(ge - bcum_s[tid] + ig_s[tid]);
        if (tid == 0) gend[u] = ge;
        __syncthreads();
        { const int c = tid & 127, sg = tid >> 7; const int hc = h * 128 + c;
          const float w0 = p.in[16][0 * 512 + hc], w1 = p.in[16][1 * 512 + hc], w2 = p.in[16][2 * 512 + hc], w3 = p.in[16][3 * 512 + hc], bk = p.in[17][hc];
          const int s0 = sg * 16; float xm3 = 0.f, xm2 = 0.f, xm1 = 0.f;
          if (t0 + s0 - 3 >= 0) xm3 = bf2f(zml[(size_t)(n0 + s0 - 3) * 2048 + 512 + hc]);
          if (t0 + s0 - 2 >= 0) xm2 = bf2f(zml[(size_t)(n0 + s0 - 2) * 2048 + 512 + hc]);
          if (t0 + s0 - 1 >= 0) xm1 = bf2f(zml[(size_t)(n0 + s0 - 1) * 2048 + 512 + hc]);
#pragma unroll 4
          for (int i = 0; i < 16; ++i) {
              const int s = s0 + i; const float xc = bf2f(zml[(size_t)(n0 + s) * 2048 + 512 + hc]);
              const float a = bk + w0 * xm3 + w1 * xm2 + w2 * xm1 + w3 * xc;
              Ks[s * 128 + c] = siluf_(a) * 0.08838834764831845f;
              xm3 = xm2; xm2 = xm1; xm1 = xc;
              Vw[s * 128 + c] = wts_s[s] * bf2f(zml[(size_t)(n0 + s) * 2048 + 1024 + hc]);
          } }
        __syncthreads();
        { const int v0 = (tid >> 4) * 4, k0 = (tid & 15) * 8;
          float acc[4][8];
#pragma unroll
          for (int i = 0; i < 4; ++i)
#pragma unroll
              for (int j = 0; j < 8; ++j) acc[i][j] = 0.f;
          for (int s = 0; s < 64; ++s) {
              const f32x4 vv = *(const f32x4*)(Vw + s * 128 + v0); const f32x4 ka = *(const f32x4*)(Ks + s * 128 + k0), kb = *(const f32x4*)(Ks + s * 128 + k0 + 4);
#pragma unroll
              for (int i = 0; i < 4; ++i) {
#pragma unroll
                  for (int j = 0; j < 4; ++j) { acc[i][j] += vv[i] * ka[j]; acc[i][4 + j] += vv[i] * kb[j]; } }
          }
#pragma unroll
          for (int i = 0; i < 4; ++i) { u32x4 w; w.x = pk2(acc[i][0], acc[i][1]); w.y = pk2(acc[i][2], acc[i][3]); w.z = pk2(acc[i][4], acc[i][5]); w.w = pk2(acc[i][6], acc[i][7]);
              *(u32x4*)(CLOC + ((size_t)u * 128 + v0 + i) * 128 + k0) = w; }
          if (tid < 128) { float a = 0.f; for (int s = 0; s < 64; ++s) a += wts_s[s] * Ks[s * 128 + tid]; nloc[u * 128 + tid] = a; }
        }
        __syncthreads();
    }
}

__device__ __forceinline__ void phase_ml_scan(const Params& p) {
    bf16_t* CLOC = (bf16_t*)(p.ws + OFF_CLOC); float* nloc = (float*)(p.ws + OFF_NLOC); const float* gend = (const float*)(p.ws + OFF_GEND);
    const int gt = blockIdx.x * 512 + threadIdx.x, nt = gridDim.x * 512;
    for (int task = gt; task < 32768 + 2048; task += nt) {
        if (task < 32768) {
            const int bh = task >> 11, rem = task & 2047; const int b = bh >> 2, h = bh & 3;
            float run[8];
#pragma unroll
            for (int j = 0; j < 8; ++j) run[j] = 0.f;
            for (int c0 = 0; c0 < 64; c0 += 8) {
                u32x4 raw[8]; float g[8];
#pragma unroll
                for (int i = 0; i < 8; ++i) { const int unit = (b * 64 + c0 + i) * 4 + h; raw[i] = *(const u32x4*)(CLOC + (size_t)unit * 16384 + rem * 8); g[i] = __expf(gend[unit]); }
#pragma unroll
                for (int i = 0; i < 8; ++i) { const int unit = (b * 64 + c0 + i) * 4 + h;
                    u32x4 w; w.x = pk2(run[0], run[1]); w.y = pk2(run[2], run[3]); w.z = pk2(run[4], run[5]); w.w = pk2(run[6], run[7]);
                    *(u32x4*)(CLOC + (size_t)unit * 16384 + rem * 8) = w;
                    run[0] = g[i] * run[0] + __uint_as_float(raw[i].x << 16); run[1] = g[i] * run[1] + __uint_as_float(raw[i].x & 0xffff0000u);
                    run[2] = g[i] * run[2] + __uint_as_float(raw[i].y << 16); run[3] = g[i] * run[3] + __uint_as_float(raw[i].y & 0xffff0000u);
                    run[4] = g[i] * run[4] + __uint_as_float(raw[i].z << 16); run[5] = g[i] * run[5] + __uint_as_float(raw[i].z & 0xffff0000u);
                    run[6] = g[i] * run[6] + __uint_as_float(raw[i].w << 16); run[7] = g[i] * run[7] + __uint_as_float(raw[i].w & 0xffff0000u); }
            }
        } else {
            const int t2 = task - 32768; const int bh = t2 >> 7, k = t2 & 127; const int b = bh >> 2, h = bh & 3;
            float run = 0.f;
            for (int c = 0; c < 64; ++c) { const int unit = (b * 64 + c) * 4 + h; const float x = nloc[unit * 128 + k]; nloc[unit * 128 + k] = run; run = __expf(gend[unit]) * run + x; }
        }
    }
}
__device__ __forceinline__ void phase_rwkv_post(const Params& p) {
    bf16_t* Y = (bf16_t*)(p.ws + OFF_Y); const bf16_t* V = (const bf16_t*)(p.ws + OFF_V); const bf16_t* G = (const bf16_t*)((const unsigned char*)p.out + OOF_G);
    const float* bonus = (const float*)(p.ws + OFF_BONUS);
    const int lane = threadIdx.x & 63; const int gw = blockIdx.x * 8 + (threadIdx.x >> 6), nw = gridDim.x * 8;
    for (int pair = gw; pair < NTOK * 8; pair += nw) {
        const int n = pair >> 3, h = pair & 7, hc = h * 64 + lane; const size_t o = (size_t)n * 512 + hc;
        const float y = bf2f(Y[o]); const float mean = wave_sum(y) * (1.f / 64.f); const float d = y - mean; const float var = wave_sum(d * d) * (1.f / 64.f);
        float r = d * (1.f / sqrtf(var + 64e-5f)) * p.in[12][hc] + p.in[13][hc];
        r += bonus[n * 8 + h] * bf2f(V[o]);
        r *= bf2f(G[o]);
        Y[o] = (bf16_t)f2bf(r);
    }
}

__device__ __forceinline__ void phase_ml_out(const Params& p, float* lds) {
    float* Q = lds; float* Kk = Q + 64 * 132; float* Vv = Kk + 64 * 132; float* PT = Vv + 64 * 132;
    bf16_t* Cin = (bf16_t*)(PT + 64 * 68);
    float* bcum_s = (float*)(Cin + 128 * 136); float* ig_s = bcum_s + 64; float* nin_s = ig_s + 64; float* den_s = nin_s + 128;
    const int tid = threadIdx.x;
    const bf16_t* zml = (const bf16_t*)(p.ws + OFF_ZML); const bf16_t* CLOC = (const bf16_t*)(p.ws + OFF_CLOC); const float* nloc = (const float*)(p.ws + OFF_NLOC);
    bf16_t* YML = (bf16_t*)(p.ws + OFF_YML);
    for (int u = blockIdx.x; u < 1024; u += gridDim.x) {
        const int h = u & 3, bc = u >> 2; const int n0 = bc * 64, t0 = (bc & 63) * 64;
        ml_gates(p, n0, h, bcum_s, ig_s);
        { const int c = tid & 127, sg = tid >> 7; const int hc = h * 128 + c;
          const float q0 = p.in[14][0 * 512 + hc], q1 = p.in[14][1 * 512 + hc], q2 = p.in[14][2 * 512 + hc], q3 = p.in[14][3 * 512 + hc], bq = p.in[15][hc];
          const float w0 = p.in[16][0 * 512 + hc], w1 = p.in[16][1 * 512 + hc], w2 = p.in[16][2 * 512 + hc], w3 = p.in[16][3 * 512 + hc], bk = p.in[17][hc];
          const int s0 = sg * 16; float xm3 = 0.f, xm2 = 0.f, xm1 = 0.f, ym3 = 0.f, ym2 = 0.f, ym1 = 0.f;
          if (t0 + s0 - 3 >= 0) { xm3 = bf2f(zml[(size_t)(n0 + s0 - 3) * 2048 + 512 + hc]); ym3 = bf2f(zml[(size_t)(n0 + s0 - 3) * 2048 + hc]); }
          if (t0 + s0 - 2 >= 0) { xm2 = bf2f(zml[(size_t)(n0 + s0 - 2) * 2048 + 512 + hc]); ym2 = bf2f(zml[(size_t)(n0 + s0 - 2) * 2048 + hc]); }
          if (t0 + s0 - 1 >= 0) { xm1 = bf2f(zml[(size_t)(n0 + s0 - 1) * 2048 + 512 + hc]); ym1 = bf2f(zml[(size_t)(n0 + s0 - 1) * 2048 + hc]); }
#pragma unroll 4
          for (int i = 0; i < 16; ++i) {
              const int s = s0 + i; const size_t o = (size_t)(n0 + s) * 2048;
              const float xc = bf2f(zml[o + 512 + hc]), yc = bf2f(zml[o + hc]);
              Kk[s * 132 + c] = siluf_(bk + w0 * xm3 + w1 * xm2 + w2 * xm1 + w3 * xc) * 0.08838834764831845f;
              Q[s * 132 + c] = siluf_(bq + q0 * ym3 + q1 * ym2 + q2 * ym1 + q3 * yc);
              xm3 = xm2; xm2 = xm1; xm1 = xc; ym3 = ym2; ym2 = ym1; ym1 = yc;
              Vv[s * 132 + c] = bf2f(zml[o + 1024 + hc]);
          }
#pragma unroll
          for (int j = 0; j < 4; ++j) { const int idx = tid + 512 * j; const int v = idx >> 4, pc = idx & 15;
              *(u32x4*)(Cin + v * 136 + pc * 8) = *(const u32x4*)(CLOC + ((size_t)u * 128 + v) * 128 + pc * 8); }
          if (tid < 128) nin_s[tid] = nloc[u * 128 + tid];
        }
        __syncthreads();
        {
          const int l = tid >> 3, sq = tid & 7;
          float acc[8];
#pragma unroll
          for (int j = 0; j < 8; ++j) acc[j] = 0.f;
#pragma unroll 2
          for (int k = 0; k < 128; k += 4) {
              const f32x4 q4 = *(const f32x4*)(Q + l * 132 + k);
#pragma unroll
              for (int j = 0; j < 8; ++j) { const f32x4 k4 = *(const f32x4*)(Kk + (sq * 8 + j) * 132 + k); acc[j] += (q4[0] * k4[0] + q4[1] * k4[1]) + (q4[2] * k4[2] + q4[3] * k4[3]); }
          }
          const float bl = bcum_s[l]; float dsum = 0.f;
#pragma unroll
          for (int j = 0; j < 8; ++j) { const int s = sq * 8 + j; const float w = (s <= l) ? acc[j] * __expf(bl - bcum_s[s] + ig_s[s]) : 0.f; PT[s * 68 + l] = w; dsum += w; }
          float qn = 0.f;
#pragma unroll
          for (int j = 0; j < 16; ++j) qn += Q[l * 132 + sq * 16 + j] * nin_s[sq * 16 + j];
          dsum = sum8(dsum); qn = sum8(qn);
          if (sq == 0) den_s[l] = dsum + __expf(bl) * qn;
        }
        __syncthreads();
        { const int l0 = (tid >> 5) * 4, v0 = (tid & 31) * 4;
          float a1[4][4], a2[4][4];
#pragma unroll
          for (int i = 0; i < 4; ++i)
#pragma unroll
              for (int j = 0; j < 4; ++j) { a1[i][j] = 0.f; a2[i][j] = 0.f; }
#pragma unroll 2
          for (int s = 0; s < 64; ++s) {
              const f32x4 pw = *(const f32x4*)(PT + s * 68 + l0); const f32x4 vv = *(const f32x4*)(Vv + s * 132 + v0);
#pragma unroll
              for (int i = 0; i < 4; ++i)
#pragma unroll
                  for (int j = 0; j < 4; ++j) a1[i][j] += pw[i] * vv[j];
          }
#pragma unroll 1
          for (int k = 0; k < 128; k += 4) {
              f32x4 qq[4]; f32x4 cc[4];
#pragma unroll
              for (int i = 0; i < 4; ++i) qq[i] = *(const f32x4*)(Q + (l0 + i) * 132 + k);
#pragma unroll
              for (int j = 0; j < 4; ++j) { const u32x2 raw = *(const u32x2*)(Cin + (v0 + j) * 136 + k);
                  cc[j][0] = __uint_as_float(raw.x << 16); cc[j][1] = __uint_as_float(raw.x & 0xffff0000u); cc[j][2] = __uint_as_float(raw.y << 16); cc[j][3] = __uint_as_float(raw.y & 0xffff0000u); }
#pragma unroll
              for (int i = 0; i < 4; ++i)
#pragma unroll
                  for (int j = 0; j < 4; ++j) a2[i][j] += (qq[i][0] * cc[j][0] + qq[i][1] * cc[j][1]) + (qq[i][2] * cc[j][2] + qq[i][3] * cc[j][3]);
          }
          const int hc = h * 128 + v0;
          const f32x4 nw = *(const f32x4*)(p.in[20] + hc);
#pragma unroll
          for (int i = 0; i < 4; ++i) {
              const int l = l0 + i; const float eb = __expf(bcum_s[l]); const float dn = 1.f / fmaxf(fabsf(den_s[l]), 1.f);
              float hv[4]; float sm = 0.f;
#pragma unroll
              for (int j = 0; j < 4; ++j) { hv[j] = (a1[i][j] + eb * a2[i][j]) * dn; sm += hv[j]; }
#pragma unroll
              for (int o = 1; o < 32; o <<= 1) sm += __shfl_xor(sm, o);
              const float mean = sm * (1.f / 128.f); float sq = 0.f;
#pragma unroll
              for (int j = 0; j < 4; ++j) { hv[j] -= mean; sq += hv[j] * hv[j]; }
#pragma unroll
              for (int o = 1; o < 32; o <<= 1) sq += __shfl_xor(sq, o);
              const float rs = 1.f / sqrtf(sq * (1.f / 128.f) + 1e-5f);
              const u32x2 op = *(const u32x2*)(zml + (size_t)(n0 + l) * 2048 + 1536 + hc);
              const float o0 = hv[0] * rs * nw[0] * sigmoidf_(__uint_as_float(op.x << 16)), o1 = hv[1] * rs * nw[1] * sigmoidf_(__uint_as_float(op.x & 0xffff0000u));
              const float o2 = hv[2] * rs * nw[2] * sigmoidf_(__uint_as_float(op.y << 16)), o3 = hv[3] * rs * nw[3] * sigmoidf_(__uint_as_float(op.y & 0xffff0000u));
              u32x2 w; w.x = pk2(o0, o1); w.y = pk2(o2, o3);
              *(u32x2*)(YML + (size_t)(n0 + l) * 512 + hc) = w;
          }
        }
        __syncthreads();
    }
}

__device__ __forceinline__ void phase_peer_keys(const Params& p, float* lds) {
    bf16_t* Qs = (bf16_t*)lds; bf16_t* SK = Qs + 64 * 136; float* S = (float*)(SK + 128 * 136);
    const int tid = threadIdx.x, lane = tid & 63, wv = tid >> 6, fr = lane & 15, fq = lane >> 4;
    const bf16_t* q = (const bf16_t*)(p.ws + OFF_Q); const bf16_t* skt = (const bf16_t*)(p.ws + OFF_SKT); float* keys = (float*)(p.ws + OFF_KEYS);
    for (int u = blockIdx.x; u < 4096; u += gridDim.x) {
        const int g = u & 15, n0 = (u >> 4) * 64;
#pragma unroll
        for (int j = 0; j < 2; ++j) { const int idx = tid + 512 * j, row = idx >> 4, pc = idx & 15; *(u32x4*)(Qs + row * 136 + pc * 8) = *(const u32x4*)(q + (size_t)(n0 + row) * 2048 + g * 128 + pc * 8); }
#pragma unroll
        for (int j = 0; j < 4; ++j) { const int idx = tid + 512 * j, row = idx >> 4, pc = idx & 15; *(u32x4*)(SK + row * 136 + pc * 8) = *(const u32x4*)(skt + (size_t)(g * 128 + row) * 128 + pc * 8); }
        __syncthreads();
        { const int ti = wv & 3, kj0 = (wv >> 2) * 4;
          f32x4 acc[4];
#pragma unroll
          for (int jj = 0; jj < 4; ++jj) acc[jj] = (f32x4){0.f, 0.f, 0.f, 0.f};
#pragma unroll
          for (int ksp = 0; ksp < 4; ++ksp) {
              const bf16x8 a = *(const bf16x8*)(Qs + (ti * 16 + fr) * 136 + ksp * 32 + fq * 8);
#pragma unroll
              for (int jj = 0; jj < 4; ++jj) { const bf16x8 b = *(const bf16x8*)(SK + ((kj0 + jj) * 16 + fr) * 136 + ksp * 32 + fq * 8); acc[jj] = __builtin_amdgcn_mfma_f32_16x16x32_bf16(a, b, acc[jj], 0, 0, 0); }
          }
#pragma unroll
          for (int jj = 0; jj < 4; ++jj)
#pragma unroll
              for (int r = 0; r < 4; ++r) S[(ti * 16 + fq * 4 + r) * 132 + (kj0 + jj) * 16 + fr] = acc[jj][r];
        }
        __syncthreads();
#pragma unroll 1
        for (int rd = 0; rd < 2; ++rd) {
            const int row = (tid >> 4) + 32 * rd, jj = tid & 15;
            float val[8];
#pragma unroll
            for (int i = 0; i < 8; ++i) { const int key = jj + 16 * i; const unsigned bits = (__float_as_uint(S[row * 132 + key]) & ~127u) | (unsigned)(127 - key); val[i] = __uint_as_float(bits); }
            float res = 0.f;
#pragma unroll 1
            for (int it = 0; it < 16; ++it) {
                float m = fmaxf(fmaxf(fmaxf(val[0], val[1]), fmaxf(val[2], val[3])), fmaxf(fmaxf(val[4], val[5]), fmaxf(val[6], val[7])));
                m = max16(m);
#pragma unroll
                for (int i = 0; i < 8; ++i) val[i] = (val[i] == m) ? -3.0e38f : val[i];
                res = (jj == it) ? m : res;
            }
            keys[((size_t)(n0 + row) * 16 + g) * 16 + jj] = res;
        }
        __syncthreads();
    }
}

__device__ __forceinline__ void phase_peer_gather(const Params& p, float* lds) {
    const int tid = threadIdx.x, lane = tid & 63, wv = tid >> 6;
    int* wl_e = (int*)lds + wv * 256; float* wl_g = (float*)(wl_e + 128);
    const float* keys = (const float*)(p.ws + OFF_KEYS); const float* ss2 = (const float*)(p.ws + OFF_SS2);
    const float* U = p.in[28]; const float* Vt = p.in[29]; const float* g2 = p.in[25]; const float* fg = p.in[30];
    float* out = p.out;
    for (int n = blockIdx.x * 8 + wv; n < NTOK; n += gridDim.x * 8) {
#pragma unroll 1
        for (int rr = 0; rr < 2; ++rr) {
            const int h = rr * 4 + (lane >> 4), jj = lane & 15;
            const float* kp = keys + ((size_t)n * 16 + h * 2) * 16;
            const float k0 = kp[jj], k1own = kp[16 + jj];
            const f32x4 qa = *(const f32x4*)(kp + 16), qb = *(const f32x4*)(kp + 20), qc = *(const f32x4*)(kp + 24), qd = *(const f32x4*)(kp + 28);
            float cand[16];
#pragma unroll
            for (int j = 0; j < 4; ++j) { cand[j] = k0 + qa[j]; cand[4 + j] = k0 + qb[j]; cand[8 + j] = k0 + qc[j]; cand[12 + j] = k0 + qd[j]; }
#pragma unroll
            for (int j = 0; j < 16; ++j) cand[j] = __uint_as_float((__float_as_uint(cand[j]) & ~255u) | (unsigned)(jj * 16 + j));
            float res = 0.f;
#pragma unroll 1
            for (int it = 0; it < 16; ++it) {
                float m = cand[0];
#pragma unroll
                for (int j = 1; j < 16; ++j) m = fmaxf(m, cand[j]);
                m = max16(m);
#pragma unroll
                for (int j = 0; j < 16; ++j) cand[j] = (cand[j] == m) ? -3.0e38f : cand[j];
                res = (jj == it) ? m : res;
            }
            const unsigned code = __float_as_uint(res) & 255u; const int p0 = code >> 4, p1 = code & 15;
            const int i0 = 127 - (int)(__float_as_uint(k0) & 127u), i1 = 127 - (int)(__float_as_uint(k1own) & 127u);
            const int gi0 = __shfl(i0, (lane & 48) + p0), gi1 = __shfl(i1, (lane & 48) + p1);
            const float mx = max16(res); const float ex = __expf(res - mx); const float sm = sum16(ex);
            wl_e[h * 16 + jj] = gi0 * 128 + gi1; wl_g[h * 16 + jj] = ex / sm;
        }
        const float rs2 = 1.f / sqrtf(ss2[n] * (1.f / 1024.f) + 1e-6f);
        f32x4 x1[4], tok[4], acc[4];
#pragma unroll
        for (int i = 0; i < 4; ++i) { x1[i] = ((const f32x4*)(out + (size_t)n * 1024))[lane + 64 * i]; const f32x4 gg = ((const f32x4*)g2)[lane + 64 * i]; tok[i] = x1[i] * rs2 * gg; acc[i] = (f32x4){0.f, 0.f, 0.f, 0.f}; }
#pragma unroll 1
        for (int j0 = 0; j0 < 128; j0 += 4) {
            float dt[4]; int e[4];
#pragma unroll
            for (int q = 0; q < 4; ++q) {
                e[q] = __builtin_amdgcn_readfirstlane(wl_e[j0 + q]);
                const f32x4* ur = (const f32x4*)(U + (size_t)e[q] * 1024); float d = 0.f;
#pragma unroll
                for (int i = 0; i < 4; ++i) { const f32x4 uu = ur[lane + 64 * i]; d += (uu[0] * tok[i][0] + uu[1] * tok[i][1]) + (uu[2] * tok[i][2] + uu[3] * tok[i][3]); }
                dt[q] = d;
            }
#pragma unroll
            for (int q = 0; q < 4; ++q) dt[q] = wave_sum(dt[q]);
#pragma unroll
            for (int q = 0; q < 4; ++q) {
                const float a = 0.5f * dt[q] * (1.f + erff(dt[q] * 0.70710678118f)) * wl_g[j0 + q];
                const f32x4* vr = (const f32x4*)(Vt + (size_t)e[q] * 1024);
#pragma unroll
                for (int i = 0; i < 4; ++i) acc[i] += vr[lane + 64 * i] * a;
            }
        }
        float ss = 0.f;
#pragma unroll
        for (int i = 0; i < 4; ++i) { acc[i] += x1[i]; ss += (acc[i][0] * acc[i][0] + acc[i][1] * acc[i][1]) + (acc[i][2] * acc[i][2] + acc[i][3] * acc[i][3]); }
        ss = wave_sum(ss); const float rs = 1.f / sqrtf(ss * (1.f / 1024.f) + 1e-6f);
#pragma unroll
        for (int i = 0; i < 4; ++i) { const f32x4 gg = ((const f32x4*)fg)[lane + 64 * i]; ((f32x4*)(out + (size_t)n * 1024))[lane + 64 * i] = acc[i] * rs * gg; }
    }
}

extern __shared__ __attribute__((aligned(16))) unsigned char smem[];
__global__ void __launch_bounds__(512, 2) mega_kernel(Params p) {
    cg::grid_group grid = cg::this_grid();
    float* lds = (float*)smem;
    PG8_LAS unsigned char* ldsa = (PG8_LAS unsigned char*)smem;
    unsigned char* ws = p.ws;
    const int G = gridDim.x;
#if PHMASK & 1
    phase0(p, lds);
#endif
    grid.sync();
#if PHMASK & 2
    { pg8::Gemm g{(const bf16_t*)(ws + OFF_XB), (const bf16_t*)(ws + OFF_WINT), NTOK, 5888, 1024}; pg8::StaticOrder S; S.init(NTOK, 5888, G, (int)blockIdx.x);
      EpiZ E{(bf16_t*)(ws + OFF_ZRW), (bf16_t*)(ws + OFF_ZML), (bf16_t*)(ws + OFF_ZG), (const float*)(ws + OFF_RSTD1)};
      pg8::gemm_phase<EpiZ, pg8::StaticOrder>(ldsa, g, S, E, nullptr); }
#endif
    grid.sync();
#if PHMASK & 4
    phase_rwkv_pre(p, lds);
#endif
    grid.sync();
#if PHMASK & 8
    if (blockIdx.x < 32) phase_rwkv_scan(p, lds, blockIdx.x);
#endif
#if PHMASK & 16
    if (blockIdx.x >= 32) phase_ml_cloc(p, lds, blockIdx.x - 32, G - 32);
#endif
    grid.sync();
#if PHMASK & 32
    phase_ml_scan(p);
    phase_rwkv_post(p);
#endif
    grid.sync();
#if PHMASK & 64
    phase_ml_out(p, lds);
#endif
    grid.sync();
#if PHMASK & 128
    { pg8::StaticOrder S; S.init(NTOK, 1024, G, (int)blockIdx.x);
      { pg8::Gemm g{(const bf16_t*)(ws + OFF_Y), (const bf16_t*)(ws + OFF_PRWT), NTOK, 1024, 512};
        EpiMerge1 E{(const bf16_t*)(ws + OFF_ZG), p.in[21], (float*)(ws + OFF_T)};
        pg8::gemm_phase<EpiMerge1, pg8::StaticOrder>(ldsa, g, S, E, nullptr); }
      { pg8::Gemm g{(const bf16_t*)(ws + OFF_YML), (const bf16_t*)(ws + OFF_PMLT), NTOK, 1024, 512};
        EpiMerge2 E{(const bf16_t*)(ws + OFF_ZG), p.in[21], (const float*)(ws + OFF_T), (bf16_t*)(ws + OFF_MERGED)};
        pg8::gemm_phase<EpiMerge2, pg8::StaticOrder>(ldsa, g, S, E, nullptr); } }
#endif
    grid.sync();
#if PHMASK & 256
    { pg8::Gemm g{(const bf16_t*)(ws + OFF_MERGED), (const bf16_t*)(ws + OFF_WOUTT), NTOK, 1024, 1024}; pg8::StaticOrder S; S.init(NTOK, 1024, G, (int)blockIdx.x);
      EpiOut E{p.in[0], p.out, (bf16_t*)(ws + OFF_X1B), (float*)(ws + OFF_SS2)};
      pg8::gemm_phase<EpiOut, pg8::StaticOrder>(ldsa, g, S, E, nullptr); }
#endif
    grid.sync();
#if PHMASK & 512
    { pg8::Gemm g{(const bf16_t*)(ws + OFF_X1B), (const bf16_t*)(ws + OFF_WQT), NTOK, 2048, 1024}; pg8::StaticOrder S; S.init(NTOK, 2048, G, (int)blockIdx.x);
      EpiQ E{(bf16_t*)(ws + OFF_Q), (const float*)(ws + OFF_SS2)};
      pg8::gemm_phase<EpiQ, pg8::StaticOrder>(ldsa, g, S, E, nullptr); }
#endif
    grid.sync();
#if PHMASK & 1024
    phase_peer_keys(p, lds);
#endif
    grid.sync();
#if PHMASK & 2048
    phase_peer_gather(p, lds);
#endif
}

extern "C" void kernel_launch(void* const* d_in, const int* in_sizes, int n_in, void* d_out, int out_size, void* d_ws, size_t ws_size, hipStream_t stream) {
    constexpr size_t kDynLds = 163840;
    static int grid_blocks = 0;
    if (!grid_blocks) {
        int dev = 0, cus = 0, per_cu = 0;
        (void)hipGetDevice(&dev);
        (void)hipDeviceGetAttribute(&cus, hipDeviceAttributeMultiprocessorCount, dev);
        (void)hipFuncSetAttribute((const void*)mega_kernel, hipFuncAttributeMaxDynamicSharedMemorySize, (int)kDynLds);
        (void)hipOccupancyMaxActiveBlocksPerMultiprocessor(&per_cu, mega_kernel, 512, kDynLds);
        if (per_cu < 1) { fprintf(stderr, "occupancy query says %d blocks per CU\n", per_cu); per_cu = 1; }
        if (per_cu > 1) per_cu = 1;
        grid_blocks = cus * per_cu;
        if (ws_size < 256 * MiB) fprintf(stderr, "workspace too small: %zu\n", ws_size);
    }
    Params p{};
    for (int i = 0; i < 31; ++i) p.in[i] = (const float*)d_in[i];
    p.out = (float*)d_out; p.ws = (unsigned char*)d_ws;
    void* args[] = {&p};
    hipError_t e = hipLaunchCooperativeKernel((void*)mega_kernel, dim3(grid_blocks), dim3(512), args, kDynLds, stream);
    if (e != hipSuccess) fprintf(stderr, "cooperative launch failed: %s (grid %d)\n", hipGetErrorString(e), grid_blocks);
}
```

```cpp
#include <hip/hip_runtime.h>
#include <hip/hip_cooperative_groups.h>
#include <cstdio>
namespace cg = cooperative_groups;
#define DUPMASK 0
namespace pg8 {
#define PG8_LAS __attribute__((address_space(3)))
typedef unsigned short bf16_t;
typedef short bf16x8 __attribute__((ext_vector_type(8)));
typedef float f32x4 __attribute__((ext_vector_type(4)));
typedef unsigned u32x4 __attribute__((ext_vector_type(4)));
constexpr int BM = 256, BK = 64, HALF = 128, HTB = HALF * BK * 2  , STAGE_BYTES = 8 * HTB, NXCD = 8, WGM = 4;

__host__ __device__ __forceinline__ int lds_byte(int r, int c) { const int st = (r >> 4) * 2 + (c >> 5), rr = r & 15, cc = c & 31, ob = rr * 64 + cc * 2; return st * 1024 + (ob ^ (((ob >> 9) & 1) << 5)); }
__host__ __device__ __forceinline__ void stage_rc(int b, int& R, int& C) { const int st = b / 1024, sb = b % 1024, swz = sb ^ (((sb >> 9) & 1) << 5); R = (st >> 1) * 16 + swz / 64; C = (st & 1) * 32 + (swz % 64) / 2; }
__host__ __device__ __forceinline__ int perm32(int rho) { const int n = rho >> 4, i = rho & 15; return 8 * (i >> 2) + 4 * n + (i & 3); }

struct Unit { int pm, pn; };
struct Gemm { const bf16_t* A; const bf16_t* Bt; int M, N, K; };

struct StaticOrder {
    int nM, nN, nwg, G, c;
    __host__ __device__ void init(int M, int N, int G_, int c_) { nM = M / BM; nN = N / BM; nwg = nM * nN; G = G_; c = c_; }
    __host__ __device__ bool next(int i, Unit& u) const {
        const long L = (long)i * G + c; if (L >= nwg) return false;
        int wgid = (int)L; { const int q = nwg / NXCD, r = nwg % NXCD, xcd = wgid % NXCD, off = wgid / NXCD; wgid = (xcd < r ? xcd * (q + 1) : r * (q + 1) + (xcd - r) * q) + off; }
        const int nig = WGM * nN, gid = wgid / nig, fm = gid * WGM, gsz = (nM - fm) < WGM ? (nM - fm) : WGM;
        u.pm = fm + ((wgid % nig) % gsz); u.pn = (wgid % nig) / gsz; return true;
    }
    __device__ __forceinline__ void a_ready(const Unit&) const {}
    __device__ __forceinline__ void done(const Unit&) const {}
};
__device__ __forceinline__ unsigned cvt_pk_bf16(float lo, float hi) { unsigned r; asm volatile("v_cvt_pk_bf16_f32 %0, %1, %2" : "=v"(r) : "v"(lo), "v"(hi)); return r; }
typedef float f32x2 __attribute__((ext_vector_type(2)));
template <class Epi, class Sched, bool STAMP = false>
__device__ __forceinline__ void gemm_phase(PG8_LAS unsigned char* lds, const Gemm g, const Sched& S, const Epi& E, unsigned long long* stamps) {
    int tid = threadIdx.x; asm volatile("" : "+v"(tid)); const int wid = __builtin_amdgcn_readfirstlane(tid >> 6), lane = tid & 63, wr = wid >> 2, wc = wid & 3, fr = lane & 15, fq = lane >> 4;
    const int K = g.K, nt = K / BK;
    int ts_lo = 0, ts_hi = 0, nts = 0; const unsigned long long rt_entry = STAMP ? (unsigned long long)wall_clock64() : 0ull;
#define PG8_STAMP() do { if (STAMP && wid == 0 && nts < 64) { const unsigned long long _c = (unsigned long long)clock64(); \
        ts_lo = (lane == nts) ? (int)(unsigned)_c : ts_lo; ts_hi = (lane == nts) ? (int)(unsigned)(_c >> 32) : ts_hi; ++nts; } } while (0)
    PG8_STAMP();
    unsigned voffA[2], voffB[2];
#pragma unroll
    for (int i = 0; i < 2; ++i) { int R, C; stage_rc(tid * 16 + i * 8192, R, C); const int Rb = Epi::PERM ? ((R & ~31) + perm32(R & 31)) : R;
        voffA[i] = (unsigned)(R * K + C) * 2u; voffB[i] = (unsigned)(Rb * K + C) * 2u; }
    const size_t kstep = (size_t)(BK * 2);
    const size_t hstep = (size_t)HALF * K * 2;
    const size_t tstep = 2 * hstep;
    const unsigned ldsw = (unsigned)wid * 1024u;
    const int aoff = lds_byte(wr * 64 + fr, fq * 8), boff = lds_byte(wc * 32 + fr, fq * 8);
#define PG8_SA(b, h) (((b) * 2 + (h)) * HTB)
#define PG8_SB(b, h) ((4 + (b) * 2 + (h)) * HTB)
#define PG8_STAGE(bufoff, gbase, voff) do { _Pragma("unroll") for (int _i = 0; _i < 2; ++_i) \
        __builtin_amdgcn_global_load_lds((const unsigned*)((const char*)(gbase) + (voff)[_i]), (PG8_LAS unsigned*)(lds + (bufoff) + ldsw + _i * 8192), 16, 0, 0); } while (0)
#define PG8_LDA(dst, b, h) do { _Pragma("unroll") for (int m = 0; m < 4; ++m) _Pragma("unroll") for (int k = 0; k < 2; ++k) dst[m][k] = *(const PG8_LAS bf16x8*)(lds + PG8_SA(b, h) + aoff + m * 2048 + k * 1024); } while (0)
#define PG8_LDB(dst, b, h) do { _Pragma("unroll") for (int n = 0; n < 2; ++n) _Pragma("unroll") for (int k = 0; k < 2; ++k) dst[n][k] = *(const PG8_LAS bf16x8*)(lds + PG8_SB(b, h) + boff + n * 2048 + k * 1024); } while (0)
#define PG8_MMA(ai, bj, At, Bt) do { __builtin_amdgcn_s_setprio(1); _Pragma("unroll") for (int m = 0; m < 4; ++m) _Pragma("unroll") for (int n = 0; n < 2; ++n) _Pragma("unroll") for (int k = 0; k < 2; ++k) \
        acc[ai][bj][m][n] = __builtin_amdgcn_mfma_f32_16x16x32_bf16(Bt[n][k], At[m][k], acc[ai][bj][m][n], 0, 0, 0); __builtin_amdgcn_s_setprio(0); } while (0)
#define PG8_WAIT_V(n) asm volatile("s_waitcnt vmcnt(" #n ")" ::: "memory")
#define PG8_WAIT_L(n) asm volatile("s_waitcnt lgkmcnt(" #n ")" ::: "memory")
#define PG8_BAR __builtin_amdgcn_s_barrier()
#define PG8_SCHED __builtin_amdgcn_sched_barrier(0)
    Unit cur, nxt; int ui = 0;
    if (!S.next(0, cur)) return;
    f32x4 acc[2][2][4][2];
#pragma unroll
    for (int a = 0; a < 2; ++a)
#pragma unroll
        for (int b = 0; b < 2; ++b)
#pragma unroll
            for (int m = 0; m < 4; ++m)
#pragma unroll
                for (int n = 0; n < 2; ++n) acc[a][b][m][n] = (f32x4){0.f, 0.f, 0.f, 0.f};
    bf16x8 At[4][2], B0[2][2], B1[2][2];
    const char* cA = (const char*)g.A + (size_t)cur.pm * tstep; const char* cB = (const char*)g.Bt + (size_t)cur.pn * tstep;
    S.a_ready(cur);
    PG8_STAGE(PG8_SB(0, 0), cB, voffB); PG8_STAGE(PG8_SA(0, 0), cA, voffA); PG8_STAGE(PG8_SB(0, 1), cB + hstep, voffB); PG8_STAGE(PG8_SA(0, 1), cA + hstep, voffA);
    if (wr == 1) PG8_BAR;
    PG8_WAIT_V(4); PG8_BAR;
    PG8_STAGE(PG8_SB(1, 0), cB + kstep, voffB); PG8_STAGE(PG8_SA(1, 0), cA + kstep, voffA); PG8_STAGE(PG8_SB(1, 1), cB + hstep + kstep, voffB);
    PG8_WAIT_V(6); PG8_BAR;
    PG8_STAMP();
    for (;;) {
        const bool has_next = S.next(ui + 1, nxt);
        const char* nA = has_next ? (const char*)g.A + (size_t)nxt.pm * tstep : cA; const char* nB = has_next ? (const char*)g.Bt + (size_t)nxt.pn * tstep : cB;
        for (int t = 0; t < nt; t += 2) {
            const bool last = (t == nt - 2);
            const char* a1 = cA + (size_t)(t + 1) * kstep;
            const char* a2 = last ? nA : cA + (size_t)(t + 2) * kstep; const char* b2 = last ? nB : cB + (size_t)(t + 2) * kstep;
            const char* a3 = a2 + kstep; const char* b3 = b2 + kstep;
            if (last && has_next) S.a_ready(nxt);
            PG8_LDB(B0, 0, 0); PG8_SCHED; PG8_LDA(At, 0, 0); PG8_STAGE(PG8_SA(1, 1), a1 + hstep, voffA);
            PG8_WAIT_L(8); PG8_BAR; PG8_WAIT_L(0); PG8_MMA(0, 0, At, B0); PG8_BAR; PG8_SCHED;
            PG8_LDB(B1, 0, 1); PG8_STAGE(PG8_SB(0, 0), b2, voffB);
            PG8_BAR; PG8_WAIT_L(0); PG8_MMA(0, 1, At, B1); PG8_BAR;
            PG8_LDA(At, 0, 1); PG8_STAGE(PG8_SA(0, 0), a2, voffA);
            PG8_BAR; PG8_WAIT_L(0); PG8_MMA(1, 0, At, B0); PG8_BAR; PG8_SCHED;
            PG8_STAGE(PG8_SB(0, 1), b2 + hstep, voffB);
            PG8_WAIT_V(6); PG8_BAR; PG8_MMA(1, 1, At, B1); PG8_BAR;
            PG8_LDB(B0, 1, 0); PG8_SCHED; PG8_LDA(At, 1, 0); PG8_STAGE(PG8_SA(0, 1), a2 + hstep, voffA);
            PG8_WAIT_L(8); PG8_BAR; PG8_WAIT_L(0); PG8_MMA(0, 0, At, B0); PG8_BAR; PG8_SCHED;
            PG8_LDB(B1, 1, 1); PG8_STAGE(PG8_SB(1, 0), b3, voffB);
            PG8_BAR; PG8_WAIT_L(0); PG8_MMA(0, 1, At, B1); PG8_BAR;
            PG8_LDA(At, 1, 1); PG8_STAGE(PG8_SA(1, 0), a3, voffA);
            PG8_BAR; PG8_WAIT_L(0); PG8_MMA(1, 0, At, B0); PG8_BAR; PG8_SCHED;
            PG8_STAGE(PG8_SB(1, 1), b3 + hstep, voffB);
            PG8_WAIT_V(6); PG8_BAR; PG8_MMA(1, 1, At, B1); PG8_BAR;
        }
        PG8_STAMP();
        if constexpr (!Epi::AFTER_DRAIN) { E(acc, cur, wr, wc, fr, fq); S.done(cur); }
        PG8_STAMP();
        if (!has_next) break;
#pragma unroll
        for (int a = 0; a < 2; ++a)
#pragma unroll
            for (int b = 0; b < 2; ++b)
#pragma unroll
                for (int m = 0; m < 4; ++m)
#pragma unroll
                    for (int n = 0; n < 2; ++n) acc[a][b][m][n] = (f32x4){0.f, 0.f, 0.f, 0.f};
        cur = nxt; cA = nA; cB = nB; ++ui;
    }
    PG8_WAIT_V(0);
    if (wr == 0) PG8_BAR;
    PG8_BAR;
    if constexpr (Epi::AFTER_DRAIN) { E.fused(acc, cur, wr, wc, fr, fq, lds, wid, lane); S.done(cur); }
    PG8_STAMP();
    if (STAMP && wid == 0) { stamps[lane] = lane < nts ? (((unsigned long long)(unsigned)ts_hi << 32) | (unsigned)ts_lo) : 0ull;
        if (lane == 62) stamps[62] = rt_entry; if (lane == 63) stamps[63] = (unsigned long long)wall_clock64(); }
#undef PG8_STAMP
#undef PG8_SA
#undef PG8_SB
#undef PG8_STAGE
#undef PG8_LDA
#undef PG8_LDB
#undef PG8_MMA
#undef PG8_WAIT_V
#undef PG8_WAIT_L
#undef PG8_BAR
#undef PG8_SCHED
}
}
#ifndef PHMASK
#define PHMASK 4095
#endif
#ifndef DUPMASK
#define DUPMASK 0
#endif

using pg8::bf16_t; using pg8::bf16x8; using pg8::f32x4; using pg8::u32x4;
#define LAS __attribute__((address_space(3)))
typedef unsigned u32x2 __attribute__((ext_vector_type(2)));

constexpr int NTOK = 16384, DM = 1024, SEQ = 4096;
constexpr size_t MiB = 1ull << 20;
constexpr size_t OFF_RSTD1 = 0, OFF_IFG = 64 * 1024, OFF_SS2 = 576 * 1024, OFF_BONUS = 640 * 1024, OFF_NLOC = 1152 * 1024, OFF_GEND = 1664 * 1024;
constexpr size_t OFF_WINT = 2 * MiB, OFF_PRWT = OFF_WINT + 5888ull * 1024 * 2, OFF_PMLT = OFF_PRWT + MiB, OFF_WOUTT = OFF_PMLT + MiB, OFF_WQT = OFF_WOUTT + 2 * MiB, OFF_SKT = OFF_WQT + 4 * MiB;
static_assert(OFF_SKT + MiB / 2 == 22 * MiB, "weights map");
constexpr size_t OFF_ZRW = 22 * MiB, OFF_ZML = 78 * MiB, OFF_ZG = 142 * MiB, OFF_XB = 206 * MiB;
constexpr size_t OFF_V = 206 * MiB, OFF_G = 222 * MiB;
constexpr size_t OFF_BAR = 1960 * 1024;
constexpr size_t OFF_WUPT = 1700 * 1024, OFF_AUPT = 1764 * 1024, OFF_GUPT = 1828 * 1024;
constexpr size_t OFF_CLOC = 22 * MiB, OFF_Y = 54 * MiB;
constexpr size_t OFF_YML = 206 * MiB, OFF_T = 78 * MiB, OFF_MERGED = 222 * MiB, OFF_X1B = 22 * MiB, OFF_Q = 142 * MiB, OFF_KEYS = 206 * MiB, OFF_U8 = 78 * MiB, OFF_V8 = 94 * MiB, OFF_UINV = 110 * MiB, OFF_SS2P = 111 * MiB, OFF_ACT = 142 * MiB, OFF_EID = 150 * MiB, OFF_ACTIN = 238 * MiB;

struct Params {
    const float* in[31];
    float* out;
    unsigned char* ws;
    int cg_sync;
    int pad;
};

__device__ __forceinline__ int tid_opaque() { int t = threadIdx.x; asm volatile("" : "+v"(t)); return t; }
__device__ __forceinline__ float bf2f(bf16_t v) { return __uint_as_float(((unsigned)v) << 16); }
typedef __bf16 hwbf2 __attribute__((ext_vector_type(2)));
typedef float hwf2 __attribute__((ext_vector_type(2)));
__device__ __forceinline__ unsigned pk2(float lo, float hi) { hwf2 v = {lo, hi}; return __builtin_bit_cast(unsigned, __builtin_convertvector(v, hwbf2)); }
__device__ __forceinline__ unsigned f2bf(float f) { return pk2(f, 0.f) & 0xffffu; }
__device__ __forceinline__ float wave_sum(float v) {
#pragma unroll
    for (int o = 1; o < 64; o <<= 1) v += __shfl_xor(v, o);
    return v;
}
template <int CTRL> __device__ __forceinline__ float dpp_mov(float v) {
    return __builtin_bit_cast(float, __builtin_amdgcn_update_dpp(0, __builtin_bit_cast(int, v), CTRL, 0xf, 0xf, true));
}
__device__ __forceinline__ float sum8(float v) { v += dpp_mov<0xB1>(v); v += dpp_mov<0x4E>(v); v += dpp_mov<0x141>(v); return v; }
__device__ __forceinline__ float sum16(float v) { v = sum8(v); v += dpp_mov<0x140>(v); return v; }
__device__ __forceinline__ float max16(float v) { v = fmaxf(v, dpp_mov<0xB1>(v)); v = fmaxf(v, dpp_mov<0x4E>(v)); v = fmaxf(v, dpp_mov<0x141>(v)); v = fmaxf(v, dpp_mov<0x140>(v)); return v; }
__device__ __forceinline__ int imax16(int v) { v = max(v, __builtin_amdgcn_update_dpp(0, v, 0xB1, 0xf, 0xf, true)); v = max(v, __builtin_amdgcn_update_dpp(0, v, 0x4E, 0xf, 0xf, true)); v = max(v, __builtin_amdgcn_update_dpp(0, v, 0x141, 0xf, 0xf, true)); v = max(v, __builtin_amdgcn_update_dpp(0, v, 0x140, 0xf, 0xf, true)); return v; }
__device__ __forceinline__ int f2key(float f) { const int i = __float_as_int(f); return i ^ ((i >> 31) & 0x7fffffff); }
__device__ __forceinline__ float key2f(int i) { return __int_as_float(i ^ ((i >> 31) & 0x7fffffff)); }
__device__ __forceinline__ float sigmoidf_(float x) { return 1.f / (1.f + __expf(-x)); }
__device__ __forceinline__ float softplusf_(float x) { return fmaxf(x, 0.f) + log1pf(__expf(-fabsf(x))); }

#define BLO(x) __uint_as_float((x) << 16)
#define BHI(x) __uint_as_float((x) & 0xffff0000u)
struct EpiZ {
    static constexpr bool PERM = true, AFTER_DRAIN = false;
    bf16_t* zrw; bf16_t* zml; bf16_t* zg;
    __device__ __forceinline__ void operator()(const f32x4 (&acc)[2][2][4][2], const pg8::Unit& u, int wr, int wc, int fr, int fq) const {
        const int row0 = u.pm * 256 + wr * 64 + fr;
        bf16_t* base; int ldc, colt;
        if (u.pn < 7) { base = zrw; ldc = 1792; colt = u.pn * 256; }
        else if (u.pn < 15) { base = zml; ldc = 2048; colt = (u.pn - 7) * 256; }
        else { base = zg; ldc = 2048; colt = (u.pn - 15) * 256; }
        const int col0 = colt + wc * 32 + 8 * fq;
#pragma unroll
        for (int ai = 0; ai < 2; ++ai)
#pragma unroll
            for (int m = 0; m < 4; ++m) {
                const int row = row0 + ai * 128 + m * 16;
                bf16_t* rowp = base + (size_t)row * ldc + col0;
#pragma unroll
                for (int bj = 0; bj < 2; ++bj) {
                    const f32x4 v0 = acc[ai][bj][m][0], v1 = acc[ai][bj][m][1];
                    u32x4 w; w.x = pg8::cvt_pk_bf16(v0[0], v0[1]); w.y = pg8::cvt_pk_bf16(v0[2], v0[3]); w.z = pg8::cvt_pk_bf16(v1[0], v1[1]); w.w = pg8::cvt_pk_bf16(v1[2], v1[3]);
                    *(u32x4*)(rowp + bj * 128) = w;
                }
            }
    }
};
__device__ __forceinline__ f32x4 sig4(const u32x2 zr, const f32x4 b) {
    f32x4 g; g[0] = __builtin_amdgcn_rcpf(1.f + __expf(-(BLO(zr.x) + b[0]))); g[1] = __builtin_amdgcn_rcpf(1.f + __expf(-(BHI(zr.x) + b[1])));
    g[2] = __builtin_amdgcn_rcpf(1.f + __expf(-(BLO(zr.y) + b[2]))); g[3] = __builtin_amdgcn_rcpf(1.f + __expf(-(BHI(zr.y) + b[3]))); return g;
}
struct EpiMerge1 {
    static constexpr bool PERM = false, AFTER_DRAIN = false;
    const bf16_t* zg; const float* gb; bf16_t* T;
    __device__ __forceinline__ void operator()(const f32x4 (&acc)[2][2][4][2], const pg8::Unit& u, int wr, int wc, int fr, int fq) const {
        const int row0 = u.pm * 256 + wr * 64 + fr, col0 = u.pn * 256 + wc * 32 + 4 * fq;
        f32x4 bv[4];
#pragma unroll
        for (int c = 0; c < 4; ++c) bv[c] = *(const f32x4*)(gb + col0 + (c >> 1) * 128 + (c & 1) * 16);
        u32x2 zc[4], zn[4];
#pragma unroll
        for (int c = 0; c < 4; ++c) zc[c] = *(const u32x2*)(zg + (size_t)row0 * 2048 + col0 + (c >> 1) * 128 + (c & 1) * 16);
#pragma unroll
        for (int g = 0; g < 8; ++g) {
            const int ai = g >> 2, m = g & 3, row = row0 + ai * 128 + m * 16;
            if (g < 7) { const int rn = row0 + ((g + 1) >> 2) * 128 + ((g + 1) & 3) * 16;
#pragma unroll
                for (int c = 0; c < 4; ++c) zn[c] = *(const u32x2*)(zg + (size_t)rn * 2048 + col0 + (c >> 1) * 128 + (c & 1) * 16); }
#pragma unroll
            for (int c = 0; c < 4; ++c) { const f32x4 t = sig4(zc[c], bv[c]) * acc[ai][c >> 1][m][c & 1]; u32x2 w; w.x = pk2(t[0], t[1]); w.y = pk2(t[2], t[3]); *(u32x2*)(T + (size_t)row * 1024 + col0 + (c >> 1) * 128 + (c & 1) * 16) = w; }
#pragma unroll
            for (int c = 0; c < 4; ++c) zc[c] = zn[c];
        }
    }
};
struct EpiMerge2 {
    static constexpr bool PERM = false, AFTER_DRAIN = false;
    const bf16_t* zg; const float* gb; const bf16_t* T; bf16_t* merged;
    __device__ __forceinline__ void operator()(const f32x4 (&acc)[2][2][4][2], const pg8::Unit& u, int wr, int wc, int fr, int fq) const {
        const int row0 = u.pm * 256 + wr * 64 + fr, col0 = u.pn * 256 + wc * 32 + 4 * fq;
        f32x4 bv[4];
#pragma unroll
        for (int c = 0; c < 4; ++c) bv[c] = *(const f32x4*)(gb + 1024 + col0 + (c >> 1) * 128 + (c & 1) * 16);
        u32x2 zc[4], zn[4]; u32x2 tc[4], tn[4];
#pragma unroll
        for (int c = 0; c < 4; ++c) { const int co = col0 + (c >> 1) * 128 + (c & 1) * 16; zc[c] = *(const u32x2*)(zg + (size_t)row0 * 2048 + 1024 + co); tc[c] = *(const u32x2*)(T + (size_t)row0 * 1024 + co); }
#pragma unroll
        for (int g = 0; g < 8; ++g) {
            const int ai = g >> 2, m = g & 3, row = row0 + ai * 128 + m * 16;
            if (g < 7) { const int rn = row0 + ((g + 1) >> 2) * 128 + ((g + 1) & 3) * 16;
#pragma unroll
                for (int c = 0; c < 4; ++c) { const int co = col0 + (c >> 1) * 128 + (c & 1) * 16; zn[c] = *(const u32x2*)(zg + (size_t)rn * 2048 + 1024 + co); tn[c] = *(const u32x2*)(T + (size_t)rn * 1024 + co); } }
#pragma unroll
            for (int c = 0; c < 4; ++c) { const f32x4 tf = (f32x4){BLO(tc[c].x), BHI(tc[c].x), BLO(tc[c].y), BHI(tc[c].y)}; const f32x4 o = tf + sig4(zc[c], bv[c]) * acc[ai][c >> 1][m][c & 1];
                u32x2 w; w.x = pg8::cvt_pk_bf16(o[0], o[1]); w.y = pg8::cvt_pk_bf16(o[2], o[3]);
                *(u32x2*)(merged + (size_t)row * 1024 + col0 + (c >> 1) * 128 + (c & 1) * 16) = w; }
#pragma unroll
            for (int c = 0; c < 4; ++c) { zc[c] = zn[c]; tc[c] = tn[c]; }
        }
    }
};
constexpr int MERGE_PM_OFF = (int)((OFF_YML - OFF_Y) / (256 * 512 * 2)), MERGE_PN_OFF = (int)((OFF_PMLT - OFF_PRWT) / (256 * 512 * 2));
static_assert((size_t)MERGE_PM_OFF * 256 * 512 * 2 == OFF_YML - OFF_Y && (size_t)MERGE_PN_OFF * 256 * 512 * 2 == OFF_PMLT - OFF_PRWT, "merge operand panels");
struct MergeOrder : pg8::StaticOrder {
    __device__ __forceinline__ bool next(int i, pg8::Unit& u) const { if (i >= 2 || !pg8::StaticOrder::next(0, u)) return false; if (i == 1) { u.pm += MERGE_PM_OFF; u.pn += MERGE_PN_OFF; } return true; }
};
struct EpiMerge {
    static constexpr bool PERM = false, AFTER_DRAIN = false;
    EpiMerge1 e1; EpiMerge2 e2;
    __device__ __forceinline__ void operator()(const f32x4 (&acc)[2][2][4][2], const pg8::Unit& u, int wr, int wc, int fr, int fq) const {
        if (u.pm >= MERGE_PM_OFF) { pg8::Unit v; v.pm = u.pm - MERGE_PM_OFF; v.pn = u.pn - MERGE_PN_OFF; e2(acc, v, wr, wc, fr, fq); } else e1(acc, u, wr, wc, fr, fq);
    }
};
struct EpiOut {
    static constexpr bool PERM = false, AFTER_DRAIN = false;
    const float* x; float* x1; bf16_t* x1b; float* ss2;
    __device__ __forceinline__ void operator()(const f32x4 (&acc)[2][2][4][2], const pg8::Unit& u, int wr, int wc, int fr, int fq) const {
        const int row0 = u.pm * 256 + wr * 64 + fr, col0 = u.pn * 256 + wc * 32 + 4 * fq;
        f32x4 xc[4], xn[4];
#pragma unroll
        for (int c = 0; c < 4; ++c) xc[c] = *(const f32x4*)(x + (size_t)row0 * 1024 + col0 + (c >> 1) * 128 + (c & 1) * 16);
#pragma unroll
        for (int g = 0; g < 8; ++g) {
            const int ai = g >> 2, m = g & 3, row = row0 + ai * 128 + m * 16; float s = 0.f;
            if (g < 7) { const int rn = row0 + ((g + 1) >> 2) * 128 + ((g + 1) & 3) * 16;
#pragma unroll
                for (int c = 0; c < 4; ++c) xn[c] = *(const f32x4*)(x + (size_t)rn * 1024 + col0 + (c >> 1) * 128 + (c & 1) * 16); }
#pragma unroll
            for (int c = 0; c < 4; ++c) { const int col = col0 + (c >> 1) * 128 + (c & 1) * 16;
                const f32x4 o = xc[c] + acc[ai][c >> 1][m][c & 1];
                u32x2 w; w.x = pg8::cvt_pk_bf16(o[0], o[1]); w.y = pg8::cvt_pk_bf16(o[2], o[3]);
                *(u32x2*)(x1b + (size_t)row * 1024 + col) = w;
                s += (o[0] * o[0] + o[1] * o[1]) + (o[2] * o[2] + o[3] * o[3]); }
            s += __shfl_xor(s, 16); s += __shfl_xor(s, 32);
            if (fq == 0) ss2[(size_t)(u.pn * 4 + wc) * NTOK + row] = s;
#pragma unroll
            for (int c = 0; c < 4; ++c) xc[c] = xn[c];
        }
    }
};
struct EpiQ {
    static constexpr bool PERM = true, AFTER_DRAIN = false;
    bf16_t* q;
    __device__ __forceinline__ void operator()(const f32x4 (&acc)[2][2][4][2], const pg8::Unit& u, int wr, int wc, int fr, int fq) const {
        const int row0 = u.pm * 256 + wr * 64 + fr, col0 = u.pn * 256 + wc * 32 + 8 * fq;
#pragma unroll
        for (int ai = 0; ai < 2; ++ai)
#pragma unroll
            for (int m = 0; m < 4; ++m) {
                const int row = row0 + ai * 128 + m * 16;
                bf16_t* rowp = q + (size_t)row * 2048 + col0;
#pragma unroll
                for (int bj = 0; bj < 2; ++bj) {
                    const f32x4 v0 = acc[ai][bj][m][0], v1 = acc[ai][bj][m][1];
                    u32x4 w; w.x = pg8::cvt_pk_bf16(v0[0], v0[1]); w.y = pg8::cvt_pk_bf16(v0[2], v0[3]); w.z = pg8::cvt_pk_bf16(v1[0], v1[1]); w.w = pg8::cvt_pk_bf16(v1[2], v1[3]);
                    *(u32x4*)(rowp + bj * 128) = w;
                }
            }
    }
};

#define P0_LOAD(dstv, tt) do { if ((tt) < ntiles) { const int kb_ = (tt) / NT, nb_ = (tt) - kb_ * NT; const int n_ = nb_ * 64 + nl, col_ = n_ >= sf ? n_ + sk : n_; \
        _Pragma("unroll") for (int i = 0; i < 8; ++i) { const int k_ = kb_ * 64 + kl0 + 8 * i; float v_ = src[(size_t)k_ * ld + col_]; if (ks) v_ *= ks[k_]; dstv[i] = v_; } } } while (0)
__device__ __forceinline__ void p0_matrix(const float* src, int ld, int K, bf16_t* dst, const float* ks, int sf, int sk, int NT, int ntiles, int start, int step, float* lds, int tid) {
    const int nl = tid & 63, kl0 = tid >> 6;
    float cur[8], n1[8], n2[8];
    int t = start;
    P0_LOAD(cur, t); P0_LOAD(n1, t + step);
    for (; t < ntiles; t += step) {
        P0_LOAD(n2, t + 2 * step);
#pragma unroll
        for (int i = 0; i < 8; ++i) lds[(kl0 + 8 * i) * 65 + nl] = cur[i];
        __syncthreads();
        { const int kb = t / NT, nb = t - kb * NT; const int n = tid & 63, kc = tid >> 6; const float* c0 = lds + (kc * 8) * 65 + n;
          u32x4 w; w.x = pk2(c0[0], c0[65]); w.y = pk2(c0[130], c0[195]); w.z = pk2(c0[260], c0[325]); w.w = pk2(c0[390], c0[455]);
          *(u32x4*)(dst + (size_t)(nb * 64 + n) * K + kb * 64 + kc * 8) = w; }
        __syncthreads();
#pragma unroll
        for (int i = 0; i < 8; ++i) { cur[i] = n1[i]; n1[i] = n2[i]; }
    }
}
#undef P0_LOAD
__device__ __forceinline__ void phase0(const Params& p, float* lds) {
    unsigned char* ws = p.ws;
    const int tid = tid_opaque();
    float* TB = lds;
    float* GW = lds + 4224;
    { const float* w_in = p.in[2]; const float* g1 = p.in[1];
      for (int i = tid; i < 8192; i += 512) { const int c = i >> 10, k = i & 1023; GW[i] = w_in[(size_t)k * 5896 + 3840 + c] * g1[k]; } }
    __syncthreads();
    const int wave = tid >> 6, lane = tid & 63;
    float* rstd1 = (float*)(ws + OFF_RSTD1); float* ifg = (float*)(ws + OFF_IFG); bf16_t* xb = (bf16_t*)(ws + OFF_XB);
    int row = blockIdx.x * 8 + wave; const int rstep = gridDim.x * 8;
    f32x4 v[4], vn[4];
#define P0_ROWLD(dstv, rr) do { if ((rr) < NTOK) { _Pragma("unroll") for (int jx = 0; jx < 4; ++jx) dstv[jx] = ((const f32x4*)(p.in[0] + (size_t)(rr) * 1024))[lane + 64 * jx]; } } while (0)
#define P0_ROWPROC() do { if (row < NTOK) { \
        float d[9]; _Pragma("unroll") for (int c = 0; c < 9; ++c) d[c] = 0.f; \
        _Pragma("unroll") for (int jx = 0; jx < 4; ++jx) { \
            d[8] += (v[jx][0] * v[jx][0] + v[jx][1] * v[jx][1]) + (v[jx][2] * v[jx][2] + v[jx][3] * v[jx][3]); \
            _Pragma("unroll") for (int c = 0; c < 8; ++c) { const f32x4 w = *(const f32x4*)(GW + c * 1024 + (lane + 64 * jx) * 4); d[c] += (v[jx][0] * w[0] + v[jx][1] * w[1]) + (v[jx][2] * w[2] + v[jx][3] * w[3]); } } \
        _Pragma("unroll") for (int o = 1; o < 64; o <<= 1) { _Pragma("unroll") for (int c = 0; c < 9; ++c) d[c] += __shfl_xor(d[c], o); } \
        const float rs = __builtin_amdgcn_rsqf(d[8] * (1.f / 1024.f) + 1e-6f); \
        if (lane == 0) rstd1[row] = rs; \
        _Pragma("unroll") for (int jx = 0; jx < 4; ++jx) { u32x2 o; o.x = pk2(v[jx][0] * rs, v[jx][1] * rs); o.y = pk2(v[jx][2] * rs, v[jx][3] * rs); ((u32x2*)(xb + (size_t)row * 1024))[lane + 64 * jx] = o; } \
        float mine = d[0]; _Pragma("unroll") for (int c = 1; c < 8; ++c) mine = (lane == c) ? d[c] : mine; \
        if (lane < 8) ifg[row * 8 + lane] = mine * rs; \
        _Pragma("unroll") for (int jx = 0; jx < 4; ++jx) v[jx] = vn[jx]; \
        P0_ROWLD(vn, row + 2 * rstep); row += rstep; } } while (0)
    P0_ROWLD(v, row); P0_ROWLD(vn, row + rstep);
    { const float* src = p.in[2]; const float* ks = p.in[1]; bf16_t* dst = (bf16_t*)(ws + OFF_WINT);
      const int ld = 5896, K = 1024, sf = 3840, sk = 8, NT = 92, ntiles = 1472, step = gridDim.x;
      const int nl = tid & 63, kl0 = tid >> 6;
      float cur[8], n1[8];
#define P0_LOAD(dstv, tt) do { if ((tt) < ntiles) { const int kb_ = (tt) / NT, nb_ = (tt) - kb_ * NT; const int n_ = nb_ * 64 + nl, col_ = n_ >= sf ? n_ + sk : n_; \
        _Pragma("unroll") for (int i = 0; i < 8; ++i) { const int k_ = kb_ * 64 + kl0 + 8 * i; dstv[i] = src[(size_t)k_ * ld + col_] * ks[k_]; } } } while (0)
      int t = blockIdx.x;
      P0_LOAD(cur, t);
      for (; t < ntiles; t += step) {
          P0_LOAD(n1, t + step);
#pragma unroll
          for (int i = 0; i < 8; ++i) TB[(kl0 + 8 * i) * 65 + nl] = cur[i];
          __syncthreads();
          { const int kb = t / NT, nb = t - kb * NT; const int n = tid & 63, kc = tid >> 6; const float* c0 = TB + (kc * 8) * 65 + n;
            u32x4 w; w.x = pk2(c0[0], c0[65]); w.y = pk2(c0[130], c0[195]); w.z = pk2(c0[260], c0[325]); w.w = pk2(c0[390], c0[455]);
            *(u32x4*)(dst + (size_t)(nb * 64 + n) * K + kb * 64 + kc * 8) = w; }
          P0_ROWPROC();
          __syncthreads();
          P0_ROWPROC();
#pragma unroll
          for (int i = 0; i < 8; ++i) cur[i] = n1[i];
      }
#undef P0_LOAD
    }
    while (__any(row < NTOK)) P0_ROWPROC();
#undef P0_ROWPROC
#undef P0_ROWLD
    __syncthreads();
    { const int G = gridDim.x, bx = blockIdx.x;
      p0_matrix(p.in[5], 512, 64, (bf16_t*)(ws + OFF_WUPT), nullptr, 1 << 30, 0, 8, 8, (bx + 64) % G, G, TB, tid);
      p0_matrix(p.in[7], 512, 64, (bf16_t*)(ws + OFF_AUPT), nullptr, 1 << 30, 0, 8, 8, (bx + 56) % G, G, TB, tid);
      p0_matrix(p.in[8], 512, 128, (bf16_t*)(ws + OFF_GUPT), nullptr, 1 << 30, 0, 8, 16, (bx + 40) % G, G, TB, tid); }
    { bf16_t* skt = (bf16_t*)(ws + OFF_SKT); const float* sk = p.in[27];
      for (int i = blockIdx.x * 512 + tid; i < 262144; i += gridDim.x * 512) skt[i] = (bf16_t)f2bf(sk[i]); }
}

constexpr int LDT = 72;
constexpr int SLOT = 64 * LDT * 2;
typedef float f32x16 __attribute__((ext_vector_type(16)));
#define MFMA16(a, b, c) __builtin_amdgcn_mfma_f32_16x16x32_bf16((a), (b), (c), 0, 0, 0)
#define MFMA32(a, b, c) __builtin_amdgcn_mfma_f32_32x32x16_bf16((a), (b), (c), 0, 0, 0)
__device__ __forceinline__ bf16x8 lds_frag(const bf16_t* M, int row0, int k0, int lane) { return *(const bf16x8*)(M + (row0 + (lane & 15)) * LDT + k0 + (lane >> 4) * 8); }
__device__ __forceinline__ f32x4 mm64(const bf16_t* P, const bf16_t* Q, int pt, int qt, f32x4 acc, int lane) {
#pragma unroll
    for (int k0 = 0; k0 < 64; k0 += 32) { const bf16x8 a = lds_frag(Q, qt * 16, k0, lane), b = lds_frag(P, pt * 16, k0, lane); acc = MFMA16(a, b, acc); }
    return acc;
}
__device__ __forceinline__ void st_tile(bf16_t* Z, int pt, int qt, const f32x4 v, int lane) {
    u32x2 w; w.x = pk2(v[0], v[1]); w.y = pk2(v[2], v[3]);
    *(u32x2*)(Z + (pt * 16 + (lane & 15)) * LDT + qt * 16 + (lane >> 4) * 4) = w;
}
__device__ __forceinline__ void st_tile_T(bf16_t* ZT, int pt, int qt, const f32x4 v, int lane) {
#pragma unroll
    for (int j = 0; j < 4; ++j) ZT[(qt * 16 + (lane >> 4) * 4 + j) * LDT + pt * 16 + (lane & 15)] = (bf16_t)f2bf(v[j]);
}
__device__ __forceinline__ f32x4 ld4bf(const bf16_t* p) { const u32x2 r = *(const u32x2*)p; f32x4 o; o[0] = __uint_as_float(r.x << 16); o[1] = __uint_as_float(r.x & 0xffff0000u); o[2] = __uint_as_float(r.y << 16); o[3] = __uint_as_float(r.y & 0xffff0000u); return o; }

#ifndef STAMP_SEL
#define STAMP_SEL 0
#endif
#define TSTAMP(k) do { if (STAMP_SEL) { const unsigned long long _t = __builtin_amdgcn_s_memrealtime(); if (STAMP_SEL == (k)) tacc += (unsigned)(_t - tlast); tlast = _t; } } while (0)
__device__ __forceinline__ void phase_rwkv_prep(const Params& p, unsigned char* smem_, unsigned& tacc) {
    unsigned long long tlast = 0;
    int tidv = threadIdx.x;
#define RETID() asm volatile("" : "+v"(tidv))
#define tid tidv
#define lane (tidv & 63)
#define wv (tidv >> 6)
#define fr (tidv & 15)
#define fq ((tidv >> 4) & 3)
#define SL(i) ((bf16_t*)(smem_ + (i) * SLOT))
    float* part = (float*)(smem_ + 17 * SLOT);
    float* gl_s = part + 512;
    bf16_t* RKV = SL(2);
    const bf16_t* zrw = (const bf16_t*)(p.ws + OFF_ZRW);
    bf16_t* Vg = (bf16_t*)(p.ws + OFF_V); bf16_t* Gg = (bf16_t*)(p.ws + OFF_G); float* bonus = (float*)(p.ws + OFF_BONUS);
    const bf16_t* WupT = (const bf16_t*)(p.ws + OFF_WUPT); const bf16_t* AupT = (const bf16_t*)(p.ws + OFF_AUPT); const bf16_t* GupT = (const bf16_t*)(p.ws + OFF_GUPT);
    bf16_t* FR = (bf16_t*)p.out;
    const float* mu = p.in[3];
    u32x4 zc[4], zp[4], zq[4];
#define RW_ISSUE(uu) do { const int h_ = (uu) & 7, bc_ = (uu) >> 3, n0_ = bc_ * 64, t0_ = (bc_ & 63) * 64; \
        _Pragma("unroll") for (int j = 0; j < 4; ++j) { const int task = tid + 512 * j, t = task >> 5, cg = task & 31; \
            if (h_ == 0) { const bf16_t* src = zrw + (size_t)(n0_ + t) * 1792 + 1536 + cg * 8; zc[j] = *(const u32x4*)src; \
                zp[j] = (t0_ + t > 0) ? *(const u32x4*)(src - 1792) : (u32x4){0u, 0u, 0u, 0u}; } \
            else zc[j] = *(const u32x4*)(actin + ((size_t)(bc_ * 64 + t) * 256 + cg * 8)); \
            const int i = task / 24, rem = task - i * 24; \
            zq[j] = (task < 1560 && t0_ + i > 0) ? *(const u32x4*)(zrw + (size_t)(n0_ + i - 1) * 1792 + (rem >> 3) * 512 + h_ * 64 + (rem & 7) * 8) : (u32x4){0u, 0u, 0u, 0u}; } } while (0)
    bf16_t* actin = (bf16_t*)(p.ws + OFF_ACTIN);
    int hcur = -1; bf16x8 wfw[2][2], wfa[2][2], wfg[2][4];
    float w0c = 0.f, a0c = 0.f, kkc = 0.f, kac = 0.f, rkc = 0.f, mur = 0.f, muk = 0.f, muv = 0.f;
    if (blockIdx.x < 256) RW_ISSUE(blockIdx.x * 8);
    for (int kk_ = 0; (int)blockIdx.x + (kk_ >> 3) * (int)gridDim.x < 256; ++kk_) {
        const int u = ((int)blockIdx.x + (kk_ >> 3) * (int)gridDim.x) * 8 + (kk_ & 7);
        const int un = ((int)blockIdx.x + ((kk_ + 1) >> 3) * (int)gridDim.x) * 8 + ((kk_ + 1) & 7);
        const int h = u & 7, bc = u >> 3; const int n0 = bc * 64, t0 = (bc & 63) * 64;
        const int hc = h * 64 + lane;
        if (h != hcur) { hcur = h; w0c = p.in[4][hc]; a0c = p.in[6][hc]; kkc = p.in[9][hc]; kac = p.in[10][hc]; rkc = p.in[11][hc]; mur = mu[hc]; muk = mu[512 + hc]; muv = mu[1024 + hc]; }
#pragma unroll
        for (int q = 0; q < 2; ++q) { const int qt = (wv * 2 + q) & 3;
#pragma unroll
            for (int ks = 0; ks < 2; ++ks) { wfw[q][ks] = *(const bf16x8*)(WupT + (size_t)(h * 64 + qt * 16 + fr) * 64 + ks * 32 + fq * 8); wfa[q][ks] = *(const bf16x8*)(AupT + (size_t)(h * 64 + qt * 16 + fr) * 64 + ks * 32 + fq * 8); }
#pragma unroll
            for (int ks = 0; ks < 4; ++ks) wfg[q][ks] = *(const bf16x8*)(GupT + (size_t)(h * 64 + qt * 16 + fr) * 128 + ks * 32 + fq * 8); }
        TSTAMP(0);
        RETID();
        { bf16_t* INW = SL(8); bf16_t* INA = SL(9); bf16_t* ING = SL(10);
#pragma unroll
          for (int j = 0; j < 4; ++j) { const int task = tid + 512 * j, t = task >> 5, cg = task & 31;
              u32x4 w;
              if (h == 0) {
              const f32x4 m0 = *(const f32x4*)(mu + 1536 + cg * 8), m1 = *(const f32x4*)(mu + 1536 + cg * 8 + 4);
              float z[8];
              z[0] = BLO(zc[j].x) + (BLO(zp[j].x) - BLO(zc[j].x)) * m0[0]; z[1] = BHI(zc[j].x) + (BHI(zp[j].x) - BHI(zc[j].x)) * m0[1];
              z[2] = BLO(zc[j].y) + (BLO(zp[j].y) - BLO(zc[j].y)) * m0[2]; z[3] = BHI(zc[j].y) + (BHI(zp[j].y) - BHI(zc[j].y)) * m0[3];
              z[4] = BLO(zc[j].z) + (BLO(zp[j].z) - BLO(zc[j].z)) * m1[0]; z[5] = BHI(zc[j].z) + (BHI(zp[j].z) - BHI(zc[j].z)) * m1[1];
              z[6] = BLO(zc[j].w) + (BLO(zp[j].w) - BLO(zc[j].w)) * m1[2]; z[7] = BHI(zc[j].w) + (BHI(zp[j].w) - BHI(zc[j].w)) * m1[3];
              if (cg < 8) {
#pragma unroll
                  for (int e = 0; e < 8; ++e) z[e] = 1.f - 2.f * __builtin_amdgcn_rcpf(1.f + __expf(2.f * z[e]));
              } else if (cg >= 16) {
#pragma unroll
                  for (int e = 0; e < 8; ++e) z[e] = __builtin_amdgcn_rcpf(1.f + __expf(-z[e]));
              }
              w.x = pk2(z[0], z[1]); w.y = pk2(z[2], z[3]); w.z = pk2(z[4], z[5]); w.w = pk2(z[6], z[7]);
              *(u32x4*)(actin + ((size_t)(bc * 64 + t) * 256 + cg * 8)) = w;
              } else w = zc[j];
              bf16_t* d = cg < 8 ? INW + t * LDT + cg * 8 : (cg < 16 ? INA + t * LDT + (cg - 8) * 8 : ING + t * 136 + (cg - 16) * 8);
              *(u32x4*)d = w;
              if (task < 1560) { const int i = task / 24, rem = task - i * 24; *(u32x4*)(RKV + i * 200 + (rem >> 3) * 64 + (rem & 7) * 8) = zq[j]; } } }
        if (h == 0) asm volatile("s_waitcnt vmcnt(0)" ::: "memory");
        __syncthreads();
        { float* LW = (float*)SL(12); float* LA = (float*)SL(14); float* LG = (float*)SL(0);
#pragma unroll
          for (int q = 0; q < 2; ++q) { const int pos = wv * 2 + q, pt = pos >> 2, qt = pos & 3;
              f32x4 aw = (f32x4){0.f, 0.f, 0.f, 0.f}, aa = aw, ag = aw;
#pragma unroll
              for (int ks = 0; ks < 2; ++ks) { aw = MFMA16(wfw[q][ks], lds_frag(SL(8), pt * 16, ks * 32, lane), aw); aa = MFMA16(wfa[q][ks], lds_frag(SL(9), pt * 16, ks * 32, lane), aa); }
#pragma unroll
              for (int ks = 0; ks < 4; ++ks) ag = MFMA16(wfg[q][ks], *(const bf16x8*)(SL(10) + (pt * 16 + fr) * 136 + ks * 32 + fq * 8), ag);
              *(f32x4*)(LW + (pt * 16 + fr) * 68 + qt * 16 + fq * 4) = aw; *(f32x4*)(LA + (pt * 16 + fr) * 68 + qt * 16 + fq * 4) = aa; *(f32x4*)(LG + (pt * 16 + fr) * 68 + qt * 16 + fq * 4) = ag; } }
        __syncthreads();
        TSTAMP(1);
        RETID();
        { const float* LW = (const float*)SL(12); const float* LA = (const float*)SL(14); const float* LG = (const float*)SL(0);
          float rr[8], km[8], vv[8], kk[8], bb[8], ld[8], cl[8], gg[8], bn[8], n2[8];
          float run = 0.f;
          { float zrp = bf2f(RKV[(wv * 8) * 200 + lane]), zkp = bf2f(RKV[(wv * 8) * 200 + 64 + lane]), zvp = bf2f(RKV[(wv * 8) * 200 + 128 + lane]);
#pragma unroll
            for (int i = 0; i < 8; ++i) {
                const int t = wv * 8 + i;
                const float zr = bf2f(RKV[(t + 1) * 200 + lane]), zk = bf2f(RKV[(t + 1) * 200 + 64 + lane]), zv = bf2f(RKV[(t + 1) * 200 + 128 + lane]);
                const float r = zr + (zrp - zr) * mur, k = zk + (zkp - zk) * muk, v = zv + (zvp - zv) * muv;
                zrp = zr; zkp = zk; zvp = zv;
                const float lw = w0c + LW[t * 68 + lane];
                const float sp = fmaxf(-lw, 0.f) + __logf(1.f + __expf(-fabsf(lw)));
                const float logdec = -__expf(-sp - 0.5f);
                const float a = __builtin_amdgcn_rcpf(1.f + __expf(-(a0c + LA[t * 68 + lane])));
                const float kx = k * kkc; const float kmod = k * (1.f + (a - 1.f) * kac);
                n2[i] = kx * kx; bn[i] = r * kmod * rkc;
                rr[i] = r; km[i] = kmod; vv[i] = v; kk[i] = kx; bb[i] = a; ld[i] = logdec; run += logdec; cl[i] = run; gg[i] = LG[t * 68 + lane];
            } }
#pragma unroll
          for (int o = 1; o < 64; o <<= 1) {
#pragma unroll
              for (int i = 0; i < 8; ++i) { n2[i] += __shfl_xor(n2[i], o); bn[i] += __shfl_xor(bn[i], o); } }
#pragma unroll
          for (int i = 0; i < 8; ++i) { const int n = n0 + wv * 8 + i;
              kk[i] = kk[i] * __builtin_amdgcn_rcpf(fmaxf(sqrtf(n2[i]), 1e-12f)); bb[i] = kk[i] * bb[i];
              Vg[(size_t)n * 512 + hc] = (bf16_t)f2bf(vv[i]); Gg[(size_t)n * 512 + hc] = (bf16_t)f2bf(gg[i]);
              if (lane == 0) bonus[n * 8 + h] = bn[i]; }
          part[wv * 64 + lane] = run;
          __syncthreads();
          float off = 0.f, tot = 0.f;
#pragma unroll
          for (int g = 0; g < 8; ++g) { const float x = part[g * 64 + lane]; tot += x; off += (g < wv) ? x : 0.f; }
          if (wv == 0) gl_s[lane] = __expf(tot);
          unsigned pkT[4][4];
          float prevv[4];
#pragma unroll
          for (int i = 0; i < 8; ++i) {
              const int t = wv * 8 + i; const float cum = off + cl[i];
              const float ein = __expf(cum), eout = __expf(-cum), eex = __expf(cum - ld[i]), erem = __expf(tot - cum);
              const float kap = kk[i] * eex, bet = bb[i] * eout, kt = km[i] * eout, rt = rr[i] * ein, betp = bb[i] * erem, ktp = km[i] * erem;
              SL(0)[t * LDT + lane] = (bf16_t)f2bf(kap); SL(1)[t * LDT + lane] = (bf16_t)f2bf(bet); SL(2)[t * LDT + lane] = (bf16_t)f2bf(kt); SL(3)[t * LDT + lane] = (bf16_t)f2bf(rt);
              if (i & 1) { pkT[0][i >> 1] = pk2(prevv[0], kap); pkT[1][i >> 1] = pk2(prevv[1], betp); pkT[2][i >> 1] = pk2(prevv[2], ktp); pkT[3][i >> 1] = pk2(prevv[3], vv[i]); }
              else { prevv[0] = kap; prevv[1] = betp; prevv[2] = ktp; prevv[3] = vv[i]; }
          }
#pragma unroll
          for (int a = 0; a < 4; ++a) { u32x4 w; w.x = pkT[a][0]; w.y = pkT[a][1]; w.z = pkT[a][2]; w.w = pkT[a][3]; *(u32x4*)(SL(4 + a) + lane * LDT + wv * 8) = w; }
        }
        __syncthreads();
        TSTAMP(2);
        RETID();
        if (un < 2048) RW_ISSUE(un);
        f32x4 Tacc[2];
#pragma unroll
        for (int q = 0; q < 2; ++q) {
            const int pos = wv * 2 + q, pt = pos >> 2, qt = pos & 3;
            const int t = pt * 16 + fr, s0 = qt * 16 + fq * 4;
            const f32x4 z = (f32x4){0.f, 0.f, 0.f, 0.f};
            f32x4 abk = mm64(SL(0), SL(1), pt, qt, z, lane), akk = mm64(SL(0), SL(2), pt, qt, z, lane), akr = mm64(SL(3), SL(2), pt, qt, z, lane), abr = mm64(SL(3), SL(1), pt, qt, z, lane);
            f32x4 t0v;
#pragma unroll
            for (int j = 0; j < 4; ++j) { const int s = s0 + j; const bool lo = s < t, le = s <= t;
                abk[j] = lo ? -abk[j] : 0.f; akk[j] = lo ? akk[j] : 0.f; akr[j] = le ? akr[j] : 0.f; abr[j] = le ? abr[j] : 0.f; t0v[j] = abk[j] + (s == t ? 1.f : 0.f); }
            st_tile(SL(8), pt, qt, akk, lane); st_tile(SL(9), pt, qt, akr, lane); st_tile(SL(10), pt, qt, abr, lane);
            st_tile(SL(11), pt, qt, abk, lane); st_tile_T(SL(12), pt, qt, abk, lane); st_tile(SL(13), pt, qt, t0v, lane);
            Tacc[q] = t0v;
        }
        __syncthreads();
        TSTAMP(3);
        RETID();
#pragma unroll 1
        for (int lv = 0; lv < 5; ++lv) {
            const int ib = (lv & 1) ? 0 : 11, ob = (lv & 1) ? 11 : 0;
            const bf16_t* Pc = SL(ib); const bf16_t* Pt = SL(ib + 1); const bf16_t* Tin = SL(ib + 2);
            bf16_t* Pco = SL(ob); bf16_t* Pto = SL(ob + 1); bf16_t* Tout = SL(ob + 2);
#pragma unroll
            for (int q = 0; q < 2; ++q) { const int pos = wv * 2 + q, pt = pos >> 2, qt = pos & 3;
                const f32x4 pn = mm64(Pc, Pt, pt, qt, (f32x4){0.f, 0.f, 0.f, 0.f}, lane);
                st_tile(Pco, pt, qt, pn, lane); st_tile_T(Pto, pt, qt, pn, lane); }
            __syncthreads();
#pragma unroll
            for (int q = 0; q < 2; ++q) { const int pos = wv * 2 + q, pt = pos >> 2, qt = pos & 3;
                Tacc[q] = mm64(Tin, Pto, pt, qt, Tacc[q], lane);
                st_tile(Tout, pt, qt, Tacc[q], lane); }
            __syncthreads();
        }
        TSTAMP(4);
        RETID();
#pragma unroll
        for (int q = 0; q < 2; ++q) { const int pos = wv * 2 + q, pt = pos >> 2, qt = pos & 3; const f32x4 z = (f32x4){0.f, 0.f, 0.f, 0.f};
            st_tile(SL(14), pt, qt, mm64(SL(7), SL(8), pt, qt, z, lane), lane);
            st_tile(SL(15), pt, qt, mm64(SL(4), SL(2), pt, qt, z, lane), lane); }
        __syncthreads();
#pragma unroll
        for (int q = 0; q < 2; ++q) { const int pos = wv * 2 + q, pt = pos >> 2, qt = pos & 3;
            const f32x4 r = mm64(SL(14), SL(2), pt, qt, (f32x4){0.f, 0.f, 0.f, 0.f}, lane);
            st_tile(SL(16), pt, qt, -r, lane); }
        __syncthreads();
#pragma unroll
        for (int q = 0; q < 2; ++q) { const int pos = wv * 2 + q, pt = pos >> 2, qt = pos & 3; const f32x4 z = (f32x4){0.f, 0.f, 0.f, 0.f};
            f32x4 y0 = mm64(SL(7), SL(9), pt, qt, z, lane); y0 = mm64(SL(16), SL(10), pt, qt, y0, lane);
            st_tile(SL(0), pt, qt, y0, lane);
            const f32x4 rt = ld4bf(SL(3) + (pt * 16 + fr) * LDT + qt * 16 + fq * 4);
            const f32x4 aw = mm64(SL(10), SL(15), pt, qt, z, lane);
            st_tile(SL(1), pt, qt, rt - aw, lane);
            f32x4 m = -mm64(SL(5), SL(15), pt, qt, z, lane);
#pragma unroll
            for (int j = 0; j < 4; ++j) if (qt * 16 + fq * 4 + j == pt * 16 + fr) m[j] += gl_s[pt * 16 + fr];
            st_tile(SL(11), pt, qt, m, lane);
            f32x4 nn = mm64(SL(7), SL(6), pt, qt, z, lane); nn = mm64(SL(16), SL(5), pt, qt, nn, lane);
            st_tile(SL(12), pt, qt, nn, lane);
        }
        __syncthreads();
        TSTAMP(5);
        RETID();
        { bf16_t* dst = FR + (size_t)u * 16384;
          { const int which = tid >> 8, it = (tid >> 6) & 3, l = tid & 63, r = l & 31, hh = l >> 5;
            const int k0 = 32 * (it >> 1) + 16 * (it & 1) + 4 * hh;
            { const bf16_t* src = SL(1) + (32 * which + r) * LDT + k0; u32x2 a = *(const u32x2*)src, b = *(const u32x2*)(src + 8); u32x4 w; w.x = a.x; w.y = a.y; w.z = b.x; w.w = b.y;
              *(u32x4*)(dst + ((which * 4 + it) * 64 + l) * 8) = w; }
            { const bf16_t* src = SL(11) + (32 * which + r) * LDT + k0; u32x2 a = *(const u32x2*)src, b = *(const u32x2*)(src + 8); u32x4 w; w.x = a.x; w.y = a.y; w.z = b.x; w.w = b.y;
              *(u32x4*)(dst + 4096 + ((which * 4 + it) * 64 + l) * 8) = w; }
          }
          {
            const int sel = tid >> 8, x = (tid >> 7) & 1, vb = (tid >> 6) & 1, l = tid & 63, r = l & 31, hh = l >> 5;
            const bf16_t* src = (sel == 0 ? SL(12) : SL(0)) + (32 * vb + r) * LDT + 32 * x + 4 * hh;
            const u32x2 g0 = *(const u32x2*)src, g1 = *(const u32x2*)(src + 8), g2 = *(const u32x2*)(src + 16), g3 = *(const u32x2*)(src + 24);
            u32x4 w0, w1; w0.x = g0.x; w0.y = g0.y; w0.z = g1.x; w0.w = g1.y; w1.x = g2.x; w1.y = g2.y; w1.z = g3.x; w1.w = g3.y;
            bf16_t* d2 = dst + 8192 + sel * 4096 + ((x * 2 + vb) * 64 + l) * 16;
            *(u32x4*)d2 = w0; *(u32x4*)(d2 + 8) = w1;
          }
        }
        __syncthreads();
        TSTAMP(6);
    }
#undef RW_ISSUE
#undef SL
#undef RETID
#undef tid
#undef lane
#undef wv
#undef fr
#undef fq
}

__device__ __forceinline__ bf16x8 pack8(const f32x16& x, int s8) {
    u32x4 w; w.x = pk2(x[s8], x[s8 + 1]); w.y = pk2(x[s8 + 2], x[s8 + 3]); w.z = pk2(x[s8 + 4], x[s8 + 5]); w.w = pk2(x[s8 + 6], x[s8 + 7]);
    return __builtin_bit_cast(bf16x8, w);
}
__device__ __forceinline__ f32x16 unpack16(const u32x4 a, const u32x4 b) {
    f32x16 o;
    o[0] = BLO(a.x); o[1] = BHI(a.x); o[2] = BLO(a.y); o[3] = BHI(a.y); o[4] = BLO(a.z); o[5] = BHI(a.z); o[6] = BLO(a.w); o[7] = BHI(a.w);
    o[8] = BLO(b.x); o[9] = BHI(b.x); o[10] = BLO(b.y); o[11] = BHI(b.y); o[12] = BLO(b.z); o[13] = BHI(b.z); o[14] = BLO(b.w); o[15] = BHI(b.w);
    return o;
}


__device__ __forceinline__ void phase_rwkv_scan4(const Params& p, unsigned char* smem_, int bh) {
    int tidv = threadIdx.x; asm volatile("" : "+v"(tidv));
    const int lane = tidv & 63, wv = __builtin_amdgcn_readfirstlane(tidv >> 6);
    const int b = bh >> 3, h = bh & 7;
    const bf16_t* FR = (const bf16_t*)p.out; bf16_t* Y = (bf16_t*)(p.ws + OFF_Y);
    constexpr int PD = 4; constexpr int SFB = 98304;
    if (wv >= 2 && wv < 6) {
        const int pc0 = (wv - 2) * 512 + lane;
        u32x4 buf[PD][8];
#define SC_LOAD(k, c) do { const bf16_t* src = FR + (size_t)(((b * 64 + (c)) * 8 + h)) * 16384; _Pragma("unroll") for (int i = 0; i < 8; ++i) buf[k][i] = *(const u32x4*)(src + (size_t)(pc0 + 64 * i) * 8); } while (0)
#define SC_PUT(k, c) do { bf16_t* dst = (bf16_t*)(smem_ + ((c) % 3) * 32768); _Pragma("unroll") for (int i = 0; i < 8; ++i) *(u32x4*)(dst + (pc0 + 64 * i) * 8) = buf[k][i]; } while (0)
#pragma unroll
        for (int k = 0; k < PD; ++k) SC_LOAD(k, k);
        SC_PUT(0, 0); SC_LOAD(0, PD);
        __syncthreads();
#pragma unroll 1
        for (int c0 = 0; c0 < 64; c0 += PD) {
#pragma unroll
            for (int kk = 0; kk < PD; ++kk) {
                const int c = c0 + kk, k = (kk + 1) % PD;
                if (c + 1 < 64) { SC_PUT(k, c + 1); if (c + 1 + PD < 64) SC_LOAD(k, c + 1 + PD); }
                __syncthreads();
            }
        }
        __syncthreads();
#undef SC_LOAD
#undef SC_PUT
    } else if (wv < 2) {
        const int vb = wv;
        f32x16 S0, S1;
#pragma unroll
        for (int i = 0; i < 16; ++i) { S0[i] = 0.f; S1[i] = 0.f; }
        __syncthreads();
#pragma unroll 1
        for (int c = 0; c < 64; ++c) {
            const bf16_t* src = (const bf16_t*)(smem_ + (c % 3) * 32768);
            u32x4 mf[8], nf[4];
#pragma unroll
            for (int i = 0; i < 8; ++i) mf[i] = *(const u32x4*)(src + 4096 + (i * 64 + lane) * 8);
#pragma unroll
            for (int x = 0; x < 2; ++x) { const bf16_t* s2 = src + 8192 + ((x * 2 + vb) * 64 + lane) * 16; nf[2 * x] = *(const u32x4*)s2; nf[2 * x + 1] = *(const u32x4*)(s2 + 8); }
            bf16x8 sf[4];
            sf[0] = pack8(S0, 0); sf[1] = pack8(S0, 8); sf[2] = pack8(S1, 0); sf[3] = pack8(S1, 8);
            { unsigned char* sb = smem_ + SFB + (c & 1) * 8192 + vb * 4096;
#pragma unroll
              for (int s = 0; s < 4; ++s) *(bf16x8*)(sb + (s * 64 + lane) * 16) = sf[s]; }
            f32x16 n0 = unpack16(nf[0], nf[1]), n1 = unpack16(nf[2], nf[3]);
#pragma unroll
            for (int s = 0; s < 4; ++s) { n0 = MFMA32(__builtin_bit_cast(bf16x8, mf[s]), sf[s], n0); n1 = MFMA32(__builtin_bit_cast(bf16x8, mf[4 + s]), sf[s], n1); }
            S0 = n0; S1 = n1;
            __syncthreads();
        }
        __syncthreads();
    } else {
        const int vb = wv - 6, r = lane & 31, hh = lane >> 5;
        __syncthreads();
#pragma unroll 1
        for (int c = 0; c <= 64; ++c) {
            if (c >= 1) {
                const int cc = c - 1;
                const bf16_t* src = (const bf16_t*)(smem_ + (cc % 3) * 32768);
                u32x4 qf[8], yf[4]; bf16x8 sf[4];
#pragma unroll
                for (int i = 0; i < 8; ++i) qf[i] = *(const u32x4*)(src + (i * 64 + lane) * 8);
#pragma unroll
                for (int x = 0; x < 2; ++x) { const bf16_t* s3 = src + 12288 + ((x * 2 + vb) * 64 + lane) * 16; yf[2 * x] = *(const u32x4*)s3; yf[2 * x + 1] = *(const u32x4*)(s3 + 8); }
                { const unsigned char* sb = smem_ + SFB + (cc & 1) * 8192 + vb * 4096;
#pragma unroll
                  for (int s = 0; s < 4; ++s) sf[s] = *(const bf16x8*)(sb + (s * 64 + lane) * 16); }
                f32x16 y0 = unpack16(yf[0], yf[1]), y1 = unpack16(yf[2], yf[3]);
#pragma unroll
                for (int s = 0; s < 4; ++s) { y0 = MFMA32(__builtin_bit_cast(bf16x8, qf[s]), sf[s], y0); y1 = MFMA32(__builtin_bit_cast(bf16x8, qf[4 + s]), sf[s], y1); }
                bf16_t* yp = Y + ((size_t)(b * 4096 + cc * 64)) * 512 + h * 64 + vb * 32 + r;
#pragma unroll
                for (int i = 0; i < 16; ++i) { const int row = (i & 3) + 8 * (i >> 2) + 4 * hh; yp[(size_t)row * 512] = (bf16_t)f2bf(y0[i]); yp[(size_t)(32 + row) * 512] = (bf16_t)f2bf(y1[i]); }
            }
            __syncthreads();
        }
    }
}

__device__ __forceinline__ void ml_gates(const Params& p, int n0, int h, float* bcum_s, float* ig_s) {
    if (threadIdx.x < 64) {
        const int lane = threadIdx.x; const float* ifg = (const float*)(p.ws + OFF_IFG);
        const float ig = ifg[(n0 + lane) * 8 + h] + p.in[18][h];
        const float fp = ifg[(n0 + lane) * 8 + 4 + h] + p.in[19][h];
        float c = -softplusf_(-fp);
#pragma unroll
        for (int o = 1; o < 64; o <<= 1) { const float t = __shfl_up(c, o); if (lane >= o) c += t; }
        bcum_s[lane] = c; ig_s[lane] = ig;
    }
}
__device__ __forceinline__ float siluf_(float x) { return x * sigmoidf_(x); }


template <int K> __device__ __forceinline__ f32x4 mmk(const bf16_t* P, int ldp, const bf16_t* Q, int ldq, int pt, int qt, f32x4 acc, int lane_) {
#pragma unroll
    for (int k0 = 0; k0 < K; k0 += 32) {
        const bf16x8 a = *(const bf16x8*)(Q + (qt * 16 + (lane_ & 15)) * ldq + k0 + (lane_ >> 4) * 8);
        const bf16x8 b = *(const bf16x8*)(P + (pt * 16 + (lane_ & 15)) * ldp + k0 + (lane_ >> 4) * 8);
        acc = MFMA16(a, b, acc);
    }
    return acc;
}
__device__ __forceinline__ float fast_silu(float x) { return x * __builtin_amdgcn_rcpf(1.f + __expf(-x)); }

__device__ __forceinline__ void phase_ml_cloc2(const Params& p, unsigned char* smem_, int first, int stride) {
    int tidv = threadIdx.x;
#define RETID() asm volatile("" : "+v"(tidv))
    bf16_t* RAWK = (bf16_t*)smem_;
    bf16_t* RAWV = (bf16_t*)(smem_ + 18432);
    bf16_t* KT = (bf16_t*)(smem_ + 36864);
    bf16_t* VT = (bf16_t*)(smem_ + 55296);
    float* bcum_s = (float*)(smem_ + 73728); float* ig_s = bcum_s + 64;
    const bf16_t* zml = (const bf16_t*)(p.ws + OFF_ZML);
    bf16_t* CLOC = (bf16_t*)(p.ws + OFF_CLOC); float* nloc = (float*)(p.ws + OFF_NLOC); float* gend = (float*)(p.ws + OFF_GEND);
    for (int u = first; u < 1024; u += stride) {
        RETID();
        const int tid = tidv, h = u & 3, bc = u >> 2; const int n0 = bc * 64, t0 = (bc & 63) * 64;
        u32x4 kr[3], vr[2];
#pragma unroll
        for (int j = 0; j < 3; ++j) { const int task = tid + 512 * j, i = task >> 4, c8 = task & 15;
            kr[j] = (task < 1072 && t0 + i - 3 >= 0) ? *(const u32x4*)(zml + (size_t)(n0 + i - 3) * 2048 + 512 + h * 128 + c8 * 8) : (u32x4){0u, 0u, 0u, 0u}; }
#pragma unroll
        for (int j = 0; j < 2; ++j) { const int task = tid + 512 * j, i = task >> 4, c8 = task & 15; vr[j] = *(const u32x4*)(zml + (size_t)(n0 + i) * 2048 + 1024 + h * 128 + c8 * 8); }
        float tt[8]; bf16_t* tdst; int tK, tkb, tnb;
        { const int nl = tid & 63, kl0 = tid >> 6;
          if (u < 512) { tkb = u >> 5; tnb = u & 31; tK = 1024; tdst = (bf16_t*)(p.ws + OFF_WQT);
#pragma unroll
              for (int i = 0; i < 8; ++i) { const int k = tkb * 64 + kl0 + 8 * i; tt[i] = p.in[26][(size_t)k * 2048 + tnb * 64 + nl] * p.in[25][k]; } }
          else if (u < 768) { const int r = u - 512; tkb = r >> 4; tnb = r & 15; tK = 1024; tdst = (bf16_t*)(p.ws + OFF_WOUTT);
#pragma unroll
              for (int i = 0; i < 8; ++i) { const int k = tkb * 64 + kl0 + 8 * i; tt[i] = p.in[24][(size_t)k * 1024 + tnb * 64 + nl]; } }
          else if (u < 896) { const int r = u - 768; tkb = r >> 4; tnb = r & 15; tK = 512; tdst = (bf16_t*)(p.ws + OFF_PRWT);
#pragma unroll
              for (int i = 0; i < 8; ++i) { const int k = tkb * 64 + kl0 + 8 * i; tt[i] = p.in[22][(size_t)k * 1024 + tnb * 64 + nl]; } }
          else { const int r = u - 896; tkb = r >> 4; tnb = r & 15; tK = 512; tdst = (bf16_t*)(p.ws + OFF_PMLT);
#pragma unroll
              for (int i = 0; i < 8; ++i) { const int k = tkb * 64 + kl0 + 8 * i; tt[i] = p.in[23][(size_t)k * 1024 + tnb * 64 + nl]; } } }
        ml_gates(p, n0, h, bcum_s, ig_s);
        { float* TB = (float*)(smem_ + 81920); const int nl = tid & 63, kl0 = tid >> 6;
#pragma unroll
          for (int i = 0; i < 8; ++i) TB[(kl0 + 8 * i) * 65 + nl] = tt[i]; }
#pragma unroll
        for (int j = 0; j < 3; ++j) { const int task = tid + 512 * j, i = task >> 4, c8 = task & 15; if (task < 1072) *(u32x4*)(RAWK + i * 136 + c8 * 8) = kr[j]; }
#pragma unroll
        for (int j = 0; j < 2; ++j) { const int task = tid + 512 * j, i = task >> 4, c8 = task & 15; *(u32x4*)(RAWV + i * 136 + c8 * 8) = vr[j]; }
        __syncthreads();
        RETID();
        { const float* TB = (const float*)(smem_ + 81920); const int n = tidv & 63, kc = tidv >> 6; const float* c0 = TB + (kc * 8) * 65 + n;
          u32x4 w; w.x = pk2(c0[0], c0[65]); w.y = pk2(c0[130], c0[195]); w.z = pk2(c0[260], c0[325]); w.w = pk2(c0[390], c0[455]);
          *(u32x4*)(tdst + (size_t)(tnb * 64 + n) * tK + tkb * 64 + kc * 8) = w; }
        { const int c = tidv & 127, sg = tidv >> 7, s0 = sg * 16, hc = h * 128 + c;
          const float w0 = p.in[16][0 * 512 + hc], w1 = p.in[16][1 * 512 + hc], w2 = p.in[16][2 * 512 + hc], w3 = p.in[16][3 * 512 + hc], bk = p.in[17][hc];
          const float ge = bcum_s[63];
          if (tidv == 0) gend[u] = ge;
          float xm3 = bf2f(RAWK[(s0 + 0) * 136 + c]), xm2 = bf2f(RAWK[(s0 + 1) * 136 + c]), xm1 = bf2f(RAWK[(s0 + 2) * 136 + c]);
          unsigned kp[8], vp[8]; float kprev = 0.f, vprev = 0.f;
#pragma unroll
          for (int i = 0; i < 16; ++i) {
              const int s = s0 + i; const float xc = bf2f(RAWK[(s + 3) * 136 + c]);
              const float kv = fast_silu(bk + w0 * xm3 + w1 * xm2 + w2 * xm1 + w3 * xc) * 0.08838834764831845f;
              xm3 = xm2; xm2 = xm1; xm1 = xc;
              const float vv = __expf(ge - bcum_s[s] + ig_s[s]) * bf2f(RAWV[s * 136 + c]);
              if (i & 1) { kp[i >> 1] = pk2(kprev, kv); vp[i >> 1] = pk2(vprev, vv); } else { kprev = kv; vprev = vv; }
          }
          u32x4 w; w.x = kp[0]; w.y = kp[1]; w.z = kp[2]; w.w = kp[3]; *(u32x4*)(KT + c * 72 + s0) = w; w.x = kp[4]; w.y = kp[5]; w.z = kp[6]; w.w = kp[7]; *(u32x4*)(KT + c * 72 + s0 + 8) = w;
          w.x = vp[0]; w.y = vp[1]; w.z = vp[2]; w.w = vp[3]; *(u32x4*)(VT + c * 72 + s0) = w; w.x = vp[4]; w.y = vp[5]; w.z = vp[6]; w.w = vp[7]; *(u32x4*)(VT + c * 72 + s0 + 8) = w;
        }
        __syncthreads();
        RETID();
        { const int lane_ = tidv & 63, wv_ = tidv >> 6, fr_ = lane_ & 15, fq_ = lane_ >> 4;
#pragma unroll
          for (int qt = 0; qt < 8; ++qt) {
              const f32x4 z = mmk<64>(VT, 72, KT, 72, wv_, qt, (f32x4){0.f, 0.f, 0.f, 0.f}, lane_);
              u32x2 w; w.x = pk2(z[0], z[1]); w.y = pk2(z[2], z[3]);
              *(u32x2*)(CLOC + ((size_t)u * 128 + wv_ * 16 + fr_) * 128 + qt * 16 + fq_ * 4) = w;
          }
          if (tidv < 128) { const int k = tidv; float a = 0.f;
#pragma unroll
              for (int s8 = 0; s8 < 64; s8 += 8) { const u32x4 r = *(const u32x4*)(KT + k * 72 + s8);
                  const float ge = bcum_s[63];
                  a += __expf(ge - bcum_s[s8 + 0] + ig_s[s8 + 0]) * BLO(r.x) + __expf(ge - bcum_s[s8 + 1] + ig_s[s8 + 1]) * BHI(r.x)
                     + __expf(ge - bcum_s[s8 + 2] + ig_s[s8 + 2]) * BLO(r.y) + __expf(ge - bcum_s[s8 + 3] + ig_s[s8 + 3]) * BHI(r.y)
                     + __expf(ge - bcum_s[s8 + 4] + ig_s[s8 + 4]) * BLO(r.z) + __expf(ge - bcum_s[s8 + 5] + ig_s[s8 + 5]) * BHI(r.z)
                     + __expf(ge - bcum_s[s8 + 6] + ig_s[s8 + 6]) * BLO(r.w) + __expf(ge - bcum_s[s8 + 7] + ig_s[s8 + 7]) * BHI(r.w); }
              nloc[u * 128 + k] = a; }
        }
        __syncthreads();
    }
#undef RETID
}

__device__ __forceinline__ void phase_ml_out2(const Params& p, unsigned char* smem_) {
    int tidv = threadIdx.x;
#define RETID() asm volatile("" : "+v"(tidv))
    bf16_t* RAWQ = (bf16_t*)smem_;
    bf16_t* RAWK = (bf16_t*)(smem_ + 18432);
    bf16_t* RAWV = (bf16_t*)(smem_ + 36864);
    bf16_t* Qm = (bf16_t*)(smem_ + 55296);
    bf16_t* Km = (bf16_t*)(smem_ + 73728);
    bf16_t* VT = (bf16_t*)(smem_ + 92160);
    bf16_t* Cin = (bf16_t*)(smem_ + 110592);
    float* bcum_s = (float*)(smem_ + 145408); float* ig_s = bcum_s + 64; float* nin_s = ig_s + 64; float* den_s = nin_s + 128; float* st_s = den_s + 64;
    bf16_t* PM = RAWQ; bf16_t* QE = RAWK;
    const bf16_t* zml = (const bf16_t*)(p.ws + OFF_ZML); const bf16_t* CLOC = (const bf16_t*)(p.ws + OFF_CLOC); const float* nloc = (const float*)(p.ws + OFF_NLOC);
    bf16_t* YML = (bf16_t*)(p.ws + OFF_YML);
    for (int u = blockIdx.x; u < 1024; u += gridDim.x) {
        RETID();
        const int tid = tidv, h = u & 3, bc = u >> 2; const int n0 = bc * 64, t0 = (bc & 63) * 64;
        { u32x4 qr[3], kr[3], vr[2], cr[4];
#pragma unroll
          for (int j = 0; j < 3; ++j) { const int task = tid + 512 * j, i = task >> 4, c8 = task & 15; const bool ok = task < 1072 && t0 + i - 3 >= 0;
              const bf16_t* src = zml + (size_t)(n0 + i - 3) * 2048 + h * 128 + c8 * 8;
              qr[j] = ok ? *(const u32x4*)src : (u32x4){0u, 0u, 0u, 0u}; kr[j] = ok ? *(const u32x4*)(src + 512) : (u32x4){0u, 0u, 0u, 0u}; }
#pragma unroll
          for (int j = 0; j < 2; ++j) { const int task = tid + 512 * j, i = task >> 4, c8 = task & 15; vr[j] = *(const u32x4*)(zml + (size_t)(n0 + i) * 2048 + 1024 + h * 128 + c8 * 8); }
#pragma unroll
          for (int j = 0; j < 4; ++j) { const int task = tid + 512 * j, v = task >> 4, c8 = task & 15; cr[j] = *(const u32x4*)(CLOC + ((size_t)u * 128 + v) * 128 + c8 * 8); }
          ml_gates(p, n0, h, bcum_s, ig_s);
          if (tid < 128) nin_s[tid] = nloc[u * 128 + tid];
#pragma unroll
          for (int j = 0; j < 3; ++j) { const int task = tid + 512 * j, i = task >> 4, c8 = task & 15; if (task < 1072) { *(u32x4*)(RAWQ + i * 136 + c8 * 8) = qr[j]; *(u32x4*)(RAWK + i * 136 + c8 * 8) = kr[j]; } }
#pragma unroll
          for (int j = 0; j < 2; ++j) { const int task = tid + 512 * j, i = task >> 4, c8 = task & 15; *(u32x4*)(RAWV + i * 136 + c8 * 8) = vr[j]; }
#pragma unroll
          for (int j = 0; j < 4; ++j) { const int task = tid + 512 * j, v = task >> 4, c8 = task & 15; *(u32x4*)(Cin + v * 136 + c8 * 8) = cr[j]; }
        }
        __syncthreads();
        RETID();
        float qe[16];
        { const int c = tidv & 127, sg = tidv >> 7, s0 = sg * 16, hc = h * 128 + c;
          const float q0 = p.in[14][0 * 512 + hc], q1 = p.in[14][1 * 512 + hc], q2 = p.in[14][2 * 512 + hc], q3 = p.in[14][3 * 512 + hc], bq = p.in[15][hc];
          const float w0 = p.in[16][0 * 512 + hc], w1 = p.in[16][1 * 512 + hc], w2 = p.in[16][2 * 512 + hc], w3 = p.in[16][3 * 512 + hc], bk = p.in[17][hc];
          float xm3 = bf2f(RAWK[(s0 + 0) * 136 + c]), xm2 = bf2f(RAWK[(s0 + 1) * 136 + c]), xm1 = bf2f(RAWK[(s0 + 2) * 136 + c]);
          float ym3 = bf2f(RAWQ[(s0 + 0) * 136 + c]), ym2 = bf2f(RAWQ[(s0 + 1) * 136 + c]), ym1 = bf2f(RAWQ[(s0 + 2) * 136 + c]);
          unsigned vp[8]; float vprev = 0.f;
#pragma unroll
          for (int i = 0; i < 16; ++i) {
              const int s = s0 + i; const float xc = bf2f(RAWK[(s + 3) * 136 + c]), yc = bf2f(RAWQ[(s + 3) * 136 + c]);
              const float kv = fast_silu(bk + w0 * xm3 + w1 * xm2 + w2 * xm1 + w3 * xc) * 0.08838834764831845f;
              const float qv = fast_silu(bq + q0 * ym3 + q1 * ym2 + q2 * ym1 + q3 * yc);
              xm3 = xm2; xm2 = xm1; xm1 = xc; ym3 = ym2; ym2 = ym1; ym1 = yc;
              Km[s * 136 + c] = (bf16_t)f2bf(kv); Qm[s * 136 + c] = (bf16_t)f2bf(qv); qe[i] = qv * __expf(bcum_s[s]);
              const float vv = bf2f(RAWV[s * 136 + c]);
              if (i & 1) vp[i >> 1] = pk2(vprev, vv); else vprev = vv;
          }
          u32x4 w; w.x = vp[0]; w.y = vp[1]; w.z = vp[2]; w.w = vp[3]; *(u32x4*)(VT + c * 72 + s0) = w; w.x = vp[4]; w.y = vp[5]; w.z = vp[6]; w.w = vp[7]; *(u32x4*)(VT + c * 72 + s0 + 8) = w;
        }
        __syncthreads();
        RETID();
        { const int c = tidv & 127, s0 = (tidv >> 7) * 16;
#pragma unroll
          for (int i = 0; i < 16; ++i) QE[(s0 + i) * 136 + c] = (bf16_t)f2bf(qe[i]); }
        { const int lane_ = tidv & 63, wv_ = tidv >> 6, fr_ = lane_ & 15, fq_ = lane_ >> 4;
#pragma unroll
          for (int q = 0; q < 2; ++q) { const int pos = wv_ * 2 + q, pt = pos >> 2, qt = pos & 3;
              f32x4 sc = mmk<128>(Qm, 136, Km, 136, pt, qt, (f32x4){0.f, 0.f, 0.f, 0.f}, lane_);
              const int l = pt * 16 + fr_; const float bl = bcum_s[l];
#pragma unroll
              for (int j = 0; j < 4; ++j) { const int s = qt * 16 + fq_ * 4 + j; sc[j] = (s <= l) ? sc[j] * __expf(bl - bcum_s[s] + ig_s[s]) : 0.f; }
              u32x2 w; w.x = pk2(sc[0], sc[1]); w.y = pk2(sc[2], sc[3]);
              *(u32x2*)(PM + l * 72 + qt * 16 + fq_ * 4) = w; }
        }
        __syncthreads();
        RETID();
        {
          const int l = tidv >> 3, sq = tidv & 7;
          const u32x4 pr = *(const u32x4*)(PM + l * 72 + sq * 8);
          float ds = ((BLO(pr.x) + BHI(pr.x)) + (BLO(pr.y) + BHI(pr.y))) + ((BLO(pr.z) + BHI(pr.z)) + (BLO(pr.w) + BHI(pr.w)));
          const u32x4 qa = *(const u32x4*)(QE + l * 136 + sq * 16), qb = *(const u32x4*)(QE + l * 136 + sq * 16 + 8);
          const float* nn = nin_s + sq * 16;
          float qn = BLO(qa.x) * nn[0] + BHI(qa.x) * nn[1] + BLO(qa.y) * nn[2] + BHI(qa.y) * nn[3] + BLO(qa.z) * nn[4] + BHI(qa.z) * nn[5] + BLO(qa.w) * nn[6] + BHI(qa.w) * nn[7]
                   + BLO(qb.x) * nn[8] + BHI(qb.x) * nn[9] + BLO(qb.y) * nn[10] + BHI(qb.y) * nn[11] + BLO(qb.z) * nn[12] + BHI(qb.z) * nn[13] + BLO(qb.w) * nn[14] + BHI(qb.w) * nn[15];
          ds = sum8(ds + qn);
          if (sq == 0) den_s[l] = ds;
        }
        __syncthreads();
        RETID();
        { const int lane_ = tidv & 63, wv_ = tidv >> 6, fr_ = lane_ & 15, fq_ = lane_ >> 4;
          const int pt = wv_ >> 1, vh = wv_ & 1, l = pt * 16 + fr_;
          const float dn = __builtin_amdgcn_rcpf(fmaxf(fabsf(den_s[l]), 1.f));
          f32x4 hv[4]; float sm = 0.f, sq2 = 0.f;
#pragma unroll
          for (int q = 0; q < 4; ++q) { const int qt = vh * 4 + q;
              f32x4 a = mmk<64>(PM, 72, VT, 72, pt, qt, (f32x4){0.f, 0.f, 0.f, 0.f}, lane_);
              a = mmk<128>(QE, 136, Cin, 136, pt, qt, a, lane_);
              hv[q] = a * dn;
              sm += (hv[q][0] + hv[q][1]) + (hv[q][2] + hv[q][3]); sq2 += (hv[q][0] * hv[q][0] + hv[q][1] * hv[q][1]) + (hv[q][2] * hv[q][2] + hv[q][3] * hv[q][3]); }
          sm += __shfl_xor(sm, 16); sm += __shfl_xor(sm, 32); sq2 += __shfl_xor(sq2, 16); sq2 += __shfl_xor(sq2, 32);
          if (fq_ == 0) { st_s[(vh * 64 + l) * 2] = sm; st_s[(vh * 64 + l) * 2 + 1] = sq2; }
          __syncthreads();
          const float s1 = st_s[l * 2] + st_s[(64 + l) * 2], s2 = st_s[l * 2 + 1] + st_s[(64 + l) * 2 + 1];
          const float mean = s1 * (1.f / 128.f); const float var = fmaxf(s2 * (1.f / 128.f) - mean * mean, 0.f); const float rs = __builtin_amdgcn_rsqf(var + 1e-5f);
#pragma unroll
          for (int q = 0; q < 4; ++q) { const int hc = h * 128 + (vh * 4 + q) * 16 + fq_ * 4;
              const f32x4 nw = *(const f32x4*)(p.in[20] + hc);
              const u32x2 op = *(const u32x2*)(zml + (size_t)(n0 + l) * 2048 + 1536 + hc);
              const float o0 = (hv[q][0] - mean) * rs * nw[0] * sigmoidf_(BLO(op.x)), o1 = (hv[q][1] - mean) * rs * nw[1] * sigmoidf_(BHI(op.x));
              const float o2 = (hv[q][2] - mean) * rs * nw[2] * sigmoidf_(BLO(op.y)), o3 = (hv[q][3] - mean) * rs * nw[3] * sigmoidf_(BHI(op.y));
              u32x2 w; w.x = pk2(o0, o1); w.y = pk2(o2, o3);
              *(u32x2*)(YML + (size_t)(n0 + l) * 512 + hc) = w; }
        }
        __syncthreads();
    }
#undef RETID
}

__device__ __forceinline__ void phase_ml_scan(const Params& p) {
    bf16_t* CLOC = (bf16_t*)(p.ws + OFF_CLOC); float* nloc = (float*)(p.ws + OFF_NLOC); const float* gend = (const float*)(p.ws + OFF_GEND);
    const int gt = blockIdx.x * 512 + threadIdx.x, nt = gridDim.x * 512;
    for (int task = gt; task < 32768 + 2048; task += nt) {
        if (task < 32768) {
            const int bh = task >> 11, rem = task & 2047; const int b = bh >> 2, h = bh & 3;
            float run[8];
#pragma unroll
            for (int j = 0; j < 8; ++j) run[j] = 0.f;
            for (int c0 = 0; c0 < 64; c0 += 8) {
                u32x4 raw[8]; float g[8];
#pragma unroll
                for (int i = 0; i < 8; ++i) { const int unit = (b * 64 + c0 + i) * 4 + h; raw[i] = *(const u32x4*)(CLOC + (size_t)unit * 16384 + rem * 8); g[i] = __expf(gend[unit]); }
#pragma unroll
                for (int i = 0; i < 8; ++i) { const int unit = (b * 64 + c0 + i) * 4 + h;
                    u32x4 w; w.x = pk2(run[0], run[1]); w.y = pk2(run[2], run[3]); w.z = pk2(run[4], run[5]); w.w = pk2(run[6], run[7]);
                    *(u32x4*)(CLOC + (size_t)unit * 16384 + rem * 8) = w;
                    run[0] = g[i] * run[0] + __uint_as_float(raw[i].x << 16); run[1] = g[i] * run[1] + __uint_as_float(raw[i].x & 0xffff0000u);
                    run[2] = g[i] * run[2] + __uint_as_float(raw[i].y << 16); run[3] = g[i] * run[3] + __uint_as_float(raw[i].y & 0xffff0000u);
                    run[4] = g[i] * run[4] + __uint_as_float(raw[i].z << 16); run[5] = g[i] * run[5] + __uint_as_float(raw[i].z & 0xffff0000u);
                    run[6] = g[i] * run[6] + __uint_as_float(raw[i].w << 16); run[7] = g[i] * run[7] + __uint_as_float(raw[i].w & 0xffff0000u); }
            }
        } else {
            const int t2 = task - 32768; const int bh = t2 >> 7, k = t2 & 127; const int b = bh >> 2, h = bh & 3;
            float run = 0.f;
            for (int c = 0; c < 64; ++c) { const int unit = (b * 64 + c) * 4 + h; const float x = nloc[unit * 128 + k]; nloc[unit * 128 + k] = run; run = __expf(gend[unit]) * run + x; }
        }
    }
}
__device__ __forceinline__ void phase_rwkv_post(const Params& p) {
    bf16_t* Y = (bf16_t*)(p.ws + OFF_Y); const bf16_t* V = (const bf16_t*)(p.ws + OFF_V); const bf16_t* G = (const bf16_t*)(p.ws + OFF_G);
    const float* bonus = (const float*)(p.ws + OFF_BONUS);
    const int tid = tid_opaque(), lane = tid & 63; const int gw = blockIdx.x * 8 + (tid >> 6), nw = gridDim.x * 8;
    const f32x4 gwa = *(const f32x4*)(p.in[12] + lane * 8), gwb = *(const f32x4*)(p.in[12] + lane * 8 + 4), gba = *(const f32x4*)(p.in[13] + lane * 8), gbb = *(const f32x4*)(p.in[13] + lane * 8 + 4);
    for (int n = gw; n < NTOK; n += nw) {
        const size_t o = (size_t)n * 512 + lane * 8;
        const u32x4 yr = *(const u32x4*)(Y + o), vr = *(const u32x4*)(V + o), gr = *(const u32x4*)(G + o);
        const float bon = bonus[n * 8 + (lane >> 3)];
        float y[8] = {BLO(yr.x), BHI(yr.x), BLO(yr.y), BHI(yr.y), BLO(yr.z), BHI(yr.z), BLO(yr.w), BHI(yr.w)};
        const float v[8] = {BLO(vr.x), BHI(vr.x), BLO(vr.y), BHI(vr.y), BLO(vr.z), BHI(vr.z), BLO(vr.w), BHI(vr.w)};
        const float g[8] = {BLO(gr.x), BHI(gr.x), BLO(gr.y), BHI(gr.y), BLO(gr.z), BHI(gr.z), BLO(gr.w), BHI(gr.w)};
        float s = ((y[0] + y[1]) + (y[2] + y[3])) + ((y[4] + y[5]) + (y[6] + y[7]));
        const float mean = sum8(s) * (1.f / 64.f);
        float q = 0.f;
#pragma unroll
        for (int i = 0; i < 8; ++i) { y[i] -= mean; q += y[i] * y[i]; }
        const float rs = __builtin_amdgcn_rsqf(sum8(q) * (1.f / 64.f) + 64e-5f);
        float r[8];
#pragma unroll
        for (int i = 0; i < 8; ++i) { const float gw_ = i < 4 ? gwa[i & 3] : gwb[i & 3], gb_ = i < 4 ? gba[i & 3] : gbb[i & 3]; r[i] = (y[i] * rs * gw_ + gb_ + bon * v[i]) * g[i]; }
        u32x4 w; w.x = pk2(r[0], r[1]); w.y = pk2(r[2], r[3]); w.z = pk2(r[4], r[5]); w.w = pk2(r[6], r[7]);
        *(u32x4*)(Y + o) = w;
    }
}


__device__ __forceinline__ void phase_peer_keys(const Params& p, unsigned char* smem_) {
    int tidv = threadIdx.x;
#define RETID() asm volatile("" : "+v"(tidv))
    bf16_t* SK = (bf16_t*)smem_;
    bf16_t* Qs = (bf16_t*)(smem_ + 34816);
    const bf16_t* q = (const bf16_t*)(p.ws + OFF_Q); const bf16_t* skt = (const bf16_t*)(p.ws + OFF_SKT); float* keys = (float*)(p.ws + OFF_KEYS);
    const int nb = gridDim.x;
    int gcur = -1;
    u32x4 qr[4];
#define PK_ISSUE(uu) do { const int g_ = (uu) & 15, n0_ = ((uu) >> 4) * 128; \
        _Pragma("unroll") for (int j = 0; j < 4; ++j) { const int idx = tidv + 512 * j, row = idx >> 4, pc = idx & 15; qr[j] = *(const u32x4*)(q + (size_t)(n0_ + row) * 2048 + g_ * 128 + pc * 8); } } while (0)
    if ((int)blockIdx.x < 2048) PK_ISSUE(blockIdx.x);
    for (int u = blockIdx.x; u < 2048; u += nb) {
        RETID();
        const int g = u & 15, n0 = (u >> 4) * 128;
        if (g != gcur) { gcur = g;
#pragma unroll
            for (int j = 0; j < 4; ++j) { const int idx = tidv + 512 * j, row = idx >> 4, pc = idx & 15; *(u32x4*)(SK + row * 136 + pc * 8) = *(const u32x4*)(skt + (size_t)(g * 128 + row) * 128 + pc * 8); } }
#pragma unroll
        for (int j = 0; j < 4; ++j) { const int idx = tidv + 512 * j, row = idx >> 4, pc = idx & 15; *(u32x4*)(Qs + row * 136 + pc * 8) = qr[j]; }
        __syncthreads();
        RETID();
        if (u + nb < 2048) PK_ISSUE(u + nb);
        const int lane_ = tidv & 63, wv_ = tidv >> 6, fr_ = lane_ & 15, fq_ = lane_ >> 4;
        const int wu = u * 8 + wv_;
        f32x4 tu[4], tv[4];
#pragma unroll
        for (int i = 0; i < 4; ++i) { tu[i] = __builtin_nontemporal_load((const f32x4*)(p.in[28] + (size_t)wu * 1024) + lane_ + 64 * i); tv[i] = __builtin_nontemporal_load((const f32x4*)(p.in[29] + (size_t)wu * 1024) + lane_ + 64 * i); }
        f32x4 acc[8];
#pragma unroll
        for (int kj = 0; kj < 8; ++kj) acc[kj] = (f32x4){0.f, 0.f, 0.f, 0.f};
#pragma unroll
        for (int ksp = 0; ksp < 4; ++ksp) {
            const bf16x8 a = *(const bf16x8*)(Qs + (wv_ * 16 + fr_) * 136 + ksp * 32 + fq_ * 8);
#pragma unroll
            for (int kj = 0; kj < 8; ++kj) { const bf16x8 b = *(const bf16x8*)(SK + (kj * 16 + fr_) * 136 + ksp * 32 + fq_ * 8); acc[kj] = MFMA16(a, b, acc[kj]); }
        }
#define KEY(kj, r) f2key(__uint_as_float((__float_as_uint(acc[kj][r]) & ~127u) | (unsigned)(127 - ((kj) * 16 + fr_))))
#define CEX(a, b) do { const int hi_ = max(a, b), lo_ = min(a, b); a = hi_; b = lo_; } while (0)
#define ROW_INIT(r) int a0##r = KEY(0, r), a1##r = KEY(1, r), a2##r = KEY(2, r), a3##r = KEY(3, r), a4##r = KEY(4, r), a5##r = KEY(5, r), a6##r = KEY(6, r), a7##r = KEY(7, r), rs##r = 0; \
        CEX(a0##r, a1##r); CEX(a2##r, a3##r); CEX(a4##r, a5##r); CEX(a6##r, a7##r); CEX(a0##r, a2##r); CEX(a1##r, a3##r); CEX(a4##r, a6##r); CEX(a5##r, a7##r); \
        CEX(a1##r, a2##r); CEX(a5##r, a6##r); CEX(a0##r, a4##r); CEX(a3##r, a7##r); CEX(a1##r, a5##r); CEX(a2##r, a6##r); CEX(a1##r, a4##r); CEX(a3##r, a6##r); \
        CEX(a2##r, a4##r); CEX(a3##r, a5##r); CEX(a3##r, a4##r);
#define ROW_STEP(r) do { const int m_ = imax16(a0##r); const bool w_ = a0##r == m_; \
        a0##r = w_ ? a1##r : a0##r; a1##r = w_ ? a2##r : a1##r; a2##r = w_ ? a3##r : a2##r; a3##r = w_ ? a4##r : a3##r; a4##r = w_ ? a5##r : a4##r; a5##r = w_ ? a6##r : a5##r; a6##r = w_ ? a7##r : a6##r; a7##r = w_ ? (int)0x80000000 : a7##r; \
        rs##r = (fr_ == it) ? m_ : rs##r; } while (0)
        ROW_INIT(0) ROW_INIT(1) ROW_INIT(2) ROW_INIT(3)
#pragma unroll 1
        for (int it = 0; it < 16; ++it) { ROW_STEP(0); ROW_STEP(1); ROW_STEP(2); ROW_STEP(3); }
        float res[4]; res[0] = key2f(rs0); res[1] = key2f(rs1); res[2] = key2f(rs2); res[3] = key2f(rs3);
#undef KEY
#undef CEX
#undef ROW_INIT
#undef ROW_STEP
#pragma unroll
        for (int r = 0; r < 4; ++r) keys[((size_t)(n0 + wv_ * 16 + fq_ * 4 + r) * 16 + g) * 16 + fr_] = res[r];
        { float mu_ = 0.f, mv_ = 0.f;
#pragma unroll
          for (int i = 0; i < 4; ++i) { mu_ = fmaxf(mu_, fmaxf(fmaxf(fabsf(tu[i][0]), fabsf(tu[i][1])), fmaxf(fabsf(tu[i][2]), fabsf(tu[i][3])))); mv_ = fmaxf(mv_, fmaxf(fmaxf(fabsf(tv[i][0]), fabsf(tv[i][1])), fmaxf(fabsf(tv[i][2]), fabsf(tv[i][3])))); }
#pragma unroll
          for (int o = 1; o < 64; o <<= 1) { mu_ = fmaxf(mu_, __shfl_xor(mu_, o)); mv_ = fmaxf(mv_, __shfl_xor(mv_, o)); }
          const float su = mu_ > 0.f ? 440.f / mu_ : 1.f, sv = mv_ > 0.f ? 440.f / mv_ : 1.f;
          u32x4 wu4, wv4;
          { int q_ = __builtin_amdgcn_cvt_pk_fp8_f32(tu[0][0] * su, tu[0][1] * su, 0, false); wu4.x = (unsigned)__builtin_amdgcn_cvt_pk_fp8_f32(tu[0][2] * su, tu[0][3] * su, q_, true); }
          { int q_ = __builtin_amdgcn_cvt_pk_fp8_f32(tu[1][0] * su, tu[1][1] * su, 0, false); wu4.y = (unsigned)__builtin_amdgcn_cvt_pk_fp8_f32(tu[1][2] * su, tu[1][3] * su, q_, true); }
          { int q_ = __builtin_amdgcn_cvt_pk_fp8_f32(tu[2][0] * su, tu[2][1] * su, 0, false); wu4.z = (unsigned)__builtin_amdgcn_cvt_pk_fp8_f32(tu[2][2] * su, tu[2][3] * su, q_, true); }
          { int q_ = __builtin_amdgcn_cvt_pk_fp8_f32(tu[3][0] * su, tu[3][1] * su, 0, false); wu4.w = (unsigned)__builtin_amdgcn_cvt_pk_fp8_f32(tu[3][2] * su, tu[3][3] * su, q_, true); }
          { int q_ = __builtin_amdgcn_cvt_pk_fp8_f32(tv[0][0] * sv, tv[0][1] * sv, 0, false); wv4.x = (unsigned)__builtin_amdgcn_cvt_pk_fp8_f32(tv[0][2] * sv, tv[0][3] * sv, q_, true); }
          { int q_ = __builtin_amdgcn_cvt_pk_fp8_f32(tv[1][0] * sv, tv[1][1] * sv, 0, false); wv4.y = (unsigned)__builtin_amdgcn_cvt_pk_fp8_f32(tv[1][2] * sv, tv[1][3] * sv, q_, true); }
          { int q_ = __builtin_amdgcn_cvt_pk_fp8_f32(tv[2][0] * sv, tv[2][1] * sv, 0, false); wv4.z = (unsigned)__builtin_amdgcn_cvt_pk_fp8_f32(tv[2][2] * sv, tv[2][3] * sv, q_, true); }
          { int q_ = __builtin_amdgcn_cvt_pk_fp8_f32(tv[3][0] * sv, tv[3][1] * sv, 0, false); wv4.w = (unsigned)__builtin_amdgcn_cvt_pk_fp8_f32(tv[3][2] * sv, tv[3][3] * sv, q_, true); }
          *(u32x4*)(p.ws + OFF_U8 + (size_t)wu * 1024 + lane_ * 16) = wu4; *(u32x4*)(p.ws + OFF_V8 + (size_t)wu * 1024 + lane_ * 16) = wv4;
          if (lane_ == 0) { float* uinv_ = (float*)(p.ws + OFF_UINV); uinv_[wu] = mu_ > 0.f ? mu_ * (1.f / 440.f) : 1.f; uinv_[16384 + wu] = mv_ > 0.f ? mv_ * (1.f / 440.f) : 1.f; } }
        __syncthreads();
    }
#undef PK_ISSUE
#undef RETID
}

typedef float f32x2v __attribute__((ext_vector_type(2)));
#define F8LO(x) __builtin_amdgcn_cvt_pk_f32_fp8((int)(x), false)
#define F8HI(x) __builtin_amdgcn_cvt_pk_f32_fp8((int)(x), true)
__device__ __forceinline__ f32x2v fma2(f32x2v a, f32x2v b, f32x2v c) { return __builtin_elementwise_fma(a, b, c); }
__device__ __forceinline__ float dot16f8(const u32x4 r, const f32x2v (&t)[8]) {
    f32x2v d = F8LO(r.x) * t[0];
    d = fma2(F8HI(r.x), t[1], d); d = fma2(F8LO(r.y), t[2], d); d = fma2(F8HI(r.y), t[3], d);
    d = fma2(F8LO(r.z), t[4], d); d = fma2(F8HI(r.z), t[5], d); d = fma2(F8LO(r.w), t[6], d); d = fma2(F8HI(r.w), t[7], d);
    return d.x + d.y;
}
__device__ const unsigned PK_PAIRS[16] = {0xe0331000u, 0xf0401101u, 0xff411202u, 0xff421303u, 0xff501404u, 0xff511505u, 0xff601606u, 0xff611707u, 0xff702008u, 0xff712109u, 0xff80220au, 0xff90230bu, 0xffa0240cu, 0xffb0300du, 0xffc0310eu, 0xffd0320fu};
template <int EMASK, int DUMMY> __device__ __forceinline__ void phase_peer_u(const Params& p, float* lds) {
    const int tid = tid_opaque(), lane = tid & 63, wv = tid >> 6;
    int* wl_e = (int*)lds + wv * 512; float* wl_g = (float*)(wl_e + 128); float* wl_us = wl_g + 128; float* wl_vs = wl_us + 128;
    const float* keys = (const float*)(p.ws + OFF_KEYS); const float* ss2 = (const float*)(p.ws + OFF_SS2P);
    const unsigned char* U8 = p.ws + OFF_U8; const unsigned char* V8 = p.ws + OFF_V8; const float* uinv = (const float*)(p.ws + OFF_UINV); const float* vinv = uinv + 16384;
    const float* g2 = p.in[25]; const float* fg = p.in[30];
    const bf16_t* x1b = (const bf16_t*)(p.ws + OFF_X1B); float* ACT = (float*)(p.ws + OFF_ACT + (DUMMY ? 16 * MiB : 0)); int* EID = (int*)(p.ws + OFF_EID + (DUMMY ? 16 * MiB : 0));
    for (int n = blockIdx.x * 8 + wv; n < NTOK; n += gridDim.x * 8) {
        const float rs2 = __builtin_amdgcn_rsqf(sum16(ss2[(size_t)(lane & 15) * NTOK + n]) * (1.f / 1024.f) + 1e-6f);
#pragma unroll 1
        for (int rr = 0; rr < 2; ++rr) {
            const int h = rr * 4 + (lane >> 4), jj = lane & 15;
            const float* kp = keys + ((size_t)n * 16 + h * 2) * 16;
            const float k0 = kp[jj], k1own = kp[16 + jj];
            const unsigned pt4 = PK_PAIRS[jj];
            int cand[4];
#pragma unroll
            for (int i = 0; i < 4; ++i) { const unsigned cd = (pt4 >> (8 * i)) & 255u;
                const float sum = kp[cd >> 4] + kp[16 + (cd & 15u)];
                cand[i] = (cd == 255u) ? (int)0x80000000 : f2key(__uint_as_float((__float_as_uint(sum) & ~255u) | cd)); }
            int resi = 0;
#pragma unroll 1
            for (int it = 0; it < 16; ++it) {
                const int m = imax16(max(max(cand[0], cand[1]), max(cand[2], cand[3])));
#pragma unroll
                for (int i = 0; i < 4; ++i) cand[i] = (cand[i] == m) ? (int)0x80000000 : cand[i];
                resi = (jj == it) ? m : resi;
            }
            const float res = key2f(resi);
            const unsigned code = __float_as_uint(res) & 255u; const int p0 = code >> 4, p1 = code & 15;
            const int i0 = 127 - (int)(__float_as_uint(k0) & 127u), i1 = 127 - (int)(__float_as_uint(k1own) & 127u);
            const int gi0 = __shfl(i0, (lane & 48) + p0), gi1 = __shfl(i1, (lane & 48) + p1);
            const float mx = max16(res); const float ex = __expf((res - mx) * rs2); const float sm = sum16(ex);
            const int e = gi0 * 128 + gi1;
            wl_e[h * 16 + jj] = e; wl_g[h * 16 + jj] = ex / sm; wl_us[h * 16 + jj] = uinv[e]; wl_vs[h * 16 + jj] = vinv[e];
        }
        f32x2v tok[8];
#pragma unroll
        for (int i = 0; i < 4; ++i) { const f32x4 t4 = ld4bf(x1b + (size_t)n * 1024 + i * 256 + lane * 4) * rs2 * ((const f32x4*)g2)[lane + 64 * i]; tok[2 * i] = (f32x2v){t4[0], t4[1]}; tok[2 * i + 1] = (f32x2v){t4[2], t4[3]}; }
        float act0 = 0.f, act1 = 0.f;
        const int jl = (lane & 7) * 8 + (lane >> 3);
        {
            u32x4 ra[2][8]; float rj[8];
#define U_LOAD(bufi, bb) do { _Pragma("unroll") for (int q = 0; q < 8; ++q) { const int e = __builtin_amdgcn_readfirstlane(wl_e[(bb) * 8 + q]); ra[bufi][q] = *(const u32x4*)(U8 + (size_t)(e & EMASK) * 1024 + lane * 16); } } while (0)
            U_LOAD(0, 0);
#pragma unroll
            for (int bb = 0; bb < 16; ++bb) {
                if (bb + 1 < 16) U_LOAD((bb + 1) & 1, bb + 1);
                asm volatile("" ::: "memory");
                float d[8];
#pragma unroll
                for (int q = 0; q < 8; ++q) d[q] = dot16f8(ra[bb & 1][q], tok);
#pragma unroll
                for (int off = 4; off >= 1; off >>= 1) {
                    const bool up = (lane & (off * 8)) != 0;
#pragma unroll
                    for (int i = 0; i < off; ++i) { const float x = d[i], y = d[i + off]; const float send = up ? x : y, keep = up ? y : x; d[i] = keep + __shfl_xor(send, off * 8); }
                }
                rj[bb & 7] = d[0];
                if ((bb & 7) == 7) {
#pragma unroll
                    for (int off = 4; off >= 1; off >>= 1) {
                        const bool up = (lane & off) != 0;
#pragma unroll
                        for (int i = 0; i < off; ++i) { const float x = rj[i], y = rj[i + off]; const float send = up ? x : y, keep = up ? y : x; rj[i] = keep + __shfl_xor(send, off); }
                    }
                    const int grp = bb >> 3;
                    const float tot = rj[0] * wl_us[grp * 64 + jl];
                    const float a = 0.5f * tot * (1.f + erff(tot * 0.70710678118f)) * wl_g[grp * 64 + jl] * wl_vs[grp * 64 + jl];
                    if (grp == 0) act0 = a; else act1 = a;
                }
            }
#undef U_LOAD
        }
        ACT[(size_t)n * 128 + lane] = act0; ACT[(size_t)n * 128 + 64 + lane] = act1;
        EID[(size_t)n * 128 + lane] = wl_e[lane]; EID[(size_t)n * 128 + 64 + lane] = wl_e[64 + lane];
    }
}

#ifndef V2_NRB
#define V2_NRB 3
#endif
__device__ __forceinline__ void phase_peer_v2(const Params& p, unsigned char* smem_) {
    constexpr int NRB = V2_NRB, NR = 1 << NRB, NB = NR * 8, BPL = NB >= 64 ? NB / 64 : 1, ESH = 14 - NRB;
    const int tid = tid_opaque(), lane = tid & 63, wv = tid >> 6;
    unsigned long long* SP = (unsigned long long*)(smem_ + wv * (8192 + 12 * NB));
    int* cnt = (int*)(SP + 1024);
    const unsigned char* V8 = p.ws + OFF_V8; const float* ACT = (const float*)(p.ws + OFF_ACT); const int* EID = (const int*)(p.ws + OFF_EID);
    const float* fg = p.in[30]; float* out = p.out; const bf16_t* x1b = (const bf16_t*)(p.ws + OFF_X1B);
    const int gw = blockIdx.x * 8 + wv, nw = gridDim.x * 8;
    for (int g0 = gw; g0 < NTOK; g0 += 8 * nw) {
#pragma unroll
        for (int i = 0; i < BPL; ++i) if (lane + 64 * i < NB) cnt[lane + 64 * i] = 0;
        int ev[16]; float av[16];
#pragma unroll
        for (int i = 0; i < 16; ++i) { const int t = i >> 1, j = (i & 1) * 64 + lane, n = g0 + t * nw;
            const bool ok = n < NTOK;
            ev[i] = ok ? EID[(size_t)n * 128 + j] : 0;
            av[i] = ok ? ACT[(size_t)n * 128 + (j & 64) + (((j & 7) << 3) | ((j >> 3) & 7))] : 0.f; }
#pragma unroll
        for (int i = 0; i < 16; ++i) atomicAdd(&cnt[(ev[i] >> ESH) * 8 + (i >> 1)], 1);
        {
          int c[BPL]; int sc = 0;
#pragma unroll
          for (int i = 0; i < BPL; ++i) { c[i] = (BPL * lane + i < NB) ? cnt[BPL * lane + i] : 0; sc += c[i]; }
          const int tot = sc;
#pragma unroll
          for (int o = 1; o < 64; o <<= 1) { const int tt = __shfl_up(sc, o); if (lane >= o) sc += tt; }
          int ex = sc - tot;
#pragma unroll
          for (int i = 0; i < BPL; ++i) { if (BPL * lane + i < NB) { cnt[NB + BPL * lane + i] = ex; cnt[2 * NB + BPL * lane + i] = ex; } ex += c[i]; } }
#pragma unroll
        for (int i = 0; i < 16; ++i) { const int pos = atomicAdd(&cnt[2 * NB + (ev[i] >> ESH) * 8 + (i >> 1)], 1);
            SP[pos] = ((unsigned long long)(unsigned)ev[i] << 32) | (unsigned long long)__float_as_uint(av[i]); }
        f32x2v ac[8][8];
#pragma unroll
        for (int t = 0; t < 8; ++t)
#pragma unroll
            for (int k = 0; k < 8; ++k) ac[t][k] = (f32x2v){0.f, 0.f};
#pragma unroll 1
        for (int r = 0; r < NR; ++r) {
#pragma unroll
            for (int t = 0; t < 8; ++t) {
                const int beg = __builtin_amdgcn_readfirstlane(cnt[NB + r * 8 + t]), end = beg + __builtin_amdgcn_readfirstlane(cnt[r * 8 + t]);
#pragma unroll 1
                for (int b0 = beg; b0 < end; b0 += 8) {
                    u32x4 ra[8]; float aq[8];
#pragma unroll
                    for (int q = 0; q < 8; ++q) { ra[q] = (u32x4){0u, 0u, 0u, 0u}; aq[q] = 0.f;
                        if (b0 + q < end) { const unsigned long long pr = SP[b0 + q];
                            const unsigned e = (unsigned)__builtin_amdgcn_readfirstlane((int)(pr >> 32)); aq[q] = __uint_as_float((unsigned)__builtin_amdgcn_readfirstlane((int)(unsigned)pr));
                            ra[q] = *(const u32x4*)(V8 + (size_t)e * 1024 + lane * 16); } }
#pragma unroll
                    for (int q = 0; q < 8; ++q) {
                        if (b0 + q < end) {
                            const f32x2v a2 = (f32x2v){aq[q], aq[q]};
                            ac[t][0] = fma2(F8LO(ra[q].x), a2, ac[t][0]); ac[t][1] = fma2(F8HI(ra[q].x), a2, ac[t][1]); ac[t][2] = fma2(F8LO(ra[q].y), a2, ac[t][2]); ac[t][3] = fma2(F8HI(ra[q].y), a2, ac[t][3]);
                            ac[t][4] = fma2(F8LO(ra[q].z), a2, ac[t][4]); ac[t][5] = fma2(F8HI(ra[q].z), a2, ac[t][5]); ac[t][6] = fma2(F8LO(ra[q].w), a2, ac[t][6]); ac[t][7] = fma2(F8HI(ra[q].w), a2, ac[t][7]);
                        } }
                }
            }
        }
#pragma unroll
        for (int t = 0; t < 8; ++t) { const int n = g0 + t * nw;
            if (n < NTOK) {
                f32x4 acc[4]; float ss = 0.f;
#pragma unroll
                for (int i = 0; i < 4; ++i) { acc[i] = (f32x4){ac[t][2 * i].x, ac[t][2 * i].y, ac[t][2 * i + 1].x, ac[t][2 * i + 1].y} + ld4bf(x1b + (size_t)n * 1024 + i * 256 + lane * 4);
                    ss += (acc[i][0] * acc[i][0] + acc[i][1] * acc[i][1]) + (acc[i][2] * acc[i][2] + acc[i][3] * acc[i][3]); }
                ss = wave_sum(ss); const float rs = __builtin_amdgcn_rsqf(ss * (1.f / 1024.f) + 1e-6f);
#pragma unroll
                for (int i = 0; i < 4; ++i) ((f32x4*)(out + (size_t)n * 1024))[lane + 64 * i] = acc[i] * rs * ((const f32x4*)fg)[lane + 64 * i];
            } }
    }
}

#define XB_TMO      128
#define XB_XCNT(j)  (256  + 64 * (j))
#define XB_XSUB(j)  (1280 + 64 * (j))
#define XB_XGEN(j)  (2304 + 64 * (j))
#define XB_TOP      3328
#define XB_TOPGEN   3392
#define XCD_BAR_WORDS 3456
#define XB_SPIN_CAP (1u << 18)

__device__ __forceinline__ unsigned xb_ld(unsigned* p)              { return __hip_atomic_load(p, __ATOMIC_RELAXED, __HIP_MEMORY_SCOPE_AGENT); }
__device__ __forceinline__ unsigned xb_add(unsigned* p, unsigned v) { return __hip_atomic_fetch_add(p, v, __ATOMIC_RELAXED, __HIP_MEMORY_SCOPE_AGENT); }
__device__ __forceinline__ unsigned xb_xcc_id() { return (unsigned)__builtin_amdgcn_s_getreg((3 << 11) | 20) & 0xFu; }
#define XB_SPIN(cond, bar) do { unsigned _sp = 0; while (cond) { __builtin_amdgcn_s_sleep(1); \
    if ((++_sp & 255u) == 0u) { if (xb_ld(&(bar)[XB_TMO])) break; if (_sp > XB_SPIN_CAP) { atomicAdd(&(bar)[XB_TMO], 1u); break; } } } } while (0)

struct XcdBarrier {
    unsigned* bar; unsigned x;
    volatile LAS unsigned* st;
};

__device__ __forceinline__ XcdBarrier xcd_barrier_post(unsigned* bar, volatile LAS unsigned* st) {
    XcdBarrier b; b.bar = bar; b.x = xb_xcc_id(); b.st = st;
    if (threadIdx.x == 0) (void)xb_add(&bar[XB_XCNT(b.x)], 1u);
    return b;
}
__device__ __forceinline__ void xcd_barrier_complete(unsigned* bar, unsigned x, unsigned& nloc, unsigned& nx) {
    const unsigned G = gridDim.x * gridDim.y * gridDim.z;
    unsigned sum, cnt, mine, sp = 0u;
    for (;;) {
        sum = 0u; cnt = 0u; mine = 0u;
#pragma unroll
        for (unsigned j = 0; j < 16; ++j) { const unsigned c = xb_ld(&bar[XB_XCNT(j)]); sum += c; cnt += (c > 0u) ? 1u : 0u; mine = (j == x) ? c : mine; }
        if (sum == G) break;
        __builtin_amdgcn_s_sleep(1);
        if ((++sp & 255u) == 0u) { if (xb_ld(&bar[XB_TMO])) break; if (sp > XB_SPIN_CAP) { atomicAdd(&bar[XB_TMO], 1u); break; } }
    }
    nloc = mine > 0u ? mine : 1u; nx = cnt > 0u ? cnt : 1u;
}

__device__ __forceinline__ void xcd_barrier(const XcdBarrier& b) {
    asm volatile("s_waitcnt vmcnt(0)" ::: "memory");
    __syncthreads();
    if (threadIdx.x == 0) {
        unsigned* bar = b.bar;
        __builtin_amdgcn_s_waitcnt(0);
        unsigned nloc = b.st[0], nx = b.st[1];
        if (nloc == 0u) { xcd_barrier_complete(bar, b.x, nloc, nx); b.st[0] = nloc; b.st[1] = nx; }
        const unsigned old = xb_add(&bar[XB_XSUB(b.x)], 1u);
        const unsigned gen = old / nloc;
        if (old + 1u == (gen + 1u) * nloc) {
            __builtin_amdgcn_fence(__ATOMIC_RELEASE, "agent");
            asm volatile("s_waitcnt vmcnt(0)" ::: "memory");
            const unsigned og = xb_add(&bar[XB_TOP], 1u);
            const unsigned tg = og / nx;
            if (og + 1u == (tg + 1u) * nx) xb_add(&bar[XB_TOPGEN], 1u);
            else XB_SPIN(xb_ld(&bar[XB_TOPGEN]) == tg, bar);
            __builtin_amdgcn_fence(__ATOMIC_ACQUIRE, "agent");
            xb_add(&bar[XB_XGEN(b.x)], 1u);
            asm volatile("s_waitcnt vmcnt(0)" ::: "memory");
        } else {
            XB_SPIN(xb_ld(&bar[XB_XGEN(b.x)]) == gen, bar);
            __builtin_amdgcn_fence(__ATOMIC_ACQUIRE, "agent");
            asm volatile("s_waitcnt vmcnt(0)" ::: "memory");
        }
    }
    __syncthreads();
}


extern __shared__ __attribute__((aligned(16))) unsigned char smem[];
__global__ void __launch_bounds__(512, 2) mega_kernel(Params p) {
    cg::grid_group grid = cg::this_grid();
    float* lds = (float*)smem;
    PG8_LAS unsigned char* ldsa = (PG8_LAS unsigned char*)smem;
    unsigned char* ws = p.ws;
    const int G = gridDim.x;
    unsigned tacc = 0; unsigned long long klast = 0;
#define KSTAMP(k) do { if (STAMP_SEL >= 100) { const unsigned long long _t = __builtin_amdgcn_s_memrealtime(); if (STAMP_SEL == 100 + (k) || (STAMP_SEL == 999 && (k) != 99)) tacc += (unsigned)(_t - klast); klast = _t; } } while (0)
    KSTAMP(99);
    volatile LAS unsigned* xst = (volatile LAS unsigned*)((PG8_LAS unsigned char*)smem + 163840 - 16);
    if (threadIdx.x == 0) { xst[0] = 0u; xst[1] = 0u; }
    __syncthreads();
    const XcdBarrier xbar = xcd_barrier_post((unsigned*)(ws + OFF_BAR), xst);
#if PHMASK & 1
    phase0(p, lds);
    KSTAMP(21);
#endif
    xcd_barrier(xbar);
    KSTAMP(0);
#if PHMASK & 2
    { pg8::Gemm g{(const bf16_t*)(ws + OFF_XB), (const bf16_t*)(ws + OFF_WINT), NTOK, 5888, 1024}; pg8::StaticOrder S; S.init(NTOK, 5888, G, (int)blockIdx.x);
      EpiZ E{(bf16_t*)(ws + OFF_ZRW), (bf16_t*)(ws + OFF_ZML), (bf16_t*)(ws + OFF_ZG)};
      pg8::gemm_phase<EpiZ, pg8::StaticOrder>(ldsa, g, S, E, nullptr); }
#endif
    xcd_barrier(xbar);
    KSTAMP(1);
#if PHMASK & 4
    phase_rwkv_prep(p, smem, tacc);
#endif
    xcd_barrier(xbar);
    KSTAMP(2);
#if PHMASK & 8
    if (blockIdx.x < 32) phase_rwkv_scan4(p, smem, blockIdx.x);
#endif
#if PHMASK & 16
    if (blockIdx.x >= 32) phase_ml_cloc2(p, smem, blockIdx.x - 32, G - 32);
#endif
    if (p.cg_sync) grid.sync(); else xcd_barrier(xbar);
    KSTAMP(3);
#if PHMASK & 32
    phase_ml_scan(p);
    phase_rwkv_post(p);
#endif
    xcd_barrier(xbar);
    KSTAMP(4);
#if PHMASK & 64
    phase_ml_out2(p, smem);
#endif
    xcd_barrier(xbar);
    KSTAMP(5);
#if PHMASK & 128
    { MergeOrder S; S.init(NTOK, 1024, G, (int)blockIdx.x);
      pg8::Gemm g{(const bf16_t*)(ws + OFF_Y), (const bf16_t*)(ws + OFF_PRWT), NTOK, 1024, 512};
      EpiMerge E{EpiMerge1{(const bf16_t*)(ws + OFF_ZG), p.in[21], (bf16_t*)(ws + OFF_T)}, EpiMerge2{(const bf16_t*)(ws + OFF_ZG), p.in[21], (const bf16_t*)(ws + OFF_T), (bf16_t*)(ws + OFF_MERGED)}};
      if (G == 256) pg8::gemm_phase<EpiMerge, MergeOrder>(ldsa, g, S, E, nullptr);
      else { pg8::StaticOrder S1; S1.init(NTOK, 1024, G, (int)blockIdx.x);
        { pg8::gemm_phase<EpiMerge1, pg8::StaticOrder>(ldsa, g, S1, E.e1, nullptr); }
        { pg8::Gemm g2{(const bf16_t*)(ws + OFF_YML), (const bf16_t*)(ws + OFF_PMLT), NTOK, 1024, 512}; pg8::gemm_phase<EpiMerge2, pg8::StaticOrder>(ldsa, g2, S1, E.e2, nullptr); } } }
#endif
    xcd_barrier(xbar);
    KSTAMP(6);
#if PHMASK & 256
    { pg8::Gemm g{(const bf16_t*)(ws + OFF_MERGED), (const bf16_t*)(ws + OFF_WOUTT), NTOK, 1024, 1024}; pg8::StaticOrder S; S.init(NTOK, 1024, G, (int)blockIdx.x);
      EpiOut E{p.in[0], p.out, (bf16_t*)(ws + OFF_X1B), (float*)(ws + OFF_SS2P)};
      pg8::gemm_phase<EpiOut, pg8::StaticOrder>(ldsa, g, S, E, nullptr); }
#endif
    xcd_barrier(xbar);
    KSTAMP(7);
#if PHMASK & 512
    { pg8::Gemm g{(const bf16_t*)(ws + OFF_X1B), (const bf16_t*)(ws + OFF_WQT), NTOK, 2048, 1024}; pg8::StaticOrder S; S.init(NTOK, 2048, G, (int)blockIdx.x);
      EpiQ E{(bf16_t*)(ws + OFF_Q)};
      pg8::gemm_phase<EpiQ, pg8::StaticOrder>(ldsa, g, S, E, nullptr); }
#endif
    xcd_barrier(xbar);
    KSTAMP(8);
#if PHMASK & 1024
    phase_peer_keys(p, smem);
#endif
    xcd_barrier(xbar);
    KSTAMP(9);
#if PHMASK & 2048
#ifdef PROBE_L2
    phase_peer_u<PROBE_L2, 1>(p, lds);
    xcd_barrier(xbar);
    KSTAMP(12);
#endif
    phase_peer_u<16383, 0>(p, lds);
    xcd_barrier(xbar);
    KSTAMP(11);
    phase_peer_v2(p, smem);
#endif
    KSTAMP(10);
#if STAMP_SEL
    if (blockIdx.x == 0 && threadIdx.x < 64) { const unsigned long long t0 = __builtin_amdgcn_s_memrealtime(); const unsigned long long want = (unsigned long long)__builtin_amdgcn_readfirstlane(tacc) * (STAMP_SEL == 999 ? 1ull : 10ull); while (__builtin_amdgcn_s_memrealtime() - t0 < want) __builtin_amdgcn_s_sleep(8); }
#endif
}

extern "C" void kernel_launch(void* const* d_in, const int* in_sizes, int n_in, void* d_out, int out_size, void* d_ws, size_t ws_size, hipStream_t stream) {
    constexpr size_t kDynLds = 163840;
    static int grid_blocks = 0;
    if (!grid_blocks) {
        int dev = 0, cus = 0, per_cu = 0;
        (void)hipGetDevice(&dev);
        (void)hipDeviceGetAttribute(&cus, hipDeviceAttributeMultiprocessorCount, dev);
        (void)hipFuncSetAttribute((const void*)mega_kernel, hipFuncAttributeMaxDynamicSharedMemorySize, (int)kDynLds);
        (void)hipOccupancyMaxActiveBlocksPerMultiprocessor(&per_cu, mega_kernel, 512, kDynLds);
        if (per_cu < 1) { fprintf(stderr, "occupancy query says %d blocks per CU\n", per_cu); per_cu = 1; }
        if (per_cu > 1) per_cu = 1;
        grid_blocks = cus * per_cu;
        if (ws_size < 256 * MiB) fprintf(stderr, "workspace too small: %zu\n", ws_size);
    }
    (void)hipMemsetAsync((unsigned char*)d_ws + OFF_BAR, 0, XCD_BAR_WORDS * 4, stream);
    Params p{};
    for (int i = 0; i < 31; ++i) p.in[i] = (const float*)d_in[i];
    p.out = (float*)d_out; p.ws = (unsigned char*)d_ws; p.cg_sync = 0; p.pad = 0;
    void* args[] = {&p};
    hipError_t e = hipLaunchCooperativeKernel((void*)mega_kernel, dim3(grid_blocks), dim3(512), args, kDynLds, stream);
    if (e != hipSuccess) fprintf(stderr, "cooperative launch failed: %s (grid %d)\n", hipGetErrorString(e), grid_blocks);
}
```

```cpp
#include <hip/hip_runtime.h>
#include <hip/hip_cooperative_groups.h>
#include <cstdio>
namespace cg = cooperative_groups;
#define DUPMASK 0
namespace pg8 {
#define PG8_LAS __attribute__((address_space(3)))
typedef unsigned short bf16_t;
typedef short bf16x8 __attribute__((ext_vector_type(8)));
typedef float f32x4 __attribute__((ext_vector_type(4)));
typedef unsigned u32x4 __attribute__((ext_vector_type(4)));
constexpr int BM = 256, BK = 64, HALF = 128, HTB = HALF * BK * 2  , STAGE_BYTES = 8 * HTB, NXCD = 8, WGM = 8;

__host__ __device__ __forceinline__ int lds_byte(int r, int c) { const int st = (r >> 4) * 2 + (c >> 5), rr = r & 15, cc = c & 31, ob = rr * 64 + cc * 2; return st * 1024 + (ob ^ (((ob >> 9) & 1) << 5)); }
__host__ __device__ __forceinline__ void stage_rc(int b, int& R, int& C) { const int st = b / 1024, sb = b % 1024, swz = sb ^ (((sb >> 9) & 1) << 5); R = (st >> 1) * 16 + swz / 64; C = (st & 1) * 32 + (swz % 64) / 2; }
__host__ __device__ __forceinline__ int perm32(int rho) { const int n = rho >> 4, i = rho & 15; return 8 * (i >> 2) + 4 * n + (i & 3); }

struct Unit { int pm, pn; };
struct Gemm { const bf16_t* A; const bf16_t* Bt; int M, N, K; };

struct StaticOrder {
    int nM, nN, nwg, G, c;
    __host__ __device__ void init(int M, int N, int G_, int c_) { nM = M / BM; nN = N / BM; nwg = nM * nN; G = G_; c = c_; }
    __host__ __device__ bool next(int i, Unit& u) const {
        const long L = (long)i * G + c; if (L >= nwg) return false;
        int wgid = (int)L; { const int q = nwg / NXCD, r = nwg % NXCD, xcd = wgid % NXCD, off = wgid / NXCD; wgid = (xcd < r ? xcd * (q + 1) : r * (q + 1) + (xcd - r) * q) + off; }
        const int nig = WGM * nN, gid = wgid / nig, fm = gid * WGM, gsz = (nM - fm) < WGM ? (nM - fm) : WGM;
        u.pm = fm + ((wgid % nig) % gsz); u.pn = (wgid % nig) / gsz; return true;
    }
    __device__ __forceinline__ void a_ready(const Unit&) const {}
    __device__ __forceinline__ void done(const Unit&) const {}
};
__device__ __forceinline__ unsigned cvt_pk_bf16(float lo, float hi) { unsigned r; asm volatile("v_cvt_pk_bf16_f32 %0, %1, %2" : "=v"(r) : "v"(lo), "v"(hi)); return r; }
typedef float f32x2 __attribute__((ext_vector_type(2)));
template <class Epi, class Sched, bool STAMP = false>
__device__ __forceinline__ void gemm_phase(PG8_LAS unsigned char* lds, const Gemm g, const Sched& S, const Epi& E, unsigned long long* stamps) {
    int tid = threadIdx.x; asm volatile("" : "+v"(tid)); const int wid = __builtin_amdgcn_readfirstlane(tid >> 6), lane = tid & 63, wr = wid >> 2, wc = wid & 3, fr = lane & 15, fq = lane >> 4;
    const int K = g.K, nt = K / BK;
    int ts_lo = 0, ts_hi = 0, nts = 0; const unsigned long long rt_entry = STAMP ? (unsigned long long)wall_clock64() : 0ull;
#define PG8_STAMP() do { if (STAMP && wid == 0 && nts < 64) { const unsigned long long _c = (unsigned long long)clock64(); \
        ts_lo = (lane == nts) ? (int)(unsigned)_c : ts_lo; ts_hi = (lane == nts) ? (int)(unsigned)(_c >> 32) : ts_hi; ++nts; } } while (0)
    PG8_STAMP();
    unsigned voffA[2], voffB[2];
#pragma unroll
    for (int i = 0; i < 2; ++i) { int R, C; stage_rc(tid * 16 + i * 8192, R, C); const int Rb = Epi::PERM ? ((R & ~31) + perm32(R & 31)) : R;
        voffA[i] = (unsigned)(R * K + C) * 2u; voffB[i] = (unsigned)(Rb * K + C) * 2u; }
    const size_t kstep = (size_t)(BK * 2);
    const size_t hstep = (size_t)HALF * K * 2;
    const size_t tstep = 2 * hstep;
    const unsigned ldsw = (unsigned)wid * 1024u;
    const int aoff = lds_byte(wr * 64 + fr, fq * 8), boff = lds_byte(wc * 32 + fr, fq * 8);
#define PG8_SA(b, h) (((b) * 2 + (h)) * HTB)
#define PG8_SB(b, h) ((4 + (b) * 2 + (h)) * HTB)
#define PG8_STAGE(bufoff, gbase, voff) do { _Pragma("unroll") for (int _i = 0; _i < 2; ++_i) \
        __builtin_amdgcn_global_load_lds((const unsigned*)((const char*)(gbase) + (voff)[_i]), (PG8_LAS unsigned*)(lds + (bufoff) + ldsw + _i * 8192), 16, 0, 0); } while (0)
#define PG8_LDA(dst, b, h) do { _Pragma("unroll") for (int m = 0; m < 4; ++m) _Pragma("unroll") for (int k = 0; k < 2; ++k) dst[m][k] = *(const PG8_LAS bf16x8*)(lds + PG8_SA(b, h) + aoff + m * 2048 + k * 1024); } while (0)
#define PG8_LDB(dst, b, h) do { _Pragma("unroll") for (int n = 0; n < 2; ++n) _Pragma("unroll") for (int k = 0; k < 2; ++k) dst[n][k] = *(const PG8_LAS bf16x8*)(lds + PG8_SB(b, h) + boff + n * 2048 + k * 1024); } while (0)
#define PG8_MMA(ai, bj, At, Bt) do { __builtin_amdgcn_s_setprio(1); _Pragma("unroll") for (int m = 0; m < 4; ++m) _Pragma("unroll") for (int n = 0; n < 2; ++n) _Pragma("unroll") for (int k = 0; k < 2; ++k) \
        acc[ai][bj][m][n] = __builtin_amdgcn_mfma_f32_16x16x32_bf16(Bt[n][k], At[m][k], acc[ai][bj][m][n], 0, 0, 0); __builtin_amdgcn_s_setprio(0); } while (0)
#define PG8_WAIT_V(n) asm volatile("s_waitcnt vmcnt(" #n ")" ::: "memory")
#define PG8_WAIT_L(n) asm volatile("s_waitcnt lgkmcnt(" #n ")" ::: "memory")
#define PG8_BAR __builtin_amdgcn_s_barrier()
#define PG8_SCHED __builtin_amdgcn_sched_barrier(0)
    Unit cur, nxt; int ui = 0;
    if (!S.next(0, cur)) return;
    f32x4 acc[2][2][4][2];
#pragma unroll
    for (int a = 0; a < 2; ++a)
#pragma unroll
        for (int b = 0; b < 2; ++b)
#pragma unroll
            for (int m = 0; m < 4; ++m)
#pragma unroll
                for (int n = 0; n < 2; ++n) acc[a][b][m][n] = (f32x4){0.f, 0.f, 0.f, 0.f};
    bf16x8 At[4][2], B0[2][2], B1[2][2];
    const char* cA = (const char*)g.A + (size_t)cur.pm * tstep; const char* cB = (const char*)g.Bt + (size_t)cur.pn * tstep;
    S.a_ready(cur);
    PG8_STAGE(PG8_SB(0, 0), cB, voffB); PG8_STAGE(PG8_SA(0, 0), cA, voffA); PG8_STAGE(PG8_SB(0, 1), cB + hstep, voffB); PG8_STAGE(PG8_SA(0, 1), cA + hstep, voffA);
    if (wr == 1) PG8_BAR;
    PG8_WAIT_V(4); PG8_BAR;
    PG8_STAGE(PG8_SB(1, 0), cB + kstep, voffB); PG8_STAGE(PG8_SA(1, 0), cA + kstep, voffA); PG8_STAGE(PG8_SB(1, 1), cB + hstep + kstep, voffB);
    PG8_WAIT_V(6); PG8_BAR;
    PG8_STAMP();
    for (;;) {
        const bool has_next = S.next(ui + 1, nxt);
        const char* nA = has_next ? (const char*)g.A + (size_t)nxt.pm * tstep : cA; const char* nB = has_next ? (const char*)g.Bt + (size_t)nxt.pn * tstep : cB;
        for (int t = 0; t < nt; t += 2) {
            const bool last = (t == nt - 2);
            const char* a1 = cA + (size_t)(t + 1) * kstep;
            const char* a2 = last ? nA : cA + (size_t)(t + 2) * kstep; const char* b2 = last ? nB : cB + (size_t)(t + 2) * kstep;
            const char* a3 = a2 + kstep; const char* b3 = b2 + kstep;
            if (last && has_next) S.a_ready(nxt);
            PG8_LDB(B0, 0, 0); PG8_SCHED; PG8_LDA(At, 0, 0); PG8_STAGE(PG8_SA(1, 1), a1 + hstep, voffA);
            PG8_WAIT_L(8); PG8_BAR; PG8_WAIT_L(0); PG8_MMA(0, 0, At, B0); PG8_BAR; PG8_SCHED;
            PG8_LDB(B1, 0, 1); PG8_STAGE(PG8_SB(0, 0), b2, voffB);
            PG8_BAR; PG8_WAIT_L(0); PG8_MMA(0, 1, At, B1); PG8_BAR;
            PG8_LDA(At, 0, 1); PG8_STAGE(PG8_SA(0, 0), a2, voffA);
            PG8_BAR; PG8_WAIT_L(0); PG8_MMA(1, 0, At, B0); PG8_BAR; PG8_SCHED;
            PG8_STAGE(PG8_SB(0, 1), b2 + hstep, voffB);
            PG8_WAIT_V(6); PG8_BAR; PG8_MMA(1, 1, At, B1); PG8_BAR;
            PG8_LDB(B0, 1, 0); PG8_SCHED; PG8_LDA(At, 1, 0); PG8_STAGE(PG8_SA(0, 1), a2 + hstep, voffA);
            PG8_WAIT_L(8); PG8_BAR; PG8_WAIT_L(0); PG8_MMA(0, 0, At, B0); PG8_BAR; PG8_SCHED;
            PG8_LDB(B1, 1, 1); PG8_STAGE(PG8_SB(1, 0), b3, voffB);
            PG8_BAR; PG8_WAIT_L(0); PG8_MMA(0, 1, At, B1); PG8_BAR;
            PG8_LDA(At, 1, 1); PG8_STAGE(PG8_SA(1, 0), a3, voffA);
            PG8_BAR; PG8_WAIT_L(0); PG8_MMA(1, 0, At, B0); PG8_BAR; PG8_SCHED;
            PG8_STAGE(PG8_SB(1, 1), b3 + hstep, voffB);
            PG8_WAIT_V(6); PG8_BAR; PG8_MMA(1, 1, At, B1); PG8_BAR;
        }
        PG8_STAMP();
        if constexpr (!Epi::AFTER_DRAIN) { E(acc, cur, wr, wc, fr, fq); S.done(cur); }
        PG8_STAMP();
        if (!has_next) break;
#pragma unroll
        for (int a = 0; a < 2; ++a)
#pragma unroll
            for (int b = 0; b < 2; ++b)
#pragma unroll
                for (int m = 0; m < 4; ++m)
#pragma unroll
                    for (int n = 0; n < 2; ++n) acc[a][b][m][n] = (f32x4){0.f, 0.f, 0.f, 0.f};
        cur = nxt; cA = nA; cB = nB; ++ui;
    }
    PG8_WAIT_V(0);
    if (wr == 0) PG8_BAR;
    PG8_BAR;
    if constexpr (Epi::AFTER_DRAIN) { E.fused(acc, cur, wr, wc, fr, fq, lds, wid, lane); S.done(cur); }
    PG8_STAMP();
    if (STAMP && wid == 0) { stamps[lane] = lane < nts ? (((unsigned long long)(unsigned)ts_hi << 32) | (unsigned)ts_lo) : 0ull;
        if (lane == 62) stamps[62] = rt_entry; if (lane == 63) stamps[63] = (unsigned long long)wall_clock64(); }
#undef PG8_STAMP
#undef PG8_SA
#undef PG8_SB
#undef PG8_STAGE
#undef PG8_LDA
#undef PG8_LDB
#undef PG8_MMA
#undef PG8_WAIT_V
#undef PG8_WAIT_L
#undef PG8_BAR
#undef PG8_SCHED
}
}
#ifndef PHMASK
#define PHMASK 4095
#endif
#ifndef DUPMASK
#define DUPMASK 0
#endif

using pg8::bf16_t; using pg8::bf16x8; using pg8::f32x4; using pg8::u32x4;
#define LAS __attribute__((address_space(3)))
typedef unsigned u32x2 __attribute__((ext_vector_type(2)));
typedef float v16f __attribute__((ext_vector_type(16)));
typedef float v32f __attribute__((ext_vector_type(32)));
typedef unsigned v6u __attribute__((ext_vector_type(6)));

constexpr int NTOK = 16384, DM = 1024, SEQ = 4096;
constexpr size_t MiB = 1ull << 20;
constexpr size_t OFF_RSTD1 = 0, OFF_IFG = 64 * 1024, OFF_SS2 = 576 * 1024, OFF_BONUS = 640 * 1024, OFF_NLOC = 1152 * 1024, OFF_GEND = 1664 * 1024;
constexpr size_t OFF_WINT = 2 * MiB, OFF_PRWT = OFF_WINT + 5888ull * 1024 * 2, OFF_PMLT = OFF_PRWT + MiB, OFF_WOUTT = OFF_PMLT + MiB, OFF_WQT = OFF_WOUTT + 2 * MiB, OFF_SKT = OFF_WQT + 4 * MiB;
static_assert(OFF_SKT + MiB / 2 == 22 * MiB, "weights map");
constexpr size_t OFF_ZRW = 22 * MiB, OFF_ZML = 78 * MiB, OFF_ZG = 142 * MiB, OFF_XB = 206 * MiB;
constexpr size_t OFF_V = 206 * MiB, OFF_G = 222 * MiB;
constexpr size_t OFF_BAR = 1960 * 1024;
constexpr size_t OFF_WUPT = 1700 * 1024, OFF_AUPT = 1764 * 1024, OFF_GUPT = 1828 * 1024;
constexpr size_t OFF_CLOC = 22 * MiB, OFF_Y = 54 * MiB;
constexpr size_t OFF_YML = 206 * MiB, OFF_T = 78 * MiB, OFF_MERGED = 222 * MiB, OFF_X1B = 22 * MiB, OFF_Q = 142 * MiB, OFF_KEYS = 206 * MiB, OFF_U8 = 78 * MiB, OFF_V8 = 94 * MiB, OFF_UINV = 110 * MiB, OFF_SS2P = 111 * MiB, OFF_ACT = 142 * MiB, OFF_EID = 150 * MiB, OFF_ACTIN = 238 * MiB;

struct Params {
    const float* in[31];
    float* out;
    unsigned char* ws;
    int cg_sync;
    int pad;
};

__device__ __forceinline__ int tid_opaque() { int t = threadIdx.x; asm volatile("" : "+v"(t)); return t; }
__device__ __forceinline__ float bf2f(bf16_t v) { return __uint_as_float(((unsigned)v) << 16); }
typedef __bf16 hwbf2 __attribute__((ext_vector_type(2)));
typedef float hwf2 __attribute__((ext_vector_type(2)));
__device__ __forceinline__ unsigned pk2(float lo, float hi) { hwf2 v = {lo, hi}; return __builtin_bit_cast(unsigned, __builtin_convertvector(v, hwbf2)); }
__device__ __forceinline__ unsigned f2bf(float f) { return pk2(f, 0.f) & 0xffffu; }
__device__ __forceinline__ float wave_sum(float v) {
#pragma unroll
    for (int o = 1; o < 64; o <<= 1) v += __shfl_xor(v, o);
    return v;
}
template <int CTRL> __device__ __forceinline__ float dpp_mov(float v) {
    return __builtin_bit_cast(float, __builtin_amdgcn_update_dpp(0, __builtin_bit_cast(int, v), CTRL, 0xf, 0xf, true));
}
__device__ __forceinline__ float sum8(float v) { v += dpp_mov<0xB1>(v); v += dpp_mov<0x4E>(v); v += dpp_mov<0x141>(v); return v; }
__device__ __forceinline__ float sum16(float v) { v = sum8(v); v += dpp_mov<0x140>(v); return v; }
__device__ __forceinline__ float max16(float v) { v = fmaxf(v, dpp_mov<0xB1>(v)); v = fmaxf(v, dpp_mov<0x4E>(v)); v = fmaxf(v, dpp_mov<0x141>(v)); v = fmaxf(v, dpp_mov<0x140>(v)); return v; }
__device__ __forceinline__ int imax16(int v) { v = max(v, __builtin_amdgcn_update_dpp(0, v, 0xB1, 0xf, 0xf, true)); v = max(v, __builtin_amdgcn_update_dpp(0, v, 0x4E, 0xf, 0xf, true)); v = max(v, __builtin_amdgcn_update_dpp(0, v, 0x141, 0xf, 0xf, true)); v = max(v, __builtin_amdgcn_update_dpp(0, v, 0x140, 0xf, 0xf, true)); return v; }
__device__ __forceinline__ int f2key(float f) { const int i = __float_as_int(f); return i ^ ((i >> 31) & 0x7fffffff); }
__device__ __forceinline__ float key2f(int i) { return __int_as_float(i ^ ((i >> 31) & 0x7fffffff)); }
__device__ __forceinline__ float sigmoidf_(float x) { return 1.f / (1.f + __expf(-x)); }
__device__ __forceinline__ float softplusf_(float x) { return fmaxf(x, 0.f) + log1pf(__expf(-fabsf(x))); }

#define BLO(x) __uint_as_float((x) << 16)
#define BHI(x) __uint_as_float((x) & 0xffff0000u)
struct EpiZ {
    static constexpr bool PERM = true, AFTER_DRAIN = false;
    bf16_t* zrw; bf16_t* zml; bf16_t* zg;
    __device__ __forceinline__ void operator()(const f32x4 (&acc)[2][2][4][2], const pg8::Unit& u, int wr, int wc, int fr, int fq) const {
        const int row0 = u.pm * 256 + wr * 64 + fr;
        bf16_t* base; int ldc, colt;
        if (u.pn < 7) { base = zrw; ldc = 1792; colt = u.pn * 256; }
        else if (u.pn < 15) { base = zml; ldc = 2048; colt = (u.pn - 7) * 256; }
        else { base = zg; ldc = 2048; colt = (u.pn - 15) * 256; }
        const int col0 = colt + wc * 32 + 8 * fq;
#pragma unroll
        for (int ai = 0; ai < 2; ++ai)
#pragma unroll
            for (int m = 0; m < 4; ++m) {
                const int row = row0 + ai * 128 + m * 16;
                bf16_t* rowp = base + (size_t)row * ldc + col0;
#pragma unroll
                for (int bj = 0; bj < 2; ++bj) {
                    const f32x4 v0 = acc[ai][bj][m][0], v1 = acc[ai][bj][m][1];
                    u32x4 w; w.x = pg8::cvt_pk_bf16(v0[0], v0[1]); w.y = pg8::cvt_pk_bf16(v0[2], v0[3]); w.z = pg8::cvt_pk_bf16(v1[0], v1[1]); w.w = pg8::cvt_pk_bf16(v1[2], v1[3]);
                    *(u32x4*)(rowp + bj * 128) = w;
                }
            }
    }
};
__device__ __forceinline__ f32x4 sig4(const u32x2 zr, const f32x4 b) {
    f32x4 g; g[0] = __builtin_amdgcn_rcpf(1.f + __expf(-(BLO(zr.x) + b[0]))); g[1] = __builtin_amdgcn_rcpf(1.f + __expf(-(BHI(zr.x) + b[1])));
    g[2] = __builtin_amdgcn_rcpf(1.f + __expf(-(BLO(zr.y) + b[2]))); g[3] = __builtin_amdgcn_rcpf(1.f + __expf(-(BHI(zr.y) + b[3]))); return g;
}
struct EpiMerge1 {
    static constexpr bool PERM = false, AFTER_DRAIN = false;
    const bf16_t* zg; const float* gb; bf16_t* T;
    __device__ __forceinline__ void operator()(const f32x4 (&acc)[2][2][4][2], const pg8::Unit& u, int wr, int wc, int fr, int fq) const {
        const int row0 = u.pm * 256 + wr * 64 + fr, col0 = u.pn * 256 + wc * 32 + 4 * fq;
        f32x4 bv[4];
#pragma unroll
        for (int c = 0; c < 4; ++c) bv[c] = *(const f32x4*)(gb + col0 + (c >> 1) * 128 + (c & 1) * 16);
        u32x2 zc[4], zn[4];
#pragma unroll
        for (int c = 0; c < 4; ++c) zc[c] = *(const u32x2*)(zg + (size_t)row0 * 2048 + col0 + (c >> 1) * 128 + (c & 1) * 16);
#pragma unroll
        for (int g = 0; g < 8; ++g) {
            const int ai = g >> 2, m = g & 3, row = row0 + ai * 128 + m * 16;
            if (g < 7) { const int rn = row0 + ((g + 1) >> 2) * 128 + ((g + 1) & 3) * 16;
#pragma unroll
                for (int c = 0; c < 4; ++c) zn[c] = *(const u32x2*)(zg + (size_t)rn * 2048 + col0 + (c >> 1) * 128 + (c & 1) * 16); }
#pragma unroll
            for (int c = 0; c < 4; ++c) { const f32x4 t = sig4(zc[c], bv[c]) * acc[ai][c >> 1][m][c & 1]; u32x2 w; w.x = pk2(t[0], t[1]); w.y = pk2(t[2], t[3]); *(u32x2*)(T + (size_t)row * 1024 + col0 + (c >> 1) * 128 + (c & 1) * 16) = w; }
#pragma unroll
            for (int c = 0; c < 4; ++c) zc[c] = zn[c];
        }
    }
};
struct EpiMerge2 {
    static constexpr bool PERM = false, AFTER_DRAIN = false;
    const bf16_t* zg; const float* gb; const bf16_t* T; bf16_t* merged;
    __device__ __forceinline__ void operator()(const f32x4 (&acc)[2][2][4][2], const pg8::Unit& u, int wr, int wc, int fr, int fq) const {
        const int row0 = u.pm * 256 + wr * 64 + fr, col0 = u.pn * 256 + wc * 32 + 4 * fq;
        f32x4 bv[4];
#pragma unroll
        for (int c = 0; c < 4; ++c) bv[c] = *(const f32x4*)(gb + 1024 + col0 + (c >> 1) * 128 + (c & 1) * 16);
        u32x2 zc[4], zn[4]; u32x2 tc[4], tn[4];
#pragma unroll
        for (int c = 0; c < 4; ++c) { const int co = col0 + (c >> 1) * 128 + (c & 1) * 16; zc[c] = *(const u32x2*)(zg + (size_t)row0 * 2048 + 1024 + co); tc[c] = *(const u32x2*)(T + (size_t)row0 * 1024 + co); }
#pragma unroll
        for (int g = 0; g < 8; ++g) {
            const int ai = g >> 2, m = g & 3, row = row0 + ai * 128 + m * 16;
            if (g < 7) { const int rn = row0 + ((g + 1) >> 2) * 128 + ((g + 1) & 3) * 16;
#pragma unroll
                for (int c = 0; c < 4; ++c) { const int co = col0 + (c >> 1) * 128 + (c & 1) * 16; zn[c] = *(const u32x2*)(zg + (size_t)rn * 2048 + 1024 + co); tn[c] = *(const u32x2*)(T + (size_t)rn * 1024 + co); } }
#pragma unroll
            for (int c = 0; c < 4; ++c) { const f32x4 tf = (f32x4){BLO(tc[c].x), BHI(tc[c].x), BLO(tc[c].y), BHI(tc[c].y)}; const f32x4 o = tf + sig4(zc[c], bv[c]) * acc[ai][c >> 1][m][c & 1];
                u32x2 w; w.x = pg8::cvt_pk_bf16(o[0], o[1]); w.y = pg8::cvt_pk_bf16(o[2], o[3]);
                *(u32x2*)(merged + (size_t)row * 1024 + col0 + (c >> 1) * 128 + (c & 1) * 16) = w; }
#pragma unroll
            for (int c = 0; c < 4; ++c) { zc[c] = zn[c]; tc[c] = tn[c]; }
        }
    }
};
constexpr int MERGE_PM_OFF = (int)((OFF_YML - OFF_Y) / (256 * 512 * 2)), MERGE_PN_OFF = (int)((OFF_PMLT - OFF_PRWT) / (256 * 512 * 2));
static_assert((size_t)MERGE_PM_OFF * 256 * 512 * 2 == OFF_YML - OFF_Y && (size_t)MERGE_PN_OFF * 256 * 512 * 2 == OFF_PMLT - OFF_PRWT, "merge operand panels");
struct MergeOrder : pg8::StaticOrder {
    __device__ __forceinline__ bool next(int i, pg8::Unit& u) const { if (i >= 2 || !pg8::StaticOrder::next(0, u)) return false; if (i == 1) { u.pm += MERGE_PM_OFF; u.pn += MERGE_PN_OFF; } return true; }
};
struct EpiMerge {
    static constexpr bool PERM = false, AFTER_DRAIN = false;
    EpiMerge1 e1; EpiMerge2 e2;
    __device__ __forceinline__ void operator()(const f32x4 (&acc)[2][2][4][2], const pg8::Unit& u, int wr, int wc, int fr, int fq) const {
        if (u.pm >= MERGE_PM_OFF) { pg8::Unit v; v.pm = u.pm - MERGE_PM_OFF; v.pn = u.pn - MERGE_PN_OFF; e2(acc, v, wr, wc, fr, fq); } else e1(acc, u, wr, wc, fr, fq);
    }
};
struct EpiOut {
    static constexpr bool PERM = false, AFTER_DRAIN = false;
    const float* x; float* x1; bf16_t* x1b; float* ss2;
    __device__ __forceinline__ void operator()(const f32x4 (&acc)[2][2][4][2], const pg8::Unit& u, int wr, int wc, int fr, int fq) const {
        const int row0 = u.pm * 256 + wr * 64 + fr, col0 = u.pn * 256 + wc * 32 + 4 * fq;
        f32x4 xc[4], xn[4];
#pragma unroll
        for (int c = 0; c < 4; ++c) xc[c] = *(const f32x4*)(x + (size_t)row0 * 1024 + col0 + (c >> 1) * 128 + (c & 1) * 16);
#pragma unroll
        for (int g = 0; g < 8; ++g) {
            const int ai = g >> 2, m = g & 3, row = row0 + ai * 128 + m * 16; float s = 0.f;
            if (g < 7) { const int rn = row0 + ((g + 1) >> 2) * 128 + ((g + 1) & 3) * 16;
#pragma unroll
                for (int c = 0; c < 4; ++c) xn[c] = *(const f32x4*)(x + (size_t)rn * 1024 + col0 + (c >> 1) * 128 + (c & 1) * 16); }
#pragma unroll
            for (int c = 0; c < 4; ++c) { const int col = col0 + (c >> 1) * 128 + (c & 1) * 16;
                const f32x4 o = xc[c] + acc[ai][c >> 1][m][c & 1];
                u32x2 w; w.x = pg8::cvt_pk_bf16(o[0], o[1]); w.y = pg8::cvt_pk_bf16(o[2], o[3]);
                *(u32x2*)(x1b + (size_t)row * 1024 + col) = w;
                s += (o[0] * o[0] + o[1] * o[1]) + (o[2] * o[2] + o[3] * o[3]); }
            s += __shfl_xor(s, 16); s += __shfl_xor(s, 32);
            if (fq == 0) ss2[(size_t)(u.pn * 4 + wc) * NTOK + row] = s;
#pragma unroll
            for (int c = 0; c < 4; ++c) xc[c] = xn[c];
        }
    }
};
struct EpiQ {
    static constexpr bool PERM = true, AFTER_DRAIN = false;
    bf16_t* q;
    __device__ __forceinline__ void operator()(const f32x4 (&acc)[2][2][4][2], const pg8::Unit& u, int wr, int wc, int fr, int fq) const {
        const int row0 = u.pm * 256 + wr * 64 + fr, col0 = u.pn * 256 + wc * 32 + 8 * fq;
#pragma unroll
        for (int ai = 0; ai < 2; ++ai)
#pragma unroll
            for (int m = 0; m < 4; ++m) {
                const int row = row0 + ai * 128 + m * 16;
                bf16_t* rowp = q + (size_t)row * 2048 + col0;
#pragma unroll
                for (int bj = 0; bj < 2; ++bj) {
                    const f32x4 v0 = acc[ai][bj][m][0], v1 = acc[ai][bj][m][1];
                    u32x4 w; w.x = pg8::cvt_pk_bf16(v0[0], v0[1]); w.y = pg8::cvt_pk_bf16(v0[2], v0[3]); w.z = pg8::cvt_pk_bf16(v1[0], v1[1]); w.w = pg8::cvt_pk_bf16(v1[2], v1[3]);
                    *(u32x4*)(rowp + bj * 128) = w;
                }
            }
    }
};

#define P0_LOAD(dstv, tt) do { if ((tt) < ntiles) { const int kb_ = (tt) / NT, nb_ = (tt) - kb_ * NT; const int n_ = nb_ * 64 + nl, col_ = n_ >= sf ? n_ + sk : n_; \
        _Pragma("unroll") for (int i = 0; i < 8; ++i) { const int k_ = kb_ * 64 + kl0 + 8 * i; float v_ = src[(size_t)k_ * ld + col_]; if (ks) v_ *= ks[k_]; dstv[i] = v_; } } } while (0)
__device__ __forceinline__ void p0_matrix(const float* src, int ld, int K, bf16_t* dst, const float* ks, int sf, int sk, int NT, int ntiles, int start, int step, float* lds, int tid) {
    const int nl = tid & 63, kl0 = tid >> 6;
    float cur[8], n1[8], n2[8];
    int t = start;
    P0_LOAD(cur, t); P0_LOAD(n1, t + step);
    for (; t < ntiles; t += step) {
        P0_LOAD(n2, t + 2 * step);
#pragma unroll
        for (int i = 0; i < 8; ++i) lds[(kl0 + 8 * i) * 65 + nl] = cur[i];
        __syncthreads();
        { const int kb = t / NT, nb = t - kb * NT; const int n = tid & 63, kc = tid >> 6; const float* c0 = lds + (kc * 8) * 65 + n;
          u32x4 w; w.x = pk2(c0[0], c0[65]); w.y = pk2(c0[130], c0[195]); w.z = pk2(c0[260], c0[325]); w.w = pk2(c0[390], c0[455]);
          *(u32x4*)(dst + (size_t)(nb * 64 + n) * K + kb * 64 + kc * 8) = w; }
        __syncthreads();
#pragma unroll
        for (int i = 0; i < 8; ++i) { cur[i] = n1[i]; n1[i] = n2[i]; }
    }
}
#undef P0_LOAD
__device__ __forceinline__ void phase0(const Params& p, float* lds) {
    unsigned char* ws = p.ws;
    const int tid = tid_opaque();
    float* TB = lds;
    float* GW = lds + 4224;
    { const float* w_in = p.in[2]; const float* g1 = p.in[1];
      for (int i = tid; i < 8192; i += 512) { const int c = i >> 10, k = i & 1023; GW[i] = w_in[(size_t)k * 5896 + 3840 + c] * g1[k]; } }
    __syncthreads();
    const int wave = tid >> 6, lane = tid & 63;
    float* rstd1 = (float*)(ws + OFF_RSTD1); float* ifg = (float*)(ws + OFF_IFG); bf16_t* xb = (bf16_t*)(ws + OFF_XB);
    int row = blockIdx.x * 8 + wave; const int rstep = gridDim.x * 8;
    f32x4 v[4], vn[4];
#define P0_ROWLD(dstv, rr) do { if ((rr) < NTOK) { _Pragma("unroll") for (int jx = 0; jx < 4; ++jx) dstv[jx] = ((const f32x4*)(p.in[0] + (size_t)(rr) * 1024))[lane + 64 * jx]; } } while (0)
#define P0_ROWPROC() do { if (row < NTOK) { \
        float d[9]; _Pragma("unroll") for (int c = 0; c < 9; ++c) d[c] = 0.f; \
        _Pragma("unroll") for (int jx = 0; jx < 4; ++jx) { \
            d[8] += (v[jx][0] * v[jx][0] + v[jx][1] * v[jx][1]) + (v[jx][2] * v[jx][2] + v[jx][3] * v[jx][3]); \
            _Pragma("unroll") for (int c = 0; c < 8; ++c) { const f32x4 w = *(const f32x4*)(GW + c * 1024 + (lane + 64 * jx) * 4); d[c] += (v[jx][0] * w[0] + v[jx][1] * w[1]) + (v[jx][2] * w[2] + v[jx][3] * w[3]); } } \
        _Pragma("unroll") for (int o = 1; o < 64; o <<= 1) { _Pragma("unroll") for (int c = 0; c < 9; ++c) d[c] += __shfl_xor(d[c], o); } \
        const float rs = __builtin_amdgcn_rsqf(d[8] * (1.f / 1024.f) + 1e-6f); \
        if (lane == 0) rstd1[row] = rs; \
        _Pragma("unroll") for (int jx = 0; jx < 4; ++jx) { u32x2 o; o.x = pk2(v[jx][0] * rs, v[jx][1] * rs); o.y = pk2(v[jx][2] * rs, v[jx][3] * rs); ((u32x2*)(xb + (size_t)row * 1024))[lane + 64 * jx] = o; } \
        float mine = d[0]; _Pragma("unroll") for (int c = 1; c < 8; ++c) mine = (lane == c) ? d[c] : mine; \
        if (lane < 8) ifg[row * 8 + lane] = mine * rs; \
        _Pragma("unroll") for (int jx = 0; jx < 4; ++jx) v[jx] = vn[jx]; \
        P0_ROWLD(vn, row + 2 * rstep); row += rstep; } } while (0)
    P0_ROWLD(v, row); P0_ROWLD(vn, row + rstep);
    { const float* src = p.in[2]; const float* ks = p.in[1]; bf16_t* dst = (bf16_t*)(ws + OFF_WINT);
      const int ld = 5896, K = 1024, sf = 3840, sk = 8, NT = 92, ntiles = 1472, step = gridDim.x;
      const int nl = tid & 63, kl0 = tid >> 6;
      float cur[8], n1[8];
#define P0_LOAD(dstv, tt) do { if ((tt) < ntiles) { const int kb_ = (tt) / NT, nb_ = (tt) - kb_ * NT; const int n_ = nb_ * 64 + nl, col_ = n_ >= sf ? n_ + sk : n_; \
        _Pragma("unroll") for (int i = 0; i < 8; ++i) { const int k_ = kb_ * 64 + kl0 + 8 * i; dstv[i] = src[(size_t)k_ * ld + col_] * ks[k_]; } } } while (0)
      int t = blockIdx.x;
      P0_LOAD(cur, t);
      for (; t < ntiles; t += step) {
          P0_LOAD(n1, t + step);
#pragma unroll
          for (int i = 0; i < 8; ++i) TB[(kl0 + 8 * i) * 65 + nl] = cur[i];
          __syncthreads();
          { const int kb = t / NT, nb = t - kb * NT; const int n = tid & 63, kc = tid >> 6; const float* c0 = TB + (kc * 8) * 65 + n;
            u32x4 w; w.x = pk2(c0[0], c0[65]); w.y = pk2(c0[130], c0[195]); w.z = pk2(c0[260], c0[325]); w.w = pk2(c0[390], c0[455]);
            *(u32x4*)(dst + (size_t)(nb * 64 + n) * K + kb * 64 + kc * 8) = w; }
          P0_ROWPROC();
          __syncthreads();
          P0_ROWPROC();
#pragma unroll
          for (int i = 0; i < 8; ++i) cur[i] = n1[i];
      }
#undef P0_LOAD
    }
    while (__any(row < NTOK)) P0_ROWPROC();
#undef P0_ROWPROC
#undef P0_ROWLD
    __syncthreads();
    { const int G = gridDim.x, bx = blockIdx.x;
      p0_matrix(p.in[5], 512, 64, (bf16_t*)(ws + OFF_WUPT), nullptr, 1 << 30, 0, 8, 8, (bx + 64) % G, G, TB, tid);
      p0_matrix(p.in[7], 512, 64, (bf16_t*)(ws + OFF_AUPT), nullptr, 1 << 30, 0, 8, 8, (bx + 56) % G, G, TB, tid);
      p0_matrix(p.in[8], 512, 128, (bf16_t*)(ws + OFF_GUPT), nullptr, 1 << 30, 0, 8, 16, (bx + 40) % G, G, TB, tid); }
    { bf16_t* skt = (bf16_t*)(ws + OFF_SKT); const float* sk = p.in[27];
      for (int i = blockIdx.x * 512 + tid; i < 262144; i += gridDim.x * 512) skt[i] = (bf16_t)f2bf(sk[i]); }
}

constexpr int LDT = 72;
constexpr int SLOT = 64 * LDT * 2;
typedef float f32x16 __attribute__((ext_vector_type(16)));
#define MFMA16(a, b, c) __builtin_amdgcn_mfma_f32_16x16x32_bf16((a), (b), (c), 0, 0, 0)
#define MFMA32(a, b, c) __builtin_amdgcn_mfma_f32_32x32x16_bf16((a), (b), (c), 0, 0, 0)
__device__ __forceinline__ bf16x8 lds_frag(const bf16_t* M, int row0, int k0, int lane) { return *(const bf16x8*)(M + (row0 + (lane & 15)) * LDT + k0 + (lane >> 4) * 8); }
__device__ __forceinline__ f32x4 mm64(const bf16_t* P, const bf16_t* Q, int pt, int qt, f32x4 acc, int lane) {
#pragma unroll
    for (int k0 = 0; k0 < 64; k0 += 32) { const bf16x8 a = lds_frag(Q, qt * 16, k0, lane), b = lds_frag(P, pt * 16, k0, lane); acc = MFMA16(a, b, acc); }
    return acc;
}
__device__ __forceinline__ void st_tile(bf16_t* Z, int pt, int qt, const f32x4 v, int lane) {
    u32x2 w; w.x = pk2(v[0], v[1]); w.y = pk2(v[2], v[3]);
    *(u32x2*)(Z + (pt * 16 + (lane & 15)) * LDT + qt * 16 + (lane >> 4) * 4) = w;
}
__device__ __forceinline__ void st_tile_T(bf16_t* ZT, int pt, int qt, const f32x4 v, int lane) {
#pragma unroll
    for (int j = 0; j < 4; ++j) ZT[(qt * 16 + (lane >> 4) * 4 + j) * LDT + pt * 16 + (lane & 15)] = (bf16_t)f2bf(v[j]);
}
__device__ __forceinline__ f32x4 ld4bf(const bf16_t* p) { const u32x2 r = *(const u32x2*)p; f32x4 o; o[0] = __uint_as_float(r.x << 16); o[1] = __uint_as_float(r.x & 0xffff0000u); o[2] = __uint_as_float(r.y << 16); o[3] = __uint_as_float(r.y & 0xffff0000u); return o; }

#ifndef STAMP_SEL
#define STAMP_SEL 0
#endif
#define TSTAMP(k) do { if (STAMP_SEL) { const unsigned long long _t = __builtin_amdgcn_s_memrealtime(); if (STAMP_SEL == (k)) tacc += (unsigned)(_t - tlast); tlast = _t; } } while (0)
__device__ __forceinline__ void phase_rwkv_prep(const Params& p, unsigned char* smem_, unsigned& tacc) {
    unsigned long long tlast = 0;
    int tidv = threadIdx.x;
#define RETID() asm volatile("" : "+v"(tidv))
#define tid tidv
#define lane (tidv & 63)
#define wv (tidv >> 6)
#define fr (tidv & 15)
#define fq ((tidv >> 4) & 3)
#define SL(i) ((bf16_t*)(smem_ + (i) * SLOT))
    float* part = (float*)(smem_ + 17 * SLOT);
    float* gl_s = part + 512;
    bf16_t* RKV = SL(2);
    const bf16_t* zrw = (const bf16_t*)(p.ws + OFF_ZRW);
    bf16_t* Vg = (bf16_t*)(p.ws + OFF_V); bf16_t* Gg = (bf16_t*)(p.ws + OFF_G); float* bonus = (float*)(p.ws + OFF_BONUS);
    const bf16_t* WupT = (const bf16_t*)(p.ws + OFF_WUPT); const bf16_t* AupT = (const bf16_t*)(p.ws + OFF_AUPT); const bf16_t* GupT = (const bf16_t*)(p.ws + OFF_GUPT);
    bf16_t* FR = (bf16_t*)p.out;
    const float* mu = p.in[3];
    u32x4 zc[4], zp[4], zq[4];
#define RW_ISSUE(uu) do { const int h_ = (uu) & 7, bc_ = (uu) >> 3, n0_ = bc_ * 64, t0_ = (bc_ & 63) * 64; \
        _Pragma("unroll") for (int j = 0; j < 4; ++j) { const int task = tid + 512 * j, t = task >> 5, cg = task & 31; \
            if (h_ == 0) { const bf16_t* src = zrw + (size_t)(n0_ + t) * 1792 + 1536 + cg * 8; zc[j] = *(const u32x4*)src; \
                zp[j] = (t0_ + t > 0) ? *(const u32x4*)(src - 1792) : (u32x4){0u, 0u, 0u, 0u}; } \
            else zc[j] = *(const u32x4*)(actin + ((size_t)(bc_ * 64 + t) * 256 + cg * 8)); \
            const int i = task / 24, rem = task - i * 24; \
            zq[j] = (task < 1560 && t0_ + i > 0) ? *(const u32x4*)(zrw + (size_t)(n0_ + i - 1) * 1792 + (rem >> 3) * 512 + h_ * 64 + (rem & 7) * 8) : (u32x4){0u, 0u, 0u, 0u}; } } while (0)
    bf16_t* actin = (bf16_t*)(p.ws + OFF_ACTIN);
    int hcur = -1; bf16x8 wfw[2][2], wfa[2][2], wfg[2][4];
    float w0c = 0.f, a0c = 0.f, kkc = 0.f, kac = 0.f, rkc = 0.f, mur = 0.f, muk = 0.f, muv = 0.f;
    if (blockIdx.x < 256) RW_ISSUE(blockIdx.x * 8);
    for (int kk_ = 0; (int)blockIdx.x + (kk_ >> 3) * (int)gridDim.x < 256; ++kk_) {
        const int u = ((int)blockIdx.x + (kk_ >> 3) * (int)gridDim.x) * 8 + (kk_ & 7);
        const int un = ((int)blockIdx.x + ((kk_ + 1) >> 3) * (int)gridDim.x) * 8 + ((kk_ + 1) & 7);
        const int h = u & 7, bc = u >> 3; const int n0 = bc * 64, t0 = (bc & 63) * 64;
        const int hc = h * 64 + lane;
        if (h != hcur) { hcur = h; w0c = p.in[4][hc]; a0c = p.in[6][hc]; kkc = p.in[9][hc]; kac = p.in[10][hc]; rkc = p.in[11][hc]; mur = mu[hc]; muk = mu[512 + hc]; muv = mu[1024 + hc]; }
#pragma unroll
        for (int q = 0; q < 2; ++q) { const int qt = (wv * 2 + q) & 3;
#pragma unroll
            for (int ks = 0; ks < 2; ++ks) { wfw[q][ks] = *(const bf16x8*)(WupT + (size_t)(h * 64 + qt * 16 + fr) * 64 + ks * 32 + fq * 8); wfa[q][ks] = *(const bf16x8*)(AupT + (size_t)(h * 64 + qt * 16 + fr) * 64 + ks * 32 + fq * 8); }
#pragma unroll
            for (int ks = 0; ks < 4; ++ks) wfg[q][ks] = *(const bf16x8*)(GupT + (size_t)(h * 64 + qt * 16 + fr) * 128 + ks * 32 + fq * 8); }
        TSTAMP(0);
        RETID();
        { bf16_t* INW = SL(8); bf16_t* INA = SL(9); bf16_t* ING = SL(10);
#pragma unroll
          for (int j = 0; j < 4; ++j) { const int task = tid + 512 * j, t = task >> 5, cg = task & 31;
              u32x4 w;
              if (h == 0) {
              const f32x4 m0 = *(const f32x4*)(mu + 1536 + cg * 8), m1 = *(const f32x4*)(mu + 1536 + cg * 8 + 4);
              float z[8];
              z[0] = BLO(zc[j].x) + (BLO(zp[j].x) - BLO(zc[j].x)) * m0[0]; z[1] = BHI(zc[j].x) + (BHI(zp[j].x) - BHI(zc[j].x)) * m0[1];
              z[2] = BLO(zc[j].y) + (BLO(zp[j].y) - BLO(zc[j].y)) * m0[2]; z[3] = BHI(zc[j].y) + (BHI(zp[j].y) - BHI(zc[j].y)) * m0[3];
              z[4] = BLO(zc[j].z) + (BLO(zp[j].z) - BLO(zc[j].z)) * m1[0]; z[5] = BHI(zc[j].z) + (BHI(zp[j].z) - BHI(zc[j].z)) * m1[1];
              z[6] = BLO(zc[j].w) + (BLO(zp[j].w) - BLO(zc[j].w)) * m1[2]; z[7] = BHI(zc[j].w) + (BHI(zp[j].w) - BHI(zc[j].w)) * m1[3];
              if (cg < 8) {
#pragma unroll
                  for (int e = 0; e < 8; ++e) z[e] = 1.f - 2.f * __builtin_amdgcn_rcpf(1.f + __expf(2.f * z[e]));
              } else if (cg >= 16) {
#pragma unroll
                  for (int e = 0; e < 8; ++e) z[e] = __builtin_amdgcn_rcpf(1.f + __expf(-z[e]));
              }
              w.x = pk2(z[0], z[1]); w.y = pk2(z[2], z[3]); w.z = pk2(z[4], z[5]); w.w = pk2(z[6], z[7]);
              *(u32x4*)(actin + ((size_t)(bc * 64 + t) * 256 + cg * 8)) = w;
              } else w = zc[j];
              bf16_t* d = cg < 8 ? INW + t * LDT + cg * 8 : (cg < 16 ? INA + t * LDT + (cg - 8) * 8 : ING + t * 136 + (cg - 16) * 8);
              *(u32x4*)d = w;
              if (task < 1560) { const int i = task / 24, rem = task - i * 24; *(u32x4*)(RKV + i * 200 + (rem >> 3) * 64 + (rem & 7) * 8) = zq[j]; } } }
        if (h == 0) asm volatile("s_waitcnt vmcnt(0)" ::: "memory");
        __syncthreads();
        { float* LW = (float*)SL(12); float* LA = (float*)SL(14); float* LG = (float*)SL(0);
#pragma unroll
          for (int q = 0; q < 2; ++q) { const int pos = wv * 2 + q, pt = pos >> 2, qt = pos & 3;
              f32x4 aw = (f32x4){0.f, 0.f, 0.f, 0.f}, aa = aw, ag = aw;
#pragma unroll
              for (int ks = 0; ks < 2; ++ks) { aw = MFMA16(wfw[q][ks], lds_frag(SL(8), pt * 16, ks * 32, lane), aw); aa = MFMA16(wfa[q][ks], lds_frag(SL(9), pt * 16, ks * 32, lane), aa); }
#pragma unroll
              for (int ks = 0; ks < 4; ++ks) ag = MFMA16(wfg[q][ks], *(const bf16x8*)(SL(10) + (pt * 16 + fr) * 136 + ks * 32 + fq * 8), ag);
              *(f32x4*)(LW + (pt * 16 + fr) * 68 + qt * 16 + fq * 4) = aw; *(f32x4*)(LA + (pt * 16 + fr) * 68 + qt * 16 + fq * 4) = aa; *(f32x4*)(LG + (pt * 16 + fr) * 68 + qt * 16 + fq * 4) = ag; } }
        __syncthreads();
        TSTAMP(1);
        RETID();
        { const float* LW = (const float*)SL(12); const float* LA = (const float*)SL(14); const float* LG = (const float*)SL(0);
          float rr[8], km[8], vv[8], kk[8], bb[8], ld[8], cl[8], gg[8], bn[8], n2[8];
          float run = 0.f;
          { float zrp = bf2f(RKV[(wv * 8) * 200 + lane]), zkp = bf2f(RKV[(wv * 8) * 200 + 64 + lane]), zvp = bf2f(RKV[(wv * 8) * 200 + 128 + lane]);
#pragma unroll
            for (int i = 0; i < 8; ++i) {
                const int t = wv * 8 + i;
                const float zr = bf2f(RKV[(t + 1) * 200 + lane]), zk = bf2f(RKV[(t + 1) * 200 + 64 + lane]), zv = bf2f(RKV[(t + 1) * 200 + 128 + lane]);
                const float r = zr + (zrp - zr) * mur, k = zk + (zkp - zk) * muk, v = zv + (zvp - zv) * muv;
                zrp = zr; zkp = zk; zvp = zv;
                const float lw = w0c + LW[t * 68 + lane];
                const float sp = fmaxf(-lw, 0.f) + __logf(1.f + __expf(-fabsf(lw)));
                const float logdec = -__expf(-sp - 0.5f);
                const float a = __builtin_amdgcn_rcpf(1.f + __expf(-(a0c + LA[t * 68 + lane])));
                const float kx = k * kkc; const float kmod = k * (1.f + (a - 1.f) * kac);
                n2[i] = kx * kx; bn[i] = r * kmod * rkc;
                rr[i] = r; km[i] = kmod; vv[i] = v; kk[i] = kx; bb[i] = a; ld[i] = logdec; run += logdec; cl[i] = run; gg[i] = LG[t * 68 + lane];
            } }
#pragma unroll
          for (int o = 1; o < 64; o <<= 1) {
#pragma unroll
              for (int i = 0; i < 8; ++i) { n2[i] += __shfl_xor(n2[i], o); bn[i] += __shfl_xor(bn[i], o); } }
#pragma unroll
          for (int i = 0; i < 8; ++i) { const int n = n0 + wv * 8 + i;
              kk[i] = kk[i] * __builtin_amdgcn_rcpf(fmaxf(sqrtf(n2[i]), 1e-12f)); bb[i] = kk[i] * bb[i];
              Vg[(size_t)n * 512 + hc] = (bf16_t)f2bf(vv[i]); Gg[(size_t)n * 512 + hc] = (bf16_t)f2bf(gg[i]);
              if (lane == 0) bonus[n * 8 + h] = bn[i]; }
          part[wv * 64 + lane] = run;
          __syncthreads();
          float off = 0.f, tot = 0.f;
#pragma unroll
          for (int g = 0; g < 8; ++g) { const float x = part[g * 64 + lane]; tot += x; off += (g < wv) ? x : 0.f; }
          if (wv == 0) gl_s[lane] = __expf(tot);
          unsigned pkT[4][4];
          float prevv[4];
#pragma unroll
          for (int i = 0; i < 8; ++i) {
              const int t = wv * 8 + i; const float cum = off + cl[i];
              const float ein = __expf(cum), eout = __expf(-cum), eex = __expf(cum - ld[i]), erem = __expf(tot - cum);
              const float kap = kk[i] * eex, bet = bb[i] * eout, kt = km[i] * eout, rt = rr[i] * ein, betp = bb[i] * erem, ktp = km[i] * erem;
              SL(0)[t * LDT + lane] = (bf16_t)f2bf(kap); SL(1)[t * LDT + lane] = (bf16_t)f2bf(bet); SL(2)[t * LDT + lane] = (bf16_t)f2bf(kt); SL(3)[t * LDT + lane] = (bf16_t)f2bf(rt);
              if (i & 1) { pkT[0][i >> 1] = pk2(prevv[0], kap); pkT[1][i >> 1] = pk2(prevv[1], betp); pkT[2][i >> 1] = pk2(prevv[2], ktp); pkT[3][i >> 1] = pk2(prevv[3], vv[i]); }
              else { prevv[0] = kap; prevv[1] = betp; prevv[2] = ktp; prevv[3] = vv[i]; }
          }
#pragma unroll
          for (int a = 0; a < 4; ++a) { u32x4 w; w.x = pkT[a][0]; w.y = pkT[a][1]; w.z = pkT[a][2]; w.w = pkT[a][3]; *(u32x4*)(SL(4 + a) + lane * LDT + wv * 8) = w; }
        }
        __syncthreads();
        TSTAMP(2);
        RETID();
        if (un < 2048) RW_ISSUE(un);
        f32x4 Tacc[2];
#pragma unroll
        for (int q = 0; q < 2; ++q) {
            const int pos = wv * 2 + q, pt = pos >> 2, qt = pos & 3;
            const int t = pt * 16 + fr, s0 = qt * 16 + fq * 4;
            const f32x4 z = (f32x4){0.f, 0.f, 0.f, 0.f};
            f32x4 abk = mm64(SL(0), SL(1), pt, qt, z, lane), akk = mm64(SL(0), SL(2), pt, qt, z, lane), akr = mm64(SL(3), SL(2), pt, qt, z, lane), abr = mm64(SL(3), SL(1), pt, qt, z, lane);
            f32x4 t0v;
#pragma unroll
            for (int j = 0; j < 4; ++j) { const int s = s0 + j; const bool lo = s < t, le = s <= t;
                abk[j] = lo ? -abk[j] : 0.f; akk[j] = lo ? akk[j] : 0.f; akr[j] = le ? akr[j] : 0.f; abr[j] = le ? abr[j] : 0.f; t0v[j] = abk[j] + (s == t ? 1.f : 0.f); }
            st_tile(SL(8), pt, qt, akk, lane); st_tile(SL(9), pt, qt, akr, lane); st_tile(SL(10), pt, qt, abr, lane);
            st_tile(SL(11), pt, qt, abk, lane); st_tile_T(SL(12), pt, qt, abk, lane); st_tile(SL(13), pt, qt, t0v, lane);
            Tacc[q] = t0v;
        }
        __syncthreads();
        TSTAMP(3);
        RETID();
#pragma unroll 1
        for (int lv = 0; lv < 5; ++lv) {
            const int ib = (lv & 1) ? 0 : 11, ob = (lv & 1) ? 11 : 0;
            const bf16_t* Pc = SL(ib); const bf16_t* Pt = SL(ib + 1); const bf16_t* Tin = SL(ib + 2);
            bf16_t* Pco = SL(ob); bf16_t* Pto = SL(ob + 1); bf16_t* Tout = SL(ob + 2);
#pragma unroll
            for (int q = 0; q < 2; ++q) { const int pos = wv * 2 + q, pt = pos >> 2, qt = pos & 3;
                const f32x4 pn = mm64(Pc, Pt, pt, qt, (f32x4){0.f, 0.f, 0.f, 0.f}, lane);
                st_tile(Pco, pt, qt, pn, lane); st_tile_T(Pto, pt, qt, pn, lane); }
            __syncthreads();
#pragma unroll
            for (int q = 0; q < 2; ++q) { const int pos = wv * 2 + q, pt = pos >> 2, qt = pos & 3;
                Tacc[q] = mm64(Tin, Pto, pt, qt, Tacc[q], lane);
                st_tile(Tout, pt, qt, Tacc[q], lane); }
            __syncthreads();
        }
        TSTAMP(4);
        RETID();
#pragma unroll
        for (int q = 0; q < 2; ++q) { const int pos = wv * 2 + q, pt = pos >> 2, qt = pos & 3; const f32x4 z = (f32x4){0.f, 0.f, 0.f, 0.f};
            st_tile(SL(14), pt, qt, mm64(SL(7), SL(8), pt, qt, z, lane), lane);
            st_tile(SL(15), pt, qt, mm64(SL(4), SL(2), pt, qt, z, lane), lane); }
        __syncthreads();
#pragma unroll
        for (int q = 0; q < 2; ++q) { const int pos = wv * 2 + q, pt = pos >> 2, qt = pos & 3;
            const f32x4 r = mm64(SL(14), SL(2), pt, qt, (f32x4){0.f, 0.f, 0.f, 0.f}, lane);
            st_tile(SL(16), pt, qt, -r, lane); }
        __syncthreads();
#pragma unroll
        for (int q = 0; q < 2; ++q) { const int pos = wv * 2 + q, pt = pos >> 2, qt = pos & 3; const f32x4 z = (f32x4){0.f, 0.f, 0.f, 0.f};
            f32x4 y0 = mm64(SL(7), SL(9), pt, qt, z, lane); y0 = mm64(SL(16), SL(10), pt, qt, y0, lane);
            st_tile(SL(0), pt, qt, y0, lane);
            const f32x4 rt = ld4bf(SL(3) + (pt * 16 + fr) * LDT + qt * 16 + fq * 4);
            const f32x4 aw = mm64(SL(10), SL(15), pt, qt, z, lane);
            st_tile(SL(1), pt, qt, rt - aw, lane);
            f32x4 m = -mm64(SL(5), SL(15), pt, qt, z, lane);
#pragma unroll
            for (int j = 0; j < 4; ++j) if (qt * 16 + fq * 4 + j == pt * 16 + fr) m[j] += gl_s[pt * 16 + fr];
            st_tile(SL(11), pt, qt, m, lane);
            f32x4 nn = mm64(SL(7), SL(6), pt, qt, z, lane); nn = mm64(SL(16), SL(5), pt, qt, nn, lane);
            st_tile(SL(12), pt, qt, nn, lane);
        }
        __syncthreads();
        TSTAMP(5);
        RETID();
        { bf16_t* dst = FR + (size_t)u * 16384;
          { const int which = tid >> 8, it = (tid >> 6) & 3, l = tid & 63, r = l & 31, hh = l >> 5;
            const int k0 = 32 * (it >> 1) + 16 * (it & 1) + 4 * hh;
            { const bf16_t* src = SL(1) + (32 * which + r) * LDT + k0; u32x2 a = *(const u32x2*)src, b = *(const u32x2*)(src + 8); u32x4 w; w.x = a.x; w.y = a.y; w.z = b.x; w.w = b.y;
              *(u32x4*)(dst + ((which * 4 + it) * 64 + l) * 8) = w; }
            { const bf16_t* src = SL(11) + (32 * which + r) * LDT + k0; u32x2 a = *(const u32x2*)src, b = *(const u32x2*)(src + 8); u32x4 w; w.x = a.x; w.y = a.y; w.z = b.x; w.w = b.y;
              *(u32x4*)(dst + 4096 + ((which * 4 + it) * 64 + l) * 8) = w; }
          }
          {
            const int sel = tid >> 8, x = (tid >> 7) & 1, vb = (tid >> 6) & 1, l = tid & 63, r = l & 31, hh = l >> 5;
            const bf16_t* src = (sel == 0 ? SL(12) : SL(0)) + (32 * vb + r) * LDT + 32 * x + 4 * hh;
            const u32x2 g0 = *(const u32x2*)src, g1 = *(const u32x2*)(src + 8), g2 = *(const u32x2*)(src + 16), g3 = *(const u32x2*)(src + 24);
            u32x4 w0, w1; w0.x = g0.x; w0.y = g0.y; w0.z = g1.x; w0.w = g1.y; w1.x = g2.x; w1.y = g2.y; w1.z = g3.x; w1.w = g3.y;
            bf16_t* d2 = dst + 8192 + sel * 4096 + ((x * 2 + vb) * 64 + l) * 16;
            *(u32x4*)d2 = w0; *(u32x4*)(d2 + 8) = w1;
          }
        }
        __syncthreads();
        TSTAMP(6);
    }
#undef RW_ISSUE
#undef SL
#undef RETID
#undef tid
#undef lane
#undef wv
#undef fr
#undef fq
}

__device__ __forceinline__ bf16x8 pack8(const f32x16& x, int s8) {
    u32x4 w; w.x = pk2(x[s8], x[s8 + 1]); w.y = pk2(x[s8 + 2], x[s8 + 3]); w.z = pk2(x[s8 + 4], x[s8 + 5]); w.w = pk2(x[s8 + 6], x[s8 + 7]);
    return __builtin_bit_cast(bf16x8, w);
}
__device__ __forceinline__ f32x16 unpack16(const u32x4 a, const u32x4 b) {
    f32x16 o;
    o[0] = BLO(a.x); o[1] = BHI(a.x); o[2] = BLO(a.y); o[3] = BHI(a.y); o[4] = BLO(a.z); o[5] = BHI(a.z); o[6] = BLO(a.w); o[7] = BHI(a.w);
    o[8] = BLO(b.x); o[9] = BHI(b.x); o[10] = BLO(b.y); o[11] = BHI(b.y); o[12] = BLO(b.z); o[13] = BHI(b.z); o[14] = BLO(b.w); o[15] = BHI(b.w);
    return o;
}


__device__ __forceinline__ void phase_rwkv_scan4(const Params& p, unsigned char* smem_, int bh) {
    int tidv = threadIdx.x; asm volatile("" : "+v"(tidv));
    const int lane = tidv & 63, wv = __builtin_amdgcn_readfirstlane(tidv >> 6);
    const int b = bh >> 3, h = bh & 7;
    const bf16_t* FR = (const bf16_t*)p.out; bf16_t* Y = (bf16_t*)(p.ws + OFF_Y);
    constexpr int PD = 4; constexpr int SFB = 98304;
    if (wv >= 2 && wv < 6) {
        const int pc0 = (wv - 2) * 512 + lane;
        u32x4 buf[PD][8];
#define SC_LOAD(k, c) do { const bf16_t* src = FR + (size_t)(((b * 64 + (c)) * 8 + h)) * 16384; _Pragma("unroll") for (int i = 0; i < 8; ++i) buf[k][i] = *(const u32x4*)(src + (size_t)(pc0 + 64 * i) * 8); } while (0)
#define SC_PUT(k, c) do { bf16_t* dst = (bf16_t*)(smem_ + ((c) % 3) * 32768); _Pragma("unroll") for (int i = 0; i < 8; ++i) *(u32x4*)(dst + (pc0 + 64 * i) * 8) = buf[k][i]; } while (0)
#pragma unroll
        for (int k = 0; k < PD; ++k) SC_LOAD(k, k);
        SC_PUT(0, 0); SC_LOAD(0, PD);
        __syncthreads();
#pragma unroll 1
        for (int c0 = 0; c0 < 64; c0 += PD) {
#pragma unroll
            for (int kk = 0; kk < PD; ++kk) {
                const int c = c0 + kk, k = (kk + 1) % PD;
                if (c + 1 < 64) { SC_PUT(k, c + 1); if (c + 1 + PD < 64) SC_LOAD(k, c + 1 + PD); }
                __syncthreads();
            }
        }
        __syncthreads();
#undef SC_LOAD
#undef SC_PUT
    } else if (wv < 2) {
        const int vb = wv;
        f32x16 S0, S1;
#pragma unroll
        for (int i = 0; i < 16; ++i) { S0[i] = 0.f; S1[i] = 0.f; }
        __syncthreads();
#pragma unroll 1
        for (int c = 0; c < 64; ++c) {
            const bf16_t* src = (const bf16_t*)(smem_ + (c % 3) * 32768);
            u32x4 mf[8], nf[4];
#pragma unroll
            for (int i = 0; i < 8; ++i) mf[i] = *(const u32x4*)(src + 4096 + (i * 64 + lane) * 8);
#pragma unroll
            for (int x = 0; x < 2; ++x) { const bf16_t* s2 = src + 8192 + ((x * 2 + vb) * 64 + lane) * 16; nf[2 * x] = *(const u32x4*)s2; nf[2 * x + 1] = *(const u32x4*)(s2 + 8); }
            bf16x8 sf[4];
            sf[0] = pack8(S0, 0); sf[1] = pack8(S0, 8); sf[2] = pack8(S1, 0); sf[3] = pack8(S1, 8);
            { unsigned char* sb = smem_ + SFB + (c & 1) * 8192 + vb * 4096;
#pragma unroll
              for (int s = 0; s < 4; ++s) *(bf16x8*)(sb + (s * 64 + lane) * 16) = sf[s]; }
            f32x16 n0 = unpack16(nf[0], nf[1]), n1 = unpack16(nf[2], nf[3]);
#pragma unroll
            for (int s = 0; s < 4; ++s) { n0 = MFMA32(__builtin_bit_cast(bf16x8, mf[s]), sf[s], n0); n1 = MFMA32(__builtin_bit_cast(bf16x8, mf[4 + s]), sf[s], n1); }
            S0 = n0; S1 = n1;
            __syncthreads();
        }
        __syncthreads();
    } else {
        const int vb = wv - 6, r = lane & 31, hh = lane >> 5;
        __syncthreads();
#pragma unroll 1
        for (int c = 0; c <= 64; ++c) {
            if (c >= 1) {
                const int cc = c - 1;
                const bf16_t* src = (const bf16_t*)(smem_ + (cc % 3) * 32768);
                u32x4 qf[8], yf[4]; bf16x8 sf[4];
#pragma unroll
                for (int i = 0; i < 8; ++i) qf[i] = *(const u32x4*)(src + (i * 64 + lane) * 8);
#pragma unroll
                for (int x = 0; x < 2; ++x) { const bf16_t* s3 = src + 12288 + ((x * 2 + vb) * 64 + lane) * 16; yf[2 * x] = *(const u32x4*)s3; yf[2 * x + 1] = *(const u32x4*)(s3 + 8); }
                { const unsigned char* sb = smem_ + SFB + (cc & 1) * 8192 + vb * 4096;
#pragma unroll
                  for (int s = 0; s < 4; ++s) sf[s] = *(const bf16x8*)(sb + (s * 64 + lane) * 16); }
                f32x16 y0 = unpack16(yf[0], yf[1]), y1 = unpack16(yf[2], yf[3]);
#pragma unroll
                for (int s = 0; s < 4; ++s) { y0 = MFMA32(__builtin_bit_cast(bf16x8, qf[s]), sf[s], y0); y1 = MFMA32(__builtin_bit_cast(bf16x8, qf[4 + s]), sf[s], y1); }
                bf16_t* yp = Y + ((size_t)(b * 4096 + cc * 64)) * 512 + h * 64 + vb * 32 + r;
#pragma unroll
                for (int i = 0; i < 16; ++i) { const int row = (i & 3) + 8 * (i >> 2) + 4 * hh; yp[(size_t)row * 512] = (bf16_t)f2bf(y0[i]); yp[(size_t)(32 + row) * 512] = (bf16_t)f2bf(y1[i]); }
            }
            __syncthreads();
        }
    }
}

__device__ __forceinline__ void ml_gates(const Params& p, int n0, int h, float* bcum_s, float* ig_s) {
    if (threadIdx.x < 64) {
        const int lane = threadIdx.x; const float* ifg = (const float*)(p.ws + OFF_IFG);
        const float ig = ifg[(n0 + lane) * 8 + h] + p.in[18][h];
        const float fp = ifg[(n0 + lane) * 8 + 4 + h] + p.in[19][h];
        float c = -softplusf_(-fp);
#pragma unroll
        for (int o = 1; o < 64; o <<= 1) { const float t = __shfl_up(c, o); if (lane >= o) c += t; }
        bcum_s[lane] = c; ig_s[lane] = ig;
    }
}
__device__ __forceinline__ float siluf_(float x) { return x * sigmoidf_(x); }


template <int K> __device__ __forceinline__ f32x4 mmk(const bf16_t* P, int ldp, const bf16_t* Q, int ldq, int pt, int qt, f32x4 acc, int lane_) {
#pragma unroll
    for (int k0 = 0; k0 < K; k0 += 32) {
        const bf16x8 a = *(const bf16x8*)(Q + (qt * 16 + (lane_ & 15)) * ldq + k0 + (lane_ >> 4) * 8);
        const bf16x8 b = *(const bf16x8*)(P + (pt * 16 + (lane_ & 15)) * ldp + k0 + (lane_ >> 4) * 8);
        acc = MFMA16(a, b, acc);
    }
    return acc;
}
__device__ __forceinline__ float fast_silu(float x) { return x * __builtin_amdgcn_rcpf(1.f + __expf(-x)); }

__device__ __forceinline__ void phase_ml_cloc2(const Params& p, unsigned char* smem_, int first, int stride) {
    int tidv = threadIdx.x;
#define RETID() asm volatile("" : "+v"(tidv))
    bf16_t* RAWK = (bf16_t*)smem_;
    bf16_t* RAWV = (bf16_t*)(smem_ + 18432);
    bf16_t* KT = (bf16_t*)(smem_ + 36864);
    bf16_t* VT = (bf16_t*)(smem_ + 55296);
    float* bcum_s = (float*)(smem_ + 73728); float* ig_s = bcum_s + 64;
    const bf16_t* zml = (const bf16_t*)(p.ws + OFF_ZML);
    bf16_t* CLOC = (bf16_t*)(p.ws + OFF_CLOC); float* nloc = (float*)(p.ws + OFF_NLOC); float* gend = (float*)(p.ws + OFF_GEND);
    for (int u = first; u < 1024; u += stride) {
        RETID();
        const int tid = tidv, h = u & 3, bc = u >> 2; const int n0 = bc * 64, t0 = (bc & 63) * 64;
        u32x4 kr[3], vr[2];
#pragma unroll
        for (int j = 0; j < 3; ++j) { const int task = tid + 512 * j, i = task >> 4, c8 = task & 15;
            kr[j] = (task < 1072 && t0 + i - 3 >= 0) ? *(const u32x4*)(zml + (size_t)(n0 + i - 3) * 2048 + 512 + h * 128 + c8 * 8) : (u32x4){0u, 0u, 0u, 0u}; }
#pragma unroll
        for (int j = 0; j < 2; ++j) { const int task = tid + 512 * j, i = task >> 4, c8 = task & 15; vr[j] = *(const u32x4*)(zml + (size_t)(n0 + i) * 2048 + 1024 + h * 128 + c8 * 8); }
        float tt[8]; bf16_t* tdst; int tK, tkb, tnb;
        { const int nl = tid & 63, kl0 = tid >> 6;
          if (u < 512) { tkb = u >> 5; tnb = u & 31; tK = 1024; tdst = (bf16_t*)(p.ws + OFF_WQT);
#pragma unroll
              for (int i = 0; i < 8; ++i) { const int k = tkb * 64 + kl0 + 8 * i; tt[i] = p.in[26][(size_t)k * 2048 + tnb * 64 + nl] * p.in[25][k]; } }
          else if (u < 768) { const int r = u - 512; tkb = r >> 4; tnb = r & 15; tK = 1024; tdst = (bf16_t*)(p.ws + OFF_WOUTT);
#pragma unroll
              for (int i = 0; i < 8; ++i) { const int k = tkb * 64 + kl0 + 8 * i; tt[i] = p.in[24][(size_t)k * 1024 + tnb * 64 + nl]; } }
          else if (u < 896) { const int r = u - 768; tkb = r >> 4; tnb = r & 15; tK = 512; tdst = (bf16_t*)(p.ws + OFF_PRWT);
#pragma unroll
              for (int i = 0; i < 8; ++i) { const int k = tkb * 64 + kl0 + 8 * i; tt[i] = p.in[22][(size_t)k * 1024 + tnb * 64 + nl]; } }
          else { const int r = u - 896; tkb = r >> 4; tnb = r & 15; tK = 512; tdst = (bf16_t*)(p.ws + OFF_PMLT);
#pragma unroll
              for (int i = 0; i < 8; ++i) { const int k = tkb * 64 + kl0 + 8 * i; tt[i] = p.in[23][(size_t)k * 1024 + tnb * 64 + nl]; } } }
        ml_gates(p, n0, h, bcum_s, ig_s);
        { float* TB = (float*)(smem_ + 81920); const int nl = tid & 63, kl0 = tid >> 6;
#pragma unroll
          for (int i = 0; i < 8; ++i) TB[(kl0 + 8 * i) * 65 + nl] = tt[i]; }
#pragma unroll
        for (int j = 0; j < 3; ++j) { const int task = tid + 512 * j, i = task >> 4, c8 = task & 15; if (task < 1072) *(u32x4*)(RAWK + i * 136 + c8 * 8) = kr[j]; }
#pragma unroll
        for (int j = 0; j < 2; ++j) { const int task = tid + 512 * j, i = task >> 4, c8 = task & 15; *(u32x4*)(RAWV + i * 136 + c8 * 8) = vr[j]; }
        __syncthreads();
        RETID();
        { const float* TB = (const float*)(smem_ + 81920); const int n = tidv & 63, kc = tidv >> 6; const float* c0 = TB + (kc * 8) * 65 + n;
          u32x4 w; w.x = pk2(c0[0], c0[65]); w.y = pk2(c0[130], c0[195]); w.z = pk2(c0[260], c0[325]); w.w = pk2(c0[390], c0[455]);
          *(u32x4*)(tdst + (size_t)(tnb * 64 + n) * tK + tkb * 64 + kc * 8) = w; }
        { const int c = tidv & 127, sg = tidv >> 7, s0 = sg * 16, hc = h * 128 + c;
          const float w0 = p.in[16][0 * 512 + hc], w1 = p.in[16][1 * 512 + hc], w2 = p.in[16][2 * 512 + hc], w3 = p.in[16][3 * 512 + hc], bk = p.in[17][hc];
          const float ge = bcum_s[63];
          if (tidv == 0) gend[u] = ge;
          float xm3 = bf2f(RAWK[(s0 + 0) * 136 + c]), xm2 = bf2f(RAWK[(s0 + 1) * 136 + c]), xm1 = bf2f(RAWK[(s0 + 2) * 136 + c]);
          unsigned kp[8], vp[8]; float kprev = 0.f, vprev = 0.f;
#pragma unroll
          for (int i = 0; i < 16; ++i) {
              const int s = s0 + i; const float xc = bf2f(RAWK[(s + 3) * 136 + c]);
              const float kv = fast_silu(bk + w0 * xm3 + w1 * xm2 + w2 * xm1 + w3 * xc) * 0.08838834764831845f;
              xm3 = xm2; xm2 = xm1; xm1 = xc;
              const float vv = __expf(ge - bcum_s[s] + ig_s[s]) * bf2f(RAWV[s * 136 + c]);
              if (i & 1) { kp[i >> 1] = pk2(kprev, kv); vp[i >> 1] = pk2(vprev, vv); } else { kprev = kv; vprev = vv; }
          }
          u32x4 w; w.x = kp[0]; w.y = kp[1]; w.z = kp[2]; w.w = kp[3]; *(u32x4*)(KT + c * 72 + s0) = w; w.x = kp[4]; w.y = kp[5]; w.z = kp[6]; w.w = kp[7]; *(u32x4*)(KT + c * 72 + s0 + 8) = w;
          w.x = vp[0]; w.y = vp[1]; w.z = vp[2]; w.w = vp[3]; *(u32x4*)(VT + c * 72 + s0) = w; w.x = vp[4]; w.y = vp[5]; w.z = vp[6]; w.w = vp[7]; *(u32x4*)(VT + c * 72 + s0 + 8) = w;
        }
        __syncthreads();
        RETID();
        { const int lane_ = tidv & 63, wv_ = tidv >> 6, fr_ = lane_ & 15, fq_ = lane_ >> 4;
#pragma unroll
          for (int qt = 0; qt < 8; ++qt) {
              const f32x4 z = mmk<64>(VT, 72, KT, 72, wv_, qt, (f32x4){0.f, 0.f, 0.f, 0.f}, lane_);
              u32x2 w; w.x = pk2(z[0], z[1]); w.y = pk2(z[2], z[3]);
              *(u32x2*)(CLOC + ((size_t)u * 128 + wv_ * 16 + fr_) * 128 + qt * 16 + fq_ * 4) = w;
          }
          if (tidv < 128) { const int k = tidv; float a = 0.f;
#pragma unroll
              for (int s8 = 0; s8 < 64; s8 += 8) { const u32x4 r = *(const u32x4*)(KT + k * 72 + s8);
                  const float ge = bcum_s[63];
                  a += __expf(ge - bcum_s[s8 + 0] + ig_s[s8 + 0]) * BLO(r.x) + __expf(ge - bcum_s[s8 + 1] + ig_s[s8 + 1]) * BHI(r.x)
                     + __expf(ge - bcum_s[s8 + 2] + ig_s[s8 + 2]) * BLO(r.y) + __expf(ge - bcum_s[s8 + 3] + ig_s[s8 + 3]) * BHI(r.y)
                     + __expf(ge - bcum_s[s8 + 4] + ig_s[s8 + 4]) * BLO(r.z) + __expf(ge - bcum_s[s8 + 5] + ig_s[s8 + 5]) * BHI(r.z)
                     + __expf(ge - bcum_s[s8 + 6] + ig_s[s8 + 6]) * BLO(r.w) + __expf(ge - bcum_s[s8 + 7] + ig_s[s8 + 7]) * BHI(r.w); }
              nloc[u * 128 + k] = a; }
        }
        __syncthreads();
    }
#undef RETID
}

__device__ __forceinline__ void phase_ml_out2(const Params& p, unsigned char* smem_) {
    int tidv = threadIdx.x;
#define RETID() asm volatile("" : "+v"(tidv))
    bf16_t* RAWQ = (bf16_t*)smem_;
    bf16_t* RAWK = (bf16_t*)(smem_ + 18432);
    bf16_t* RAWV = (bf16_t*)(smem_ + 36864);
    bf16_t* Qm = (bf16_t*)(smem_ + 55296);
    bf16_t* Km = (bf16_t*)(smem_ + 73728);
    bf16_t* VT = (bf16_t*)(smem_ + 92160);
    bf16_t* Cin = (bf16_t*)(smem_ + 110592);
    float* bcum_s = (float*)(smem_ + 145408); float* ig_s = bcum_s + 64; float* nin_s = ig_s + 64; float* den_s = nin_s + 128; float* st_s = den_s + 64;
    bf16_t* PM = RAWQ; bf16_t* QE = RAWK;
    const bf16_t* zml = (const bf16_t*)(p.ws + OFF_ZML); const bf16_t* CLOC = (const bf16_t*)(p.ws + OFF_CLOC); const float* nloc = (const float*)(p.ws + OFF_NLOC);
    bf16_t* YML = (bf16_t*)(p.ws + OFF_YML);
    for (int u = blockIdx.x; u < 1024; u += gridDim.x) {
        RETID();
        const int tid = tidv, h = u & 3, bc = u >> 2; const int n0 = bc * 64, t0 = (bc & 63) * 64;
        { u32x4 qr[3], kr[3], vr[2], cr[4];
#pragma unroll
          for (int j = 0; j < 3; ++j) { const int task = tid + 512 * j, i = task >> 4, c8 = task & 15; const bool ok = task < 1072 && t0 + i - 3 >= 0;
              const bf16_t* src = zml + (size_t)(n0 + i - 3) * 2048 + h * 128 + c8 * 8;
              qr[j] = ok ? *(const u32x4*)src : (u32x4){0u, 0u, 0u, 0u}; kr[j] = ok ? *(const u32x4*)(src + 512) : (u32x4){0u, 0u, 0u, 0u}; }
#pragma unroll
          for (int j = 0; j < 2; ++j) { const int task = tid + 512 * j, i = task >> 4, c8 = task & 15; vr[j] = *(const u32x4*)(zml + (size_t)(n0 + i) * 2048 + 1024 + h * 128 + c8 * 8); }
#pragma unroll
          for (int j = 0; j < 4; ++j) { const int task = tid + 512 * j, v = task >> 4, c8 = task & 15; cr[j] = *(const u32x4*)(CLOC + ((size_t)u * 128 + v) * 128 + c8 * 8); }
          ml_gates(p, n0, h, bcum_s, ig_s);
          if (tid < 128) nin_s[tid] = nloc[u * 128 + tid];
#pragma unroll
          for (int j = 0; j < 3; ++j) { const int task = tid + 512 * j, i = task >> 4, c8 = task & 15; if (task < 1072) { *(u32x4*)(RAWQ + i * 136 + c8 * 8) = qr[j]; *(u32x4*)(RAWK + i * 136 + c8 * 8) = kr[j]; } }
#pragma unroll
          for (int j = 0; j < 2; ++j) { const int task = tid + 512 * j, i = task >> 4, c8 = task & 15; *(u32x4*)(RAWV + i * 136 + c8 * 8) = vr[j]; }
#pragma unroll
          for (int j = 0; j < 4; ++j) { const int task = tid + 512 * j, v = task >> 4, c8 = task & 15; *(u32x4*)(Cin + v * 136 + c8 * 8) = cr[j]; }
        }
        __syncthreads();
        RETID();
        float qe[16];
        { const int c = tidv & 127, sg = tidv >> 7, s0 = sg * 16, hc = h * 128 + c;
          const float q0 = p.in[14][0 * 512 + hc], q1 = p.in[14][1 * 512 + hc], q2 = p.in[14][2 * 512 + hc], q3 = p.in[14][3 * 512 + hc], bq = p.in[15][hc];
          const float w0 = p.in[16][0 * 512 + hc], w1 = p.in[16][1 * 512 + hc], w2 = p.in[16][2 * 512 + hc], w3 = p.in[16][3 * 512 + hc], bk = p.in[17][hc];
          float xm3 = bf2f(RAWK[(s0 + 0) * 136 + c]), xm2 = bf2f(RAWK[(s0 + 1) * 136 + c]), xm1 = bf2f(RAWK[(s0 + 2) * 136 + c]);
          float ym3 = bf2f(RAWQ[(s0 + 0) * 136 + c]), ym2 = bf2f(RAWQ[(s0 + 1) * 136 + c]), ym1 = bf2f(RAWQ[(s0 + 2) * 136 + c]);
          unsigned vp[8]; float vprev = 0.f;
#pragma unroll
          for (int i = 0; i < 16; ++i) {
              const int s = s0 + i; const float xc = bf2f(RAWK[(s + 3) * 136 + c]), yc = bf2f(RAWQ[(s + 3) * 136 + c]);
              const float kv = fast_silu(bk + w0 * xm3 + w1 * xm2 + w2 * xm1 + w3 * xc) * 0.08838834764831845f;
              const float qv = fast_silu(bq + q0 * ym3 + q1 * ym2 + q2 * ym1 + q3 * yc);
              xm3 = xm2; xm2 = xm1; xm1 = xc; ym3 = ym2; ym2 = ym1; ym1 = yc;
              Km[s * 136 + c] = (bf16_t)f2bf(kv); Qm[s * 136 + c] = (bf16_t)f2bf(qv); qe[i] = qv * __expf(bcum_s[s]);
              const float vv = bf2f(RAWV[s * 136 + c]);
              if (i & 1) vp[i >> 1] = pk2(vprev, vv); else vprev = vv;
          }
          u32x4 w; w.x = vp[0]; w.y = vp[1]; w.z = vp[2]; w.w = vp[3]; *(u32x4*)(VT + c * 72 + s0) = w; w.x = vp[4]; w.y = vp[5]; w.z = vp[6]; w.w = vp[7]; *(u32x4*)(VT + c * 72 + s0 + 8) = w;
        }
        __syncthreads();
        RETID();
        { const int c = tidv & 127, s0 = (tidv >> 7) * 16;
#pragma unroll
          for (int i = 0; i < 16; ++i) QE[(s0 + i) * 136 + c] = (bf16_t)f2bf(qe[i]); }
        { const int lane_ = tidv & 63, wv_ = tidv >> 6, fr_ = lane_ & 15, fq_ = lane_ >> 4;
#pragma unroll
          for (int q = 0; q < 2; ++q) { const int pos = wv_ * 2 + q, pt = pos >> 2, qt = pos & 3;
              f32x4 sc = mmk<128>(Qm, 136, Km, 136, pt, qt, (f32x4){0.f, 0.f, 0.f, 0.f}, lane_);
              const int l = pt * 16 + fr_; const float bl = bcum_s[l];
#pragma unroll
              for (int j = 0; j < 4; ++j) { const int s = qt * 16 + fq_ * 4 + j; sc[j] = (s <= l) ? sc[j] * __expf(bl - bcum_s[s] + ig_s[s]) : 0.f; }
              u32x2 w; w.x = pk2(sc[0], sc[1]); w.y = pk2(sc[2], sc[3]);
              *(u32x2*)(PM + l * 72 + qt * 16 + fq_ * 4) = w; }
        }
        __syncthreads();
        RETID();
        {
          const int l = tidv >> 3, sq = tidv & 7;
          const u32x4 pr = *(const u32x4*)(PM + l * 72 + sq * 8);
          float ds = ((BLO(pr.x) + BHI(pr.x)) + (BLO(pr.y) + BHI(pr.y))) + ((BLO(pr.z) + BHI(pr.z)) + (BLO(pr.w) + BHI(pr.w)));
          const u32x4 qa = *(const u32x4*)(QE + l * 136 + sq * 16), qb = *(const u32x4*)(QE + l * 136 + sq * 16 + 8);
          const float* nn = nin_s + sq * 16;
          float qn = BLO(qa.x) * nn[0] + BHI(qa.x) * nn[1] + BLO(qa.y) * nn[2] + BHI(qa.y) * nn[3] + BLO(qa.z) * nn[4] + BHI(qa.z) * nn[5] + BLO(qa.w) * nn[6] + BHI(qa.w) * nn[7]
                   + BLO(qb.x) * nn[8] + BHI(qb.x) * nn[9] + BLO(qb.y) * nn[10] + BHI(qb.y) * nn[11] + BLO(qb.z) * nn[12] + BHI(qb.z) * nn[13] + BLO(qb.w) * nn[14] + BHI(qb.w) * nn[15];
          ds = sum8(ds + qn);
          if (sq == 0) den_s[l] = ds;
        }
        __syncthreads();
        RETID();
        { const int lane_ = tidv & 63, wv_ = tidv >> 6, fr_ = lane_ & 15, fq_ = lane_ >> 4;
          const int pt = wv_ >> 1, vh = wv_ & 1, l = pt * 16 + fr_;
          const float dn = __builtin_amdgcn_rcpf(fmaxf(fabsf(den_s[l]), 1.f));
          f32x4 hv[4]; float sm = 0.f, sq2 = 0.f;
#pragma unroll
          for (int q = 0; q < 4; ++q) { const int qt = vh * 4 + q;
              f32x4 a = mmk<64>(PM, 72, VT, 72, pt, qt, (f32x4){0.f, 0.f, 0.f, 0.f}, lane_);
              a = mmk<128>(QE, 136, Cin, 136, pt, qt, a, lane_);
              hv[q] = a * dn;
              sm += (hv[q][0] + hv[q][1]) + (hv[q][2] + hv[q][3]); sq2 += (hv[q][0] * hv[q][0] + hv[q][1] * hv[q][1]) + (hv[q][2] * hv[q][2] + hv[q][3] * hv[q][3]); }
          sm += __shfl_xor(sm, 16); sm += __shfl_xor(sm, 32); sq2 += __shfl_xor(sq2, 16); sq2 += __shfl_xor(sq2, 32);
          if (fq_ == 0) { st_s[(vh * 64 + l) * 2] = sm; st_s[(vh * 64 + l) * 2 + 1] = sq2; }
          __syncthreads();
          const float s1 = st_s[l * 2] + st_s[(64 + l) * 2], s2 = st_s[l * 2 + 1] + st_s[(64 + l) * 2 + 1];
          const float mean = s1 * (1.f / 128.f); const float var = fmaxf(s2 * (1.f / 128.f) - mean * mean, 0.f); const float rs = __builtin_amdgcn_rsqf(var + 1e-5f);
#pragma unroll
          for (int q = 0; q < 4; ++q) { const int hc = h * 128 + (vh * 4 + q) * 16 + fq_ * 4;
              const f32x4 nw = *(const f32x4*)(p.in[20] + hc);
              const u32x2 op = *(const u32x2*)(zml + (size_t)(n0 + l) * 2048 + 1536 + hc);
              const float o0 = (hv[q][0] - mean) * rs * nw[0] * sigmoidf_(BLO(op.x)), o1 = (hv[q][1] - mean) * rs * nw[1] * sigmoidf_(BHI(op.x));
              const float o2 = (hv[q][2] - mean) * rs * nw[2] * sigmoidf_(BLO(op.y)), o3 = (hv[q][3] - mean) * rs * nw[3] * sigmoidf_(BHI(op.y));
              u32x2 w; w.x = pk2(o0, o1); w.y = pk2(o2, o3);
              *(u32x2*)(YML + (size_t)(n0 + l) * 512 + hc) = w; }
        }
        __syncthreads();
    }
#undef RETID
}

__device__ __forceinline__ void phase_ml_scan(const Params& p) {
    bf16_t* CLOC = (bf16_t*)(p.ws + OFF_CLOC); float* nloc = (float*)(p.ws + OFF_NLOC); const float* gend = (const float*)(p.ws + OFF_GEND);
    const int gt = blockIdx.x * 512 + threadIdx.x, nt = gridDim.x * 512;
    for (int task = gt; task < 32768 + 2048; task += nt) {
        if (task < 32768) {
            const int bh = task >> 11, rem = task & 2047; const int b = bh >> 2, h = bh & 3;
            float run[8];
#pragma unroll
            for (int j = 0; j < 8; ++j) run[j] = 0.f;
            for (int c0 = 0; c0 < 64; c0 += 8) {
                u32x4 raw[8]; float g[8];
#pragma unroll
                for (int i = 0; i < 8; ++i) { const int unit = (b * 64 + c0 + i) * 4 + h; raw[i] = *(const u32x4*)(CLOC + (size_t)unit * 16384 + rem * 8); g[i] = __expf(gend[unit]); }
#pragma unroll
                for (int i = 0; i < 8; ++i) { const int unit = (b * 64 + c0 + i) * 4 + h;
                    u32x4 w; w.x = pk2(run[0], run[1]); w.y = pk2(run[2], run[3]); w.z = pk2(run[4], run[5]); w.w = pk2(run[6], run[7]);
                    *(u32x4*)(CLOC + (size_t)unit * 16384 + rem * 8) = w;
                    run[0] = g[i] * run[0] + __uint_as_float(raw[i].x << 16); run[1] = g[i] * run[1] + __uint_as_float(raw[i].x & 0xffff0000u);
                    run[2] = g[i] * run[2] + __uint_as_float(raw[i].y << 16); run[3] = g[i] * run[3] + __uint_as_float(raw[i].y & 0xffff0000u);
                    run[4] = g[i] * run[4] + __uint_as_float(raw[i].z << 16); run[5] = g[i] * run[5] + __uint_as_float(raw[i].z & 0xffff0000u);
                    run[6] = g[i] * run[6] + __uint_as_float(raw[i].w << 16); run[7] = g[i] * run[7] + __uint_as_float(raw[i].w & 0xffff0000u); }
            }
        } else {
            const int t2 = task - 32768; const int bh = t2 >> 7, k = t2 & 127; const int b = bh >> 2, h = bh & 3;
            float run = 0.f;
            for (int c = 0; c < 64; ++c) { const int unit = (b * 64 + c) * 4 + h; const float x = nloc[unit * 128 + k]; nloc[unit * 128 + k] = run; run = __expf(gend[unit]) * run + x; }
        }
    }
}
__device__ __forceinline__ void phase_rwkv_post(const Params& p) {
    bf16_t* Y = (bf16_t*)(p.ws + OFF_Y); const bf16_t* V = (const bf16_t*)(p.ws + OFF_V); const bf16_t* G = (const bf16_t*)(p.ws + OFF_G);
    const float* bonus = (const float*)(p.ws + OFF_BONUS);
    const int tid = tid_opaque(), lane = tid & 63; const int gw = blockIdx.x * 8 + (tid >> 6), nw = gridDim.x * 8;
    const f32x4 gwa = *(const f32x4*)(p.in[12] + lane * 8), gwb = *(const f32x4*)(p.in[12] + lane * 8 + 4), gba = *(const f32x4*)(p.in[13] + lane * 8), gbb = *(const f32x4*)(p.in[13] + lane * 8 + 4);
    for (int n = gw; n < NTOK; n += nw) {
        const size_t o = (size_t)n * 512 + lane * 8;
        const u32x4 yr = *(const u32x4*)(Y + o), vr = *(const u32x4*)(V + o), gr = *(const u32x4*)(G + o);
        const float bon = bonus[n * 8 + (lane >> 3)];
        float y[8] = {BLO(yr.x), BHI(yr.x), BLO(yr.y), BHI(yr.y), BLO(yr.z), BHI(yr.z), BLO(yr.w), BHI(yr.w)};
        const float v[8] = {BLO(vr.x), BHI(vr.x), BLO(vr.y), BHI(vr.y), BLO(vr.z), BHI(vr.z), BLO(vr.w), BHI(vr.w)};
        const float g[8] = {BLO(gr.x), BHI(gr.x), BLO(gr.y), BHI(gr.y), BLO(gr.z), BHI(gr.z), BLO(gr.w), BHI(gr.w)};
        float s = ((y[0] + y[1]) + (y[2] + y[3])) + ((y[4] + y[5]) + (y[6] + y[7]));
        const float mean = sum8(s) * (1.f / 64.f);
        float q = 0.f;
#pragma unroll
        for (int i = 0; i < 8; ++i) { y[i] -= mean; q += y[i] * y[i]; }
        const float rs = __builtin_amdgcn_rsqf(sum8(q) * (1.f / 64.f) + 64e-5f);
        float r[8];
#pragma unroll
        for (int i = 0; i < 8; ++i) { const float gw_ = i < 4 ? gwa[i & 3] : gwb[i & 3], gb_ = i < 4 ? gba[i & 3] : gbb[i & 3]; r[i] = (y[i] * rs * gw_ + gb_ + bon * v[i]) * g[i]; }
        u32x4 w; w.x = pk2(r[0], r[1]); w.y = pk2(r[2], r[3]); w.z = pk2(r[4], r[5]); w.w = pk2(r[6], r[7]);
        *(u32x4*)(Y + o) = w;
    }
}


__device__ __forceinline__ void phase_peer_keys(const Params& p, unsigned char* smem_) {
    int tidv = threadIdx.x;
#define RETID() asm volatile("" : "+v"(tidv))
    bf16_t* SK = (bf16_t*)smem_;
    bf16_t* Qs = (bf16_t*)(smem_ + 34816);
    const bf16_t* q = (const bf16_t*)(p.ws + OFF_Q); const bf16_t* skt = (const bf16_t*)(p.ws + OFF_SKT); float* keys = (float*)(p.ws + OFF_KEYS);
    const int nb = gridDim.x;
    int gcur = -1;
    u32x4 qr[4];
#define PK_ISSUE(uu) do { const int g_ = (uu) & 15, n0_ = ((uu) >> 4) * 128; \
        _Pragma("unroll") for (int j = 0; j < 4; ++j) { const int idx = tidv + 512 * j, row = idx >> 4, pc = idx & 15; qr[j] = *(const u32x4*)(q + (size_t)(n0_ + row) * 2048 + g_ * 128 + pc * 8); } } while (0)
    if ((int)blockIdx.x < 2048) PK_ISSUE(blockIdx.x);
    for (int u = blockIdx.x; u < 2048; u += nb) {
        RETID();
        const int g = u & 15, n0 = (u >> 4) * 128;
        if (g != gcur) { gcur = g;
#pragma unroll
            for (int j = 0; j < 4; ++j) { const int idx = tidv + 512 * j, row = idx >> 4, pc = idx & 15; *(u32x4*)(SK + row * 136 + pc * 8) = *(const u32x4*)(skt + (size_t)(g * 128 + row) * 128 + pc * 8); } }
#pragma unroll
        for (int j = 0; j < 4; ++j) { const int idx = tidv + 512 * j, row = idx >> 4, pc = idx & 15; *(u32x4*)(Qs + row * 136 + pc * 8) = qr[j]; }
        __syncthreads();
        RETID();
        if (u + nb < 2048) PK_ISSUE(u + nb);
        const int lane_ = tidv & 63, wv_ = tidv >> 6, fr_ = lane_ & 15, fq_ = lane_ >> 4;
        const int wu = u * 8 + wv_;
        f32x4 tu[4], tv[4];
#pragma unroll
        for (int i = 0; i < 4; ++i) { tu[i] = __builtin_nontemporal_load((const f32x4*)(p.in[28] + (size_t)wu * 1024) + lane_ + 64 * i); tv[i] = __builtin_nontemporal_load((const f32x4*)(p.in[29] + (size_t)wu * 1024) + lane_ * 4 + i); }
        f32x4 acc[8];
#pragma unroll
        for (int kj = 0; kj < 8; ++kj) acc[kj] = (f32x4){0.f, 0.f, 0.f, 0.f};
#pragma unroll
        for (int ksp = 0; ksp < 4; ++ksp) {
            const bf16x8 a = *(const bf16x8*)(Qs + (wv_ * 16 + fr_) * 136 + ksp * 32 + fq_ * 8);
#pragma unroll
            for (int kj = 0; kj < 8; ++kj) { const bf16x8 b = *(const bf16x8*)(SK + (kj * 16 + fr_) * 136 + ksp * 32 + fq_ * 8); acc[kj] = MFMA16(a, b, acc[kj]); }
        }
#define KEY(kj, r) f2key(__uint_as_float((__float_as_uint(acc[kj][r]) & ~127u) | (unsigned)(127 - ((kj) * 16 + fr_))))
#define CEX(a, b) do { const int hi_ = max(a, b), lo_ = min(a, b); a = hi_; b = lo_; } while (0)
#define ROW_INIT(r) int a0##r = KEY(0, r), a1##r = KEY(1, r), a2##r = KEY(2, r), a3##r = KEY(3, r), a4##r = KEY(4, r), a5##r = KEY(5, r), a6##r = KEY(6, r), a7##r = KEY(7, r), rs##r = 0; \
        CEX(a0##r, a1##r); CEX(a2##r, a3##r); CEX(a4##r, a5##r); CEX(a6##r, a7##r); CEX(a0##r, a2##r); CEX(a1##r, a3##r); CEX(a4##r, a6##r); CEX(a5##r, a7##r); \
        CEX(a1##r, a2##r); CEX(a5##r, a6##r); CEX(a0##r, a4##r); CEX(a3##r, a7##r); CEX(a1##r, a5##r); CEX(a2##r, a6##r); CEX(a1##r, a4##r); CEX(a3##r, a6##r); \
        CEX(a2##r, a4##r); CEX(a3##r, a5##r); CEX(a3##r, a4##r);
#define ROW_STEP(r) do { const int m_ = imax16(a0##r); const bool w_ = a0##r == m_; \
        a0##r = w_ ? a1##r : a0##r; a1##r = w_ ? a2##r : a1##r; a2##r = w_ ? a3##r : a2##r; a3##r = w_ ? a4##r : a3##r; a4##r = w_ ? a5##r : a4##r; a5##r = w_ ? a6##r : a5##r; a6##r = w_ ? a7##r : a6##r; a7##r = w_ ? (int)0x80000000 : a7##r; \
        rs##r = (fr_ == it) ? m_ : rs##r; } while (0)
        ROW_INIT(0) ROW_INIT(1) ROW_INIT(2) ROW_INIT(3)
#pragma unroll 1
        for (int it = 0; it < 16; ++it) { ROW_STEP(0); ROW_STEP(1); ROW_STEP(2); ROW_STEP(3); }
        float res[4]; res[0] = key2f(rs0); res[1] = key2f(rs1); res[2] = key2f(rs2); res[3] = key2f(rs3);
#undef KEY
#undef CEX
#undef ROW_INIT
#undef ROW_STEP
#pragma unroll
        for (int r = 0; r < 4; ++r) keys[((size_t)(n0 + wv_ * 16 + fq_ * 4 + r) * 16 + g) * 16 + fr_] = res[r];
        { float mu_ = 0.f, mv_ = 0.f;
#pragma unroll
          for (int i = 0; i < 4; ++i) { mu_ = fmaxf(mu_, fmaxf(fmaxf(fabsf(tu[i][0]), fabsf(tu[i][1])), fmaxf(fabsf(tu[i][2]), fabsf(tu[i][3])))); mv_ = fmaxf(mv_, fmaxf(fmaxf(fabsf(tv[i][0]), fabsf(tv[i][1])), fmaxf(fabsf(tv[i][2]), fabsf(tv[i][3])))); }
#pragma unroll
          for (int o = 1; o < 64; o <<= 1) { mu_ = fmaxf(mu_, __shfl_xor(mu_, o)); mv_ = fmaxf(mv_, __shfl_xor(mv_, o)); }
          const float su = mu_ > 0.f ? 440.f / mu_ : 1.f;
          u32x4 wu4;
          { int q_ = __builtin_amdgcn_cvt_pk_fp8_f32(tu[0][0] * su, tu[0][1] * su, 0, false); wu4.x = (unsigned)__builtin_amdgcn_cvt_pk_fp8_f32(tu[0][2] * su, tu[0][3] * su, q_, true); }
          { int q_ = __builtin_amdgcn_cvt_pk_fp8_f32(tu[1][0] * su, tu[1][1] * su, 0, false); wu4.y = (unsigned)__builtin_amdgcn_cvt_pk_fp8_f32(tu[1][2] * su, tu[1][3] * su, q_, true); }
          { int q_ = __builtin_amdgcn_cvt_pk_fp8_f32(tu[2][0] * su, tu[2][1] * su, 0, false); wu4.z = (unsigned)__builtin_amdgcn_cvt_pk_fp8_f32(tu[2][2] * su, tu[2][3] * su, q_, true); }
          { int q_ = __builtin_amdgcn_cvt_pk_fp8_f32(tu[3][0] * su, tu[3][1] * su, 0, false); wu4.w = (unsigned)__builtin_amdgcn_cvt_pk_fp8_f32(tu[3][2] * su, tu[3][3] * su, q_, true); }
          *(u32x4*)(p.ws + OFF_U8 + (size_t)wu * 1024 + lane_ * 16) = wu4;
          {
            const float s6 = mv_ > 0.f ? 7.5f / mv_ : 1.f;
            v16f x0, x1;
#pragma unroll
            for (int i = 0; i < 16; ++i) { const float own = tv[i >> 2][i & 3] * s6; x0[i] = own; x1[i] = dpp_mov<0xF5>(own); }
            const v6u pk6 = __builtin_amdgcn_cvt_scalef32_2xpk16_fp6_f32(x0, x1, 1.0f);
            if ((lane_ & 1) == 0) { unsigned char* d6 = p.ws + OFF_V8 + (size_t)wu * 768 + (lane_ >> 1) * 24;
                u32x2 w0, w1, w2; w0.x = pk6[0]; w0.y = pk6[1]; w1.x = pk6[2]; w1.y = pk6[3]; w2.x = pk6[4]; w2.y = pk6[5];
                *(u32x2*)d6 = w0; *(u32x2*)(d6 + 8) = w1; *(u32x2*)(d6 + 16) = w2; } }
          if (lane_ == 0) { float* uinv_ = (float*)(p.ws + OFF_UINV); uinv_[wu] = mu_ > 0.f ? mu_ * (1.f / 440.f) : 1.f; uinv_[16384 + wu] = mv_ > 0.f ? mv_ * (1.f / 7.5f) : 1.f; } }
        __syncthreads();
    }
#undef PK_ISSUE
#undef RETID
}

typedef float f32x2v __attribute__((ext_vector_type(2)));
#define F8LO(x) __builtin_amdgcn_cvt_pk_f32_fp8((int)(x), false)
#define F8HI(x) __builtin_amdgcn_cvt_pk_f32_fp8((int)(x), true)
__device__ __forceinline__ f32x2v fma2(f32x2v a, f32x2v b, f32x2v c) { return __builtin_elementwise_fma(a, b, c); }
__device__ __forceinline__ float dot16f8(const u32x4 r, const f32x2v (&t)[8]) {
    f32x2v d = F8LO(r.x) * t[0];
    d = fma2(F8HI(r.x), t[1], d); d = fma2(F8LO(r.y), t[2], d); d = fma2(F8HI(r.y), t[3], d);
    d = fma2(F8LO(r.z), t[4], d); d = fma2(F8HI(r.z), t[5], d); d = fma2(F8LO(r.w), t[6], d); d = fma2(F8HI(r.w), t[7], d);
    return d.x + d.y;
}
__device__ const unsigned PK_PAIRS[16] = {0xe0331000u, 0xf0401101u, 0xff411202u, 0xff421303u, 0xff501404u, 0xff511505u, 0xff601606u, 0xff611707u, 0xff702008u, 0xff712109u, 0xff80220au, 0xff90230bu, 0xffa0240cu, 0xffb0300du, 0xffc0310eu, 0xffd0320fu};
template <int EMASK, int DUMMY> __device__ __forceinline__ void phase_peer_u(const Params& p, float* lds) {
    const int tid = tid_opaque(), lane = tid & 63, wv = tid >> 6;
    int* wl_e = (int*)lds + wv * 512; float* wl_g = (float*)(wl_e + 128); float* wl_us = wl_g + 128; float* wl_vs = wl_us + 128;
    const float* keys = (const float*)(p.ws + OFF_KEYS); const float* ss2 = (const float*)(p.ws + OFF_SS2P);
    const unsigned char* U8 = p.ws + OFF_U8; const unsigned char* V8 = p.ws + OFF_V8; const float* uinv = (const float*)(p.ws + OFF_UINV); const float* vinv = uinv + 16384;
    const float* g2 = p.in[25]; const float* fg = p.in[30];
    const bf16_t* x1b = (const bf16_t*)(p.ws + OFF_X1B); float* ACT = (float*)(p.ws + OFF_ACT + (DUMMY ? 16 * MiB : 0)); int* EID = (int*)(p.ws + OFF_EID + (DUMMY ? 16 * MiB : 0));
    for (int n = blockIdx.x * 8 + wv; n < NTOK; n += gridDim.x * 8) {
        const float rs2 = __builtin_amdgcn_rsqf(sum16(ss2[(size_t)(lane & 15) * NTOK + n]) * (1.f / 1024.f) + 1e-6f);
#pragma unroll 1
        for (int rr = 0; rr < 2; ++rr) {
            const int h = rr * 4 + (lane >> 4), jj = lane & 15;
            const float* kp = keys + ((size_t)n * 16 + h * 2) * 16;
            const float k0 = kp[jj], k1own = kp[16 + jj];
            const unsigned pt4 = PK_PAIRS[jj];
            int cand[4];
#pragma unroll
            for (int i = 0; i < 4; ++i) { const unsigned cd = (pt4 >> (8 * i)) & 255u;
                const float sum = kp[cd >> 4] + kp[16 + (cd & 15u)];
                cand[i] = (cd == 255u) ? (int)0x80000000 : f2key(__uint_as_float((__float_as_uint(sum) & ~255u) | cd)); }
            int resi = 0;
#pragma unroll 1
            for (int it = 0; it < 16; ++it) {
                const int m = imax16(max(max(cand[0], cand[1]), max(cand[2], cand[3])));
#pragma unroll
                for (int i = 0; i < 4; ++i) cand[i] = (cand[i] == m) ? (int)0x80000000 : cand[i];
                resi = (jj == it) ? m : resi;
            }
            const float res = key2f(resi);
            const unsigned code = __float_as_uint(res) & 255u; const int p0 = code >> 4, p1 = code & 15;
            const int i0 = 127 - (int)(__float_as_uint(k0) & 127u), i1 = 127 - (int)(__float_as_uint(k1own) & 127u);
            const int gi0 = __shfl(i0, (lane & 48) + p0), gi1 = __shfl(i1, (lane & 48) + p1);
            const float mx = max16(res); const float ex = __expf((res - mx) * rs2); const float sm = sum16(ex);
            const int e = gi0 * 128 + gi1;
            wl_e[h * 16 + jj] = e; wl_g[h * 16 + jj] = ex / sm; wl_us[h * 16 + jj] = uinv[e]; wl_vs[h * 16 + jj] = vinv[e];
        }
        f32x2v tok[8];
#pragma unroll
        for (int i = 0; i < 4; ++i) { const f32x4 t4 = ld4bf(x1b + (size_t)n * 1024 + i * 256 + lane * 4) * rs2 * ((const f32x4*)g2)[lane + 64 * i]; tok[2 * i] = (f32x2v){t4[0], t4[1]}; tok[2 * i + 1] = (f32x2v){t4[2], t4[3]}; }
        float act0 = 0.f, act1 = 0.f;
        const int jl = (lane & 7) * 8 + (lane >> 3);
        {
            u32x4 ra[2][8]; float rj[8];
#define U_LOAD(bufi, bb) do { _Pragma("unroll") for (int q = 0; q < 8; ++q) { const int e = __builtin_amdgcn_readfirstlane(wl_e[(bb) * 8 + q]); ra[bufi][q] = *(const u32x4*)(U8 + (size_t)(e & EMASK) * 1024 + lane * 16); } } while (0)
            U_LOAD(0, 0);
#pragma unroll
            for (int bb = 0; bb < 16; ++bb) {
                if (bb + 1 < 16) U_LOAD((bb + 1) & 1, bb + 1);
                asm volatile("" ::: "memory");
                float d[8];
#pragma unroll
                for (int q = 0; q < 8; ++q) d[q] = dot16f8(ra[bb & 1][q], tok);
#pragma unroll
                for (int off = 4; off >= 1; off >>= 1) {
                    const bool up = (lane & (off * 8)) != 0;
#pragma unroll
                    for (int i = 0; i < off; ++i) { const float x = d[i], y = d[i + off]; const float send = up ? x : y, keep = up ? y : x; d[i] = keep + __shfl_xor(send, off * 8); }
                }
                rj[bb & 7] = d[0];
                if ((bb & 7) == 7) {
#pragma unroll
                    for (int off = 4; off >= 1; off >>= 1) {
                        const bool up = (lane & off) != 0;
#pragma unroll
                        for (int i = 0; i < off; ++i) { const float x = rj[i], y = rj[i + off]; const float send = up ? x : y, keep = up ? y : x; rj[i] = keep + __shfl_xor(send, off); }
                    }
                    const int grp = bb >> 3;
                    const float tot = rj[0] * wl_us[grp * 64 + jl];
                    const float a = 0.5f * tot * (1.f + erff(tot * 0.70710678118f)) * wl_g[grp * 64 + jl] * wl_vs[grp * 64 + jl];
                    if (grp == 0) act0 = a; else act1 = a;
                }
            }
#undef U_LOAD
        }
        ACT[(size_t)n * 128 + lane] = act0; ACT[(size_t)n * 128 + 64 + lane] = act1;
        EID[(size_t)n * 128 + lane] = wl_e[lane]; EID[(size_t)n * 128 + 64 + lane] = wl_e[64 + lane];
    }
}

#ifndef V2_NRB
#define V2_NRB 3
#endif
__device__ __forceinline__ void phase_peer_v2(const Params& p, unsigned char* smem_) {
    constexpr int NRB = V2_NRB, NR = 1 << NRB, NB = NR * 8, BPL = NB >= 64 ? NB / 64 : 1, ESH = 14 - NRB;
    const int tid = tid_opaque(), lane = tid & 63, wv = tid >> 6;
    unsigned long long* SP = (unsigned long long*)(smem_ + wv * (8192 + 12 * NB));
    int* cnt = (int*)(SP + 1024);
    const unsigned char* V8 = p.ws + OFF_V8; const float* ACT = (const float*)(p.ws + OFF_ACT); const int* EID = (const int*)(p.ws + OFF_EID);
    const float* fg = p.in[30]; float* out = p.out; const bf16_t* x1b = (const bf16_t*)(p.ws + OFF_X1B);
    const int gw = blockIdx.x * 8 + wv, nw = gridDim.x * 8;
    for (int g0 = gw; g0 < NTOK; g0 += 8 * nw) {
#pragma unroll
        for (int i = 0; i < BPL; ++i) if (lane + 64 * i < NB) cnt[lane + 64 * i] = 0;
        int ev[16]; float av[16];
#pragma unroll
        for (int i = 0; i < 16; ++i) { const int t = i >> 1, j = (i & 1) * 64 + lane, n = g0 + t * nw;
            const bool ok = n < NTOK;
            ev[i] = ok ? EID[(size_t)n * 128 + j] : 0;
            av[i] = ok ? ACT[(size_t)n * 128 + (j & 64) + (((j & 7) << 3) | ((j >> 3) & 7))] : 0.f; }
#pragma unroll
        for (int i = 0; i < 16; ++i) atomicAdd(&cnt[(ev[i] >> ESH) * 8 + (i >> 1)], 1);
        {
          int c[BPL]; int sc = 0;
#pragma unroll
          for (int i = 0; i < BPL; ++i) { c[i] = (BPL * lane + i < NB) ? cnt[BPL * lane + i] : 0; sc += c[i]; }
          const int tot = sc;
#pragma unroll
          for (int o = 1; o < 64; o <<= 1) { const int tt = __shfl_up(sc, o); if (lane >= o) sc += tt; }
          int ex = sc - tot;
#pragma unroll
          for (int i = 0; i < BPL; ++i) { if (BPL * lane + i < NB) { cnt[NB + BPL * lane + i] = ex; cnt[2 * NB + BPL * lane + i] = ex; } ex += c[i]; } }
#pragma unroll
        for (int i = 0; i < 16; ++i) { const int pos = atomicAdd(&cnt[2 * NB + (ev[i] >> ESH) * 8 + (i >> 1)], 1);
            SP[pos] = ((unsigned long long)(unsigned)ev[i] << 32) | (unsigned long long)__float_as_uint(av[i]); }
        f32x2v ac[8][8];
#pragma unroll
        for (int t = 0; t < 8; ++t)
#pragma unroll
            for (int k = 0; k < 8; ++k) ac[t][k] = (f32x2v){0.f, 0.f};
#pragma unroll 1
        for (int r = 0; r < NR; ++r) {
#pragma unroll
            for (int t = 0; t < 8; ++t) {
                const int beg = __builtin_amdgcn_readfirstlane(cnt[NB + r * 8 + t]), end = beg + __builtin_amdgcn_readfirstlane(cnt[r * 8 + t]);
#pragma unroll 1
                for (int b0 = beg; b0 < end; b0 += 8) {
                    u32x4 ra[8]; float aq[8];
#pragma unroll
                    for (int q = 0; q < 8; ++q) { ra[q] = (u32x4){0u, 0u, 0u, 0u}; aq[q] = 0.f;
                        if (b0 + q < end) { const unsigned long long pr = SP[b0 + q];
                            const unsigned e = (unsigned)__builtin_amdgcn_readfirstlane((int)(pr >> 32)); aq[q] = __uint_as_float((unsigned)__builtin_amdgcn_readfirstlane((int)(unsigned)pr));
                            ra[q] = *(const u32x4*)(V8 + (size_t)e * 1024 + lane * 16); } }
#pragma unroll
                    for (int q = 0; q < 8; ++q) {
                        if (b0 + q < end) {
                            const f32x2v a2 = (f32x2v){aq[q], aq[q]};
                            ac[t][0] = fma2(F8LO(ra[q].x), a2, ac[t][0]); ac[t][1] = fma2(F8HI(ra[q].x), a2, ac[t][1]); ac[t][2] = fma2(F8LO(ra[q].y), a2, ac[t][2]); ac[t][3] = fma2(F8HI(ra[q].y), a2, ac[t][3]);
                            ac[t][4] = fma2(F8LO(ra[q].z), a2, ac[t][4]); ac[t][5] = fma2(F8HI(ra[q].z), a2, ac[t][5]); ac[t][6] = fma2(F8LO(ra[q].w), a2, ac[t][6]); ac[t][7] = fma2(F8HI(ra[q].w), a2, ac[t][7]);
                        } }
                }
            }
        }
#pragma unroll
        for (int t = 0; t < 8; ++t) { const int n = g0 + t * nw;
            if (n < NTOK) {
                f32x4 acc[4]; float ss = 0.f;
#pragma unroll
                for (int i = 0; i < 4; ++i) { acc[i] = (f32x4){ac[t][2 * i].x, ac[t][2 * i].y, ac[t][2 * i + 1].x, ac[t][2 * i + 1].y} + ld4bf(x1b + (size_t)n * 1024 + i * 256 + lane * 4);
                    ss += (acc[i][0] * acc[i][0] + acc[i][1] * acc[i][1]) + (acc[i][2] * acc[i][2] + acc[i][3] * acc[i][3]); }
                ss = wave_sum(ss); const float rs = __builtin_amdgcn_rsqf(ss * (1.f / 1024.f) + 1e-6f);
#pragma unroll
                for (int i = 0; i < 4; ++i) ((f32x4*)(out + (size_t)n * 1024))[lane + 64 * i] = acc[i] * rs * ((const f32x4*)fg)[lane + 64 * i];
            } }
    }
}

#define XB_TMO      128
#define XB_XCNT(j)  (256  + 64 * (j))
#define XB_XSUB(j)  (1280 + 64 * (j))
#define XB_XGEN(j)  (2304 + 64 * (j))
#define XB_TOP      3328
#define XB_TOPGEN   3392
#define XCD_BAR_WORDS 3456
#define XB_SPIN_CAP (1u << 18)

__device__ __forceinline__ unsigned xb_ld(unsigned* p)              { return __hip_atomic_load(p, __ATOMIC_RELAXED, __HIP_MEMORY_SCOPE_AGENT); }
__device__ __forceinline__ unsigned xb_add(unsigned* p, unsigned v) { return __hip_atomic_fetch_add(p, v, __ATOMIC_RELAXED, __HIP_MEMORY_SCOPE_AGENT); }
__device__ __forceinline__ unsigned xb_xcc_id() { return (unsigned)__builtin_amdgcn_s_getreg((3 << 11) | 20) & 0xFu; }
#define XB_SPIN(cond, bar) do { unsigned _sp = 0; while (cond) { __builtin_amdgcn_s_sleep(1); \
    if ((++_sp & 255u) == 0u) { if (xb_ld(&(bar)[XB_TMO])) break; if (_sp > XB_SPIN_CAP) { atomicAdd(&(bar)[XB_TMO], 1u); break; } } } } while (0)

struct XcdBarrier {
    unsigned* bar; unsigned x;
    volatile LAS unsigned* st;
};

__device__ __forceinline__ XcdBarrier xcd_barrier_post(unsigned* bar, volatile LAS unsigned* st) {
    XcdBarrier b; b.bar = bar; b.x = xb_xcc_id(); b.st = st;
    if (threadIdx.x == 0) (void)xb_add(&bar[XB_XCNT(b.x)], 1u);
    return b;
}
__device__ __forceinline__ void xcd_barrier_complete(unsigned* bar, unsigned x, unsigned& nloc, unsigned& nx) {
    const unsigned G = gridDim.x * gridDim.y * gridDim.z;
    unsigned sum, cnt, mine, sp = 0u;
    for (;;) {
        sum = 0u; cnt = 0u; mine = 0u;
#pragma unroll
        for (unsigned j = 0; j < 16; ++j) { const unsigned c = xb_ld(&bar[XB_XCNT(j)]); sum += c; cnt += (c > 0u) ? 1u : 0u; mine = (j == x) ? c : mine; }
        if (sum == G) break;
        __builtin_amdgcn_s_sleep(1);
        if ((++sp & 255u) == 0u) { if (xb_ld(&bar[XB_TMO])) break; if (sp > XB_SPIN_CAP) { atomicAdd(&bar[XB_TMO], 1u); break; } }
    }
    nloc = mine > 0u ? mine : 1u; nx = cnt > 0u ? cnt : 1u;
}

__device__ __forceinline__ void xcd_barrier(const XcdBarrier& b) {
    asm volatile("s_waitcnt vmcnt(0)" ::: "memory");
    __syncthreads();
    if (threadIdx.x == 0) {
        unsigned* bar = b.bar;
        __builtin_amdgcn_s_waitcnt(0);
        unsigned nloc = b.st[0], nx = b.st[1];
        if (nloc == 0u) { xcd_barrier_complete(bar, b.x, nloc, nx); b.st[0] = nloc; b.st[1] = nx; }
        const unsigned old = xb_add(&bar[XB_XSUB(b.x)], 1u);
        const unsigned gen = old / nloc;
        if (old + 1u == (gen + 1u) * nloc) {
            __builtin_amdgcn_fence(__ATOMIC_RELEASE, "agent");
            asm volatile("s_waitcnt vmcnt(0)" ::: "memory");
            const unsigned og = xb_add(&bar[XB_TOP], 1u);
            const unsigned tg = og / nx;
            if (og + 1u == (tg + 1u) * nx) xb_add(&bar[XB_TOPGEN], 1u);
            else XB_SPIN(xb_ld(&bar[XB_TOPGEN]) == tg, bar);
            __builtin_amdgcn_fence(__ATOMIC_ACQUIRE, "agent");
            xb_add(&bar[XB_XGEN(b.x)], 1u);
            asm volatile("s_waitcnt vmcnt(0)" ::: "memory");
        } else {
            XB_SPIN(xb_ld(&bar[XB_XGEN(b.x)]) == gen, bar);
            __builtin_amdgcn_fence(__ATOMIC_ACQUIRE, "agent");
            asm volatile("s_waitcnt vmcnt(0)" ::: "memory");
        }
    }
    __syncthreads();
}


__device__ __forceinline__ float fp6_mag(int k) { return k < 16 ? 0.125f * (float)k : (k < 24 ? 2.f + 0.25f * (float)(k - 16) : 4.f + 0.5f * (float)(k - 24)); }
__device__ __forceinline__ int fp6_idx(float v) { return v < 2.f ? (int)(v * 8.f + 0.5f) : (v < 4.f ? 16 + (int)((v - 2.f) * 4.f + 0.5f) : 24 + (int)((v - 4.f) * 2.f + 0.5f)); }
__device__ __forceinline__ void phase_peer_v3(const Params& p, unsigned char* smem_) {
    const int tid = tid_opaque(), lane = tid & 63, wv = __builtin_amdgcn_readfirstlane(tid >> 6), hf = lane >> 5, sl = lane & 31;
    unsigned char* wbase = smem_ + wv * 13312;
    int* SPE = (int*)wbase; float* SPA = (float*)(wbase + 4096); float* OUT = (float*)(wbase + 8192); int* cnt = (int*)(wbase + 12288); int* PI = cnt + 192;
    const unsigned char* V6 = p.ws + OFF_V8; const float* ACT = (const float*)(p.ws + OFF_ACT); const int* EID = (const int*)(p.ws + OFF_EID);
    const float* fg = p.in[30]; float* out = p.out; const bf16_t* x1b = (const bf16_t*)(p.ws + OFF_X1B);
    { v16f c0, c1;
#pragma unroll
      for (int i = 0; i < 16; ++i) { c0[i] = fp6_mag(i); c1[i] = fp6_mag(16 + i); }
      const v6u pc = __builtin_amdgcn_cvt_scalef32_2xpk16_fp6_f32(c0, c1, 1.0f);
      const v32f yc = __builtin_amdgcn_cvt_scalef32_pk32_f32_fp6(pc, 1.0f);
#pragma unroll
      for (int j = 0; j < 32; ++j) if (lane == 0) PI[j] = fp6_idx(yc[j]) & 31; }
    const int gw = blockIdx.x * 8 + wv, nw = gridDim.x * 8;
    for (int g0 = gw; g0 < NTOK; g0 += 8 * nw) {
        cnt[lane] = 0;
        int ev[16]; float av[16];
#pragma unroll
        for (int i = 0; i < 16; ++i) { const int t = i >> 1, j = (i & 1) * 64 + lane, n = g0 + t * nw;
            const bool ok = n < NTOK;
            ev[i] = ok ? EID[(size_t)n * 128 + j] : 0;
            av[i] = ok ? ACT[(size_t)n * 128 + (j & 64) + (((j & 7) << 3) | ((j >> 3) & 7))] : 0.f; }
#pragma unroll
        for (int i = 0; i < 16; ++i) atomicAdd(&cnt[(ev[i] >> 11) * 8 + (i >> 1)], 1);
        { const int c = cnt[lane]; int sc = c;
#pragma unroll
          for (int o = 1; o < 64; o <<= 1) { const int tt = __shfl_up(sc, o); if (lane >= o) sc += tt; }
          cnt[64 + lane] = sc - c; cnt[128 + lane] = sc - c; }
#pragma unroll
        for (int i = 0; i < 16; ++i) { const int pos = atomicAdd(&cnt[128 + (ev[i] >> 11) * 8 + (i >> 1)], 1); SPE[pos] = ev[i]; SPA[pos] = av[i]; }
#pragma unroll 1
        for (int sw = 0; sw < 2; ++sw) {
            float ac[4][32];
#pragma unroll
            for (int t = 0; t < 4; ++t)
#pragma unroll
                for (int j = 0; j < 32; ++j) ac[t][j] = 0.f;
#pragma unroll 1
            for (int r = 0; r < 8; ++r) {
#pragma unroll
                for (int t = 0; t < 4; ++t) {
                    const int bk = r * 8 + sw * 4 + t;
                    const int beg = __builtin_amdgcn_readfirstlane(cnt[64 + bk]), end = beg + __builtin_amdgcn_readfirstlane(cnt[bk]);
#pragma unroll 1
                    for (int b0 = beg; b0 < end; b0 += 8) {
                        u32x2 ra[4][3]; float aq[4];
#pragma unroll
                        for (int k = 0; k < 4; ++k) { const int idx = b0 + 2 * k + hf; const bool ok = idx < end; const int ii = ok ? idx : beg;
                            const int e = SPE[ii]; aq[k] = ok ? SPA[ii] : 0.f;
                            const unsigned char* src = V6 + (size_t)e * 768 + sl * 24;
                            ra[k][0] = *(const u32x2*)src; ra[k][1] = *(const u32x2*)(src + 8); ra[k][2] = *(const u32x2*)(src + 16); }
#pragma unroll
                        for (int k = 0; k < 4; ++k) {
                            if (b0 + 2 * k < end) {
                                v6u pk; pk[0] = ra[k][0].x; pk[1] = ra[k][0].y; pk[2] = ra[k][1].x; pk[3] = ra[k][1].y; pk[4] = ra[k][2].x; pk[5] = ra[k][2].y;
                                const v32f y = __builtin_amdgcn_cvt_scalef32_pk32_f32_fp6(pk, 1.0f);
#pragma unroll
                                for (int j = 0; j < 32; ++j) ac[t][j] += aq[k] * y[j];
                            } }
                    }
                }
            }
#pragma unroll
            for (int t = 0; t < 4; ++t) { const int n = g0 + (sw * 4 + t) * nw;
#pragma unroll
                for (int j = 0; j < 32; ++j) { const float v = ac[t][j] + __shfl_xor(ac[t][j], 32); if (hf == 0) OUT[32 * sl + PI[j]] = v; }
                if (n < NTOK) {
                    f32x4 acc[4]; float ss = 0.f;
#pragma unroll
                    for (int i = 0; i < 4; ++i) { acc[i] = *(const f32x4*)(OUT + i * 256 + lane * 4) + ld4bf(x1b + (size_t)n * 1024 + i * 256 + lane * 4);
                        ss += (acc[i][0] * acc[i][0] + acc[i][1] * acc[i][1]) + (acc[i][2] * acc[i][2] + acc[i][3] * acc[i][3]); }
                    ss = wave_sum(ss); const float rs = __builtin_amdgcn_rsqf(ss * (1.f / 1024.f) + 1e-6f);
#pragma unroll
                    for (int i = 0; i < 4; ++i) ((f32x4*)(out + (size_t)n * 1024))[lane + 64 * i] = acc[i] * rs * ((const f32x4*)fg)[lane + 64 * i];
                } }
        }
    }
}

extern __shared__ __attribute__((aligned(16))) unsigned char smem[];
__global__ void __launch_bounds__(512, 2) mega_kernel(Params p) {
    cg::grid_group grid = cg::this_grid();
    float* lds = (float*)smem;
    PG8_LAS unsigned char* ldsa = (PG8_LAS unsigned char*)smem;
    unsigned char* ws = p.ws;
    const int G = gridDim.x;
    unsigned tacc = 0; unsigned long long klast = 0;
#define KSTAMP(k) do { if (STAMP_SEL >= 100) { const unsigned long long _t = __builtin_amdgcn_s_memrealtime(); if (STAMP_SEL == 100 + (k) || (STAMP_SEL == 999 && (k) != 99)) tacc += (unsigned)(_t - klast); klast = _t; } } while (0)
    KSTAMP(99);
    volatile LAS unsigned* xst = (volatile LAS unsigned*)((PG8_LAS unsigned char*)smem + 163840 - 16);
    if (threadIdx.x == 0) { xst[0] = 0u; xst[1] = 0u; }
    __syncthreads();
    const XcdBarrier xbar = xcd_barrier_post((unsigned*)(ws + OFF_BAR), xst);
#if PHMASK & 1
    phase0(p, lds);
    KSTAMP(21);
#endif
    xcd_barrier(xbar);
    KSTAMP(0);
#if PHMASK & 2
    { pg8::Gemm g{(const bf16_t*)(ws + OFF_XB), (const bf16_t*)(ws + OFF_WINT), NTOK, 5888, 1024}; pg8::StaticOrder S; S.init(NTOK, 5888, G, (int)blockIdx.x);
      EpiZ E{(bf16_t*)(ws + OFF_ZRW), (bf16_t*)(ws + OFF_ZML), (bf16_t*)(ws + OFF_ZG)};
      pg8::gemm_phase<EpiZ, pg8::StaticOrder>(ldsa, g, S, E, nullptr); }
#endif
    xcd_barrier(xbar);
    KSTAMP(1);
#if PHMASK & 4
    phase_rwkv_prep(p, smem, tacc);
#endif
    xcd_barrier(xbar);
    KSTAMP(2);
#if PHMASK & 8
    if (blockIdx.x < 32) phase_rwkv_scan4(p, smem, blockIdx.x);
#endif
#if PHMASK & 16
    if (blockIdx.x >= 32) phase_ml_cloc2(p, smem, blockIdx.x - 32, G - 32);
#endif
    if (p.cg_sync) grid.sync(); else xcd_barrier(xbar);
    KSTAMP(3);
#if PHMASK & 32
    phase_ml_scan(p);
    phase_rwkv_post(p);
#endif
    xcd_barrier(xbar);
    KSTAMP(4);
#if PHMASK & 64
    phase_ml_out2(p, smem);
#endif
    xcd_barrier(xbar);
    KSTAMP(5);
#if PHMASK & 128
    { MergeOrder S; S.init(NTOK, 1024, G, (int)blockIdx.x);
      pg8::Gemm g{(const bf16_t*)(ws + OFF_Y), (const bf16_t*)(ws + OFF_PRWT), NTOK, 1024, 512};
      EpiMerge E{EpiMerge1{(const bf16_t*)(ws + OFF_ZG), p.in[21], (bf16_t*)(ws + OFF_T)}, EpiMerge2{(const bf16_t*)(ws + OFF_ZG), p.in[21], (const bf16_t*)(ws + OFF_T), (bf16_t*)(ws + OFF_MERGED)}};
      if (G == 256) pg8::gemm_phase<EpiMerge, MergeOrder>(ldsa, g, S, E, nullptr);
      else { pg8::StaticOrder S1; S1.init(NTOK, 1024, G, (int)blockIdx.x);
        { pg8::gemm_phase<EpiMerge1, pg8::StaticOrder>(ldsa, g, S1, E.e1, nullptr); }
        { pg8::Gemm g2{(const bf16_t*)(ws + OFF_YML), (const bf16_t*)(ws + OFF_PMLT), NTOK, 1024, 512}; pg8::gemm_phase<EpiMerge2, pg8::StaticOrder>(ldsa, g2, S1, E.e2, nullptr); } } }
#endif
    xcd_barrier(xbar);
    KSTAMP(6);
#if PHMASK & 256
    { pg8::Gemm g{(const bf16_t*)(ws + OFF_MERGED), (const bf16_t*)(ws + OFF_WOUTT), NTOK, 1024, 1024}; pg8::StaticOrder S; S.init(NTOK, 1024, G, (int)blockIdx.x);
      EpiOut E{p.in[0], p.out, (bf16_t*)(ws + OFF_X1B), (float*)(ws + OFF_SS2P)};
      pg8::gemm_phase<EpiOut, pg8::StaticOrder>(ldsa, g, S, E, nullptr); }
#endif
    xcd_barrier(xbar);
    KSTAMP(7);
#if PHMASK & 512
    { pg8::Gemm g{(const bf16_t*)(ws + OFF_X1B), (const bf16_t*)(ws + OFF_WQT), NTOK, 2048, 1024}; pg8::StaticOrder S; S.init(NTOK, 2048, G, (int)blockIdx.x);
      EpiQ E{(bf16_t*)(ws + OFF_Q)};
      pg8::gemm_phase<EpiQ, pg8::StaticOrder>(ldsa, g, S, E, nullptr); }
#endif
    xcd_barrier(xbar);
    KSTAMP(8);
#if PHMASK & 1024
    phase_peer_keys(p, smem);
#endif
    xcd_barrier(xbar);
    KSTAMP(9);
#if PHMASK & 2048
#ifdef PROBE_L2
    phase_peer_u<PROBE_L2, 1>(p, lds);
    xcd_barrier(xbar);
    KSTAMP(12);
#endif
    phase_peer_u<16383, 0>(p, lds);
    xcd_barrier(xbar);
    KSTAMP(11);
    phase_peer_v3(p, smem);
#endif
    KSTAMP(10);
#if STAMP_SEL
    if (blockIdx.x == 0 && threadIdx.x < 64) { const unsigned long long t0 = __builtin_amdgcn_s_memrealtime(); const unsigned long long want = (unsigned long long)__builtin_amdgcn_readfirstlane(tacc) * (STAMP_SEL == 999 ? 1ull : 10ull); while (__builtin_amdgcn_s_memrealtime() - t0 < want) __builtin_amdgcn_s_sleep(8); }
#endif
}

extern "C" void kernel_launch(void* const* d_in, const int* in_sizes, int n_in, void* d_out, int out_size, void* d_ws, size_t ws_size, hipStream_t stream) {
    constexpr size_t kDynLds = 163840;
    static int grid_blocks = 0;
    if (!grid_blocks) {
        int dev = 0, cus = 0, per_cu = 0;
        (void)hipGetDevice(&dev);
        (void)hipDeviceGetAttribute(&cus, hipDeviceAttributeMultiprocessorCount, dev);
        (void)hipFuncSetAttribute((const void*)mega_kernel, hipFuncAttributeMaxDynamicSharedMemorySize, (int)kDynLds);
        (void)hipOccupancyMaxActiveBlocksPerMultiprocessor(&per_cu, mega_kernel, 512, kDynLds);
        if (per_cu < 1) { fprintf(stderr, "occupancy query says %d blocks per CU\n", per_cu); per_cu = 1; }
        if (per_cu > 1) per_cu = 1;
        grid_blocks = cus * per_cu;
        if (ws_size < 256 * MiB) fprintf(stderr, "workspace too small: %zu\n", ws_size);
    }
    (void)hipMemsetAsync((unsigned char*)d_ws + OFF_BAR, 0, XCD_BAR_WORDS * 4, stream);
    Params p{};
    for (int i = 0; i < 31; ++i) p.in[i] = (const float*)d_in[i];
    p.out = (float*)d_out; p.ws = (unsigned char*)d_ws; p.cg_sync = 0; p.pad = 0;
    void* args[] = {&p};
    hipError_t e = hipLaunchCooperativeKernel((void*)mega_kernel, dim3(grid_blocks), dim3(512), args, kDynLds, stream);
    if (e != hipSuccess) fprintf(stderr, "cooperative launch failed: %s (grid %d)\n", hipGetErrorString(e), grid_blocks);
}
```

```cpp
#include <hip/hip_runtime.h>
#include <hip/hip_cooperative_groups.h>
#include <cstdio>
namespace cg = cooperative_groups;
#define DUPMASK 0
namespace pg8 {
#define PG8_LAS __attribute__((address_space(3)))
typedef unsigned short bf16_t;
typedef short bf16x8 __attribute__((ext_vector_type(8)));
typedef float f32x4 __attribute__((ext_vector_type(4)));
typedef unsigned u32x4 __attribute__((ext_vector_type(4)));
constexpr int BM = 256, BK = 64, HALF = 128, HTB = HALF * BK * 2  , STAGE_BYTES = 8 * HTB, NXCD = 8, WGM = 8;

__host__ __device__ __forceinline__ int lds_byte(int r, int c) { const int st = (r >> 4) * 2 + (c >> 5), rr = r & 15, cc = c & 31, ob = rr * 64 + cc * 2; return st * 1024 + (ob ^ (((ob >> 9) & 1) << 5)); }
__host__ __device__ __forceinline__ void stage_rc(int b, int& R, int& C) { const int st = b / 1024, sb = b % 1024, swz = sb ^ (((sb >> 9) & 1) << 5); R = (st >> 1) * 16 + swz / 64; C = (st & 1) * 32 + (swz % 64) / 2; }
__host__ __device__ __forceinline__ int perm32(int rho) { const int n = rho >> 4, i = rho & 15; return 8 * (i >> 2) + 4 * n + (i & 3); }

struct Unit { int pm, pn; };
struct Gemm { const bf16_t* A; const bf16_t* Bt; int M, N, K; };

struct StaticOrder {
    int nM, nN, nwg, G, c;
    __host__ __device__ void init(int M, int N, int G_, int c_) { nM = M / BM; nN = N / BM; nwg = nM * nN; G = G_; c = c_; }
    __host__ __device__ bool next(int i, Unit& u) const {
        const long L = (long)i * G + c; if (L >= nwg) return false;
        int wgid = (int)L; { const int q = nwg / NXCD, r = nwg % NXCD, xcd = wgid % NXCD, off = wgid / NXCD; wgid = (xcd < r ? xcd * (q + 1) : r * (q + 1) + (xcd - r) * q) + off; }
        const int nig = WGM * nN, gid = wgid / nig, fm = gid * WGM, gsz = (nM - fm) < WGM ? (nM - fm) : WGM;
        u.pm = fm + ((wgid % nig) % gsz); u.pn = (wgid % nig) / gsz; return true;
    }
    __device__ __forceinline__ void a_ready(const Unit&) const {}
    __device__ __forceinline__ void done(const Unit&) const {}
};
__device__ __forceinline__ unsigned cvt_pk_bf16(float lo, float hi) { unsigned r; asm volatile("v_cvt_pk_bf16_f32 %0, %1, %2" : "=v"(r) : "v"(lo), "v"(hi)); return r; }
typedef float f32x2 __attribute__((ext_vector_type(2)));
template <class Epi, class Sched, bool STAMP = false>
__device__ __forceinline__ void gemm_phase(PG8_LAS unsigned char* lds, const Gemm g, const Sched& S, const Epi& E, unsigned long long* stamps) {
    int tid = threadIdx.x; asm volatile("" : "+v"(tid)); const int wid = __builtin_amdgcn_readfirstlane(tid >> 6), lane = tid & 63, wr = wid >> 2, wc = wid & 3, fr = lane & 15, fq = lane >> 4;
    const int K = g.K, nt = K / BK;
    int ts_lo = 0, ts_hi = 0, nts = 0; const unsigned long long rt_entry = STAMP ? (unsigned long long)wall_clock64() : 0ull;
#define PG8_STAMP() do { if (STAMP && wid == 0 && nts < 64) { const unsigned long long _c = (unsigned long long)clock64(); \
        ts_lo = (lane == nts) ? (int)(unsigned)_c : ts_lo; ts_hi = (lane == nts) ? (int)(unsigned)(_c >> 32) : ts_hi; ++nts; } } while (0)
    PG8_STAMP();
    unsigned voffA[2], voffB[2];
#pragma unroll
    for (int i = 0; i < 2; ++i) { int R, C; stage_rc(tid * 16 + i * 8192, R, C); const int Rb = Epi::PERM ? ((R & ~31) + perm32(R & 31)) : R;
        voffA[i] = (unsigned)(R * K + C) * 2u; voffB[i] = (unsigned)(Rb * K + C) * 2u; }
    const size_t kstep = (size_t)(BK * 2);
    const size_t hstep = (size_t)HALF * K * 2;
    const size_t tstep = 2 * hstep;
    const unsigned ldsw = (unsigned)wid * 1024u;
    const int aoff = lds_byte(wr * 64 + fr, fq * 8), boff = lds_byte(wc * 32 + fr, fq * 8);
#define PG8_SA(b, h) (((b) * 2 + (h)) * HTB)
#define PG8_SB(b, h) ((4 + (b) * 2 + (h)) * HTB)
#define PG8_STAGE(bufoff, gbase, voff) do { _Pragma("unroll") for (int _i = 0; _i < 2; ++_i) \
        __builtin_amdgcn_global_load_lds((const unsigned*)((const char*)(gbase) + (voff)[_i]), (PG8_LAS unsigned*)(lds + (bufoff) + ldsw + _i * 8192), 16, 0, 0); } while (0)
#define PG8_LDA(dst, b, h) do { _Pragma("unroll") for (int m = 0; m < 4; ++m) _Pragma("unroll") for (int k = 0; k < 2; ++k) dst[m][k] = *(const PG8_LAS bf16x8*)(lds + PG8_SA(b, h) + aoff + m * 2048 + k * 1024); } while (0)
#define PG8_LDB(dst, b, h) do { _Pragma("unroll") for (int n = 0; n < 2; ++n) _Pragma("unroll") for (int k = 0; k < 2; ++k) dst[n][k] = *(const PG8_LAS bf16x8*)(lds + PG8_SB(b, h) + boff + n * 2048 + k * 1024); } while (0)
#define PG8_MMA(ai, bj, At, Bt) do { __builtin_amdgcn_s_setprio(1); _Pragma("unroll") for (int m = 0; m < 4; ++m) _Pragma("unroll") for (int n = 0; n < 2; ++n) _Pragma("unroll") for (int k = 0; k < 2; ++k) \
        acc[ai][bj][m][n] = __builtin_amdgcn_mfma_f32_16x16x32_bf16(Bt[n][k], At[m][k], acc[ai][bj][m][n], 0, 0, 0); __builtin_amdgcn_s_setprio(0); } while (0)
#define PG8_WAIT_V(n) asm volatile("s_waitcnt vmcnt(" #n ")" ::: "memory")
#define PG8_WAIT_L(n) asm volatile("s_waitcnt lgkmcnt(" #n ")" ::: "memory")
#define PG8_BAR __builtin_amdgcn_s_barrier()
#define PG8_SCHED __builtin_amdgcn_sched_barrier(0)
    Unit cur, nxt; int ui = 0;
    if (!S.next(0, cur)) return;
    f32x4 acc[2][2][4][2];
#pragma unroll
    for (int a = 0; a < 2; ++a)
#pragma unroll
        for (int b = 0; b < 2; ++b)
#pragma unroll
            for (int m = 0; m < 4; ++m)
#pragma unroll
                for (int n = 0; n < 2; ++n) acc[a][b][m][n] = (f32x4){0.f, 0.f, 0.f, 0.f};
    bf16x8 At[4][2], B0[2][2], B1[2][2];
    const char* cA = (const char*)g.A + (size_t)cur.pm * tstep; const char* cB = (const char*)g.Bt + (size_t)cur.pn * tstep;
    S.a_ready(cur);
    PG8_STAGE(PG8_SB(0, 0), cB, voffB); PG8_STAGE(PG8_SA(0, 0), cA, voffA); PG8_STAGE(PG8_SB(0, 1), cB + hstep, voffB); PG8_STAGE(PG8_SA(0, 1), cA + hstep, voffA);
    if (wr == 1) PG8_BAR;
    PG8_WAIT_V(4); PG8_BAR;
    PG8_STAGE(PG8_SB(1, 0), cB + kstep, voffB); PG8_STAGE(PG8_SA(1, 0), cA + kstep, voffA); PG8_STAGE(PG8_SB(1, 1), cB + hstep + kstep, voffB);
    PG8_WAIT_V(6); PG8_BAR;
    PG8_STAMP();
    for (;;) {
        const bool has_next = S.next(ui + 1, nxt);
        const char* nA = has_next ? (const char*)g.A + (size_t)nxt.pm * tstep : cA; const char* nB = has_next ? (const char*)g.Bt + (size_t)nxt.pn * tstep : cB;
        for (int t = 0; t < nt; t += 2) {
            const bool last = (t == nt - 2);
            const char* a1 = cA + (size_t)(t + 1) * kstep;
            const char* a2 = last ? nA : cA + (size_t)(t + 2) * kstep; const char* b2 = last ? nB : cB + (size_t)(t + 2) * kstep;
            const char* a3 = a2 + kstep; const char* b3 = b2 + kstep;
            if (last && has_next) S.a_ready(nxt);
            PG8_LDB(B0, 0, 0); PG8_SCHED; PG8_LDA(At, 0, 0); PG8_STAGE(PG8_SA(1, 1), a1 + hstep, voffA);
            PG8_WAIT_L(8); PG8_BAR; PG8_WAIT_L(0); PG8_MMA(0, 0, At, B0); PG8_BAR; PG8_SCHED;
            PG8_LDB(B1, 0, 1); PG8_STAGE(PG8_SB(0, 0), b2, voffB);
            PG8_BAR; PG8_WAIT_L(0); PG8_MMA(0, 1, At, B1); PG8_BAR;
            PG8_LDA(At, 0, 1); PG8_STAGE(PG8_SA(0, 0), a2, voffA);
            PG8_BAR; PG8_WAIT_L(0); PG8_MMA(1, 0, At, B0); PG8_BAR; PG8_SCHED;
            PG8_STAGE(PG8_SB(0, 1), b2 + hstep, voffB);
            PG8_WAIT_V(6); PG8_BAR; PG8_MMA(1, 1, At, B1); PG8_BAR;
            PG8_LDB(B0, 1, 0); PG8_SCHED; PG8_LDA(At, 1, 0); PG8_STAGE(PG8_SA(0, 1), a2 + hstep, voffA);
            PG8_WAIT_L(8); PG8_BAR; PG8_WAIT_L(0); PG8_MMA(0, 0, At, B0); PG8_BAR; PG8_SCHED;
            PG8_LDB(B1, 1, 1); PG8_STAGE(PG8_SB(1, 0), b3, voffB);
            PG8_BAR; PG8_WAIT_L(0); PG8_MMA(0, 1, At, B1); PG8_BAR;
            PG8_LDA(At, 1, 1); PG8_STAGE(PG8_SA(1, 0), a3, voffA);
            PG8_BAR; PG8_WAIT_L(0); PG8_MMA(1, 0, At, B0); PG8_BAR; PG8_SCHED;
            PG8_STAGE(PG8_SB(1, 1), b3 + hstep, voffB);
            PG8_WAIT_V(6); PG8_BAR; PG8_MMA(1, 1, At, B1); PG8_BAR;
        }
        PG8_STAMP();
        if constexpr (!Epi::AFTER_DRAIN) { E(acc, cur, wr, wc, fr, fq); S.done(cur); }
        PG8_STAMP();
        if (!has_next) break;
#pragma unroll
        for (int a = 0; a < 2; ++a)
#pragma unroll
            for (int b = 0; b < 2; ++b)
#pragma unroll
                for (int m = 0; m < 4; ++m)
#pragma unroll
                    for (int n = 0; n < 2; ++n) acc[a][b][m][n] = (f32x4){0.f, 0.f, 0.f, 0.f};
        cur = nxt; cA = nA; cB = nB; ++ui;
    }
    PG8_WAIT_V(0);
    if (wr == 0) PG8_BAR;
    PG8_BAR;
    if constexpr (Epi::AFTER_DRAIN) { E.fused(acc, cur, wr, wc, fr, fq, lds, wid, lane); S.done(cur); }
    PG8_STAMP();
    if (STAMP && wid == 0) { stamps[lane] = lane < nts ? (((unsigned long long)(unsigned)ts_hi << 32) | (unsigned)ts_lo) : 0ull;
        if (lane == 62) stamps[62] = rt_entry; if (lane == 63) stamps[63] = (unsigned long long)wall_clock64(); }
#undef PG8_STAMP
#undef PG8_SA
#undef PG8_SB
#undef PG8_STAGE
#undef PG8_LDA
#undef PG8_LDB
#undef PG8_MMA
#undef PG8_WAIT_V
#undef PG8_WAIT_L
#undef PG8_BAR
#undef PG8_SCHED
}
}
#ifndef PHMASK
#define PHMASK 4095
#endif
#ifndef DUPMASK
#define DUPMASK 0
#endif

using pg8::bf16_t; using pg8::bf16x8; using pg8::f32x4; using pg8::u32x4;
#define LAS __attribute__((address_space(3)))
typedef unsigned u32x2 __attribute__((ext_vector_type(2)));
typedef float v16f __attribute__((ext_vector_type(16)));
typedef float v32f __attribute__((ext_vector_type(32)));
typedef unsigned v6u __attribute__((ext_vector_type(6)));

constexpr int NTOK = 16384, DM = 1024, SEQ = 4096;
constexpr size_t MiB = 1ull << 20;
constexpr size_t OFF_RSTD1 = 0, OFF_IFG = 64 * 1024, OFF_SS2 = 576 * 1024, OFF_BONUS = 640 * 1024, OFF_NLOC = 1152 * 1024, OFF_GEND = 1664 * 1024;
constexpr size_t OFF_WINT = 2 * MiB, OFF_PRWT = OFF_WINT + 5888ull * 1024 * 2, OFF_PMLT = OFF_PRWT + MiB, OFF_WOUTT = OFF_PMLT + MiB, OFF_WQT = OFF_WOUTT + 2 * MiB, OFF_SKT = OFF_WQT + 4 * MiB;
static_assert(OFF_SKT + MiB / 2 == 22 * MiB, "weights map");
constexpr size_t OFF_ZRW = 22 * MiB, OFF_ZML = 78 * MiB, OFF_ZG = 142 * MiB, OFF_XB = 206 * MiB;
constexpr size_t OFF_V = 206 * MiB, OFF_G = 222 * MiB;
constexpr size_t OFF_BAR = 1960 * 1024;
constexpr size_t OFF_WUPT = 1700 * 1024, OFF_AUPT = 1764 * 1024, OFF_GUPT = 1828 * 1024;
constexpr size_t OFF_CLOC = 22 * MiB, OFF_Y = 54 * MiB;
constexpr size_t OFF_YML = 206 * MiB, OFF_T = 78 * MiB, OFF_MERGED = 222 * MiB, OFF_X1B = 22 * MiB, OFF_Q = 142 * MiB, OFF_KEYS = 206 * MiB, OFF_U8 = 78 * MiB, OFF_V8 = 94 * MiB, OFF_UINV = 110 * MiB, OFF_SS2P = 111 * MiB, OFF_ACT = 142 * MiB, OFF_EID = 150 * MiB, OFF_ACTIN = 238 * MiB;

struct Params {
    const float* in[31];
    float* out;
    unsigned char* ws;
    int cg_sync;
    int pad;
};

__device__ __forceinline__ int tid_opaque() { int t = threadIdx.x; asm volatile("" : "+v"(t)); return t; }
__device__ __forceinline__ float bf2f(bf16_t v) { return __uint_as_float(((unsigned)v) << 16); }
typedef __bf16 hwbf2 __attribute__((ext_vector_type(2)));
typedef float hwf2 __attribute__((ext_vector_type(2)));
__device__ __forceinline__ unsigned pk2(float lo, float hi) { hwf2 v = {lo, hi}; return __builtin_bit_cast(unsigned, __builtin_convertvector(v, hwbf2)); }
__device__ __forceinline__ unsigned f2bf(float f) { return pk2(f, 0.f) & 0xffffu; }
__device__ __forceinline__ float wave_sum(float v) {
#pragma unroll
    for (int o = 1; o < 64; o <<= 1) v += __shfl_xor(v, o);
    return v;
}
template <int CTRL> __device__ __forceinline__ float dpp_mov(float v) {
    return __builtin_bit_cast(float, __builtin_amdgcn_update_dpp(0, __builtin_bit_cast(int, v), CTRL, 0xf, 0xf, true));
}
__device__ __forceinline__ float sum8(float v) { v += dpp_mov<0xB1>(v); v += dpp_mov<0x4E>(v); v += dpp_mov<0x141>(v); return v; }
__device__ __forceinline__ float sum16(float v) { v = sum8(v); v += dpp_mov<0x140>(v); return v; }
__device__ __forceinline__ float max16(float v) { v = fmaxf(v, dpp_mov<0xB1>(v)); v = fmaxf(v, dpp_mov<0x4E>(v)); v = fmaxf(v, dpp_mov<0x141>(v)); v = fmaxf(v, dpp_mov<0x140>(v)); return v; }
__device__ __forceinline__ int imax16(int v) { v = max(v, __builtin_amdgcn_update_dpp(0, v, 0xB1, 0xf, 0xf, true)); v = max(v, __builtin_amdgcn_update_dpp(0, v, 0x4E, 0xf, 0xf, true)); v = max(v, __builtin_amdgcn_update_dpp(0, v, 0x141, 0xf, 0xf, true)); v = max(v, __builtin_amdgcn_update_dpp(0, v, 0x140, 0xf, 0xf, true)); return v; }
__device__ __forceinline__ int f2key(float f) { const int i = __float_as_int(f); return i ^ ((i >> 31) & 0x7fffffff); }
__device__ __forceinline__ float key2f(int i) { return __int_as_float(i ^ ((i >> 31) & 0x7fffffff)); }
__device__ __forceinline__ float sigmoidf_(float x) { return 1.f / (1.f + __expf(-x)); }
__device__ __forceinline__ float softplusf_(float x) { return fmaxf(x, 0.f) + log1pf(__expf(-fabsf(x))); }

#define BLO(x) __uint_as_float((x) << 16)
#define BHI(x) __uint_as_float((x) & 0xffff0000u)
struct EpiZ {
    static constexpr bool PERM = true, AFTER_DRAIN = false;
    bf16_t* zrw; bf16_t* zml; bf16_t* zg;
    __device__ __forceinline__ void operator()(const f32x4 (&acc)[2][2][4][2], const pg8::Unit& u, int wr, int wc, int fr, int fq) const {
        const int row0 = u.pm * 256 + wr * 64 + fr;
        bf16_t* base; int ldc, colt;
        if (u.pn < 7) { base = zrw; ldc = 1792; colt = u.pn * 256; }
        else if (u.pn < 15) { base = zml; ldc = 2048; colt = (u.pn - 7) * 256; }
        else { base = zg; ldc = 2048; colt = (u.pn - 15) * 256; }
        const int col0 = colt + wc * 32 + 8 * fq;
#pragma unroll
        for (int ai = 0; ai < 2; ++ai)
#pragma unroll
            for (int m = 0; m < 4; ++m) {
                const int row = row0 + ai * 128 + m * 16;
                bf16_t* rowp = base + (size_t)row * ldc + col0;
#pragma unroll
                for (int bj = 0; bj < 2; ++bj) {
                    const f32x4 v0 = acc[ai][bj][m][0], v1 = acc[ai][bj][m][1];
                    u32x4 w; w.x = pg8::cvt_pk_bf16(v0[0], v0[1]); w.y = pg8::cvt_pk_bf16(v0[2], v0[3]); w.z = pg8::cvt_pk_bf16(v1[0], v1[1]); w.w = pg8::cvt_pk_bf16(v1[2], v1[3]);
                    *(u32x4*)(rowp + bj * 128) = w;
                }
            }
    }
};
__device__ __forceinline__ f32x4 sig4(const u32x2 zr, const f32x4 b) {
    f32x4 g; g[0] = __builtin_amdgcn_rcpf(1.f + __expf(-(BLO(zr.x) + b[0]))); g[1] = __builtin_amdgcn_rcpf(1.f + __expf(-(BHI(zr.x) + b[1])));
    g[2] = __builtin_amdgcn_rcpf(1.f + __expf(-(BLO(zr.y) + b[2]))); g[3] = __builtin_amdgcn_rcpf(1.f + __expf(-(BHI(zr.y) + b[3]))); return g;
}
struct EpiMerge1 {
    static constexpr bool PERM = false, AFTER_DRAIN = false;
    const bf16_t* zg; const float* gb; bf16_t* T;
    __device__ __forceinline__ void operator()(const f32x4 (&acc)[2][2][4][2], const pg8::Unit& u, int wr, int wc, int fr, int fq) const {
        const int row0 = u.pm * 256 + wr * 64 + fr, col0 = u.pn * 256 + wc * 32 + 4 * fq;
        f32x4 bv[4];
#pragma unroll
        for (int c = 0; c < 4; ++c) bv[c] = *(const f32x4*)(gb + col0 + (c >> 1) * 128 + (c & 1) * 16);
        u32x2 zc[4], zn[4];
#pragma unroll
        for (int c = 0; c < 4; ++c) zc[c] = *(const u32x2*)(zg + (size_t)row0 * 2048 + col0 + (c >> 1) * 128 + (c & 1) * 16);
#pragma unroll
        for (int g = 0; g < 8; ++g) {
            const int ai = g >> 2, m = g & 3, row = row0 + ai * 128 + m * 16;
            if (g < 7) { const int rn = row0 + ((g + 1) >> 2) * 128 + ((g + 1) & 3) * 16;
#pragma unroll
                for (int c = 0; c < 4; ++c) zn[c] = *(const u32x2*)(zg + (size_t)rn * 2048 + col0 + (c >> 1) * 128 + (c & 1) * 16); }
#pragma unroll
            for (int c = 0; c < 4; ++c) { const f32x4 t = sig4(zc[c], bv[c]) * acc[ai][c >> 1][m][c & 1]; u32x2 w; w.x = pk2(t[0], t[1]); w.y = pk2(t[2], t[3]); *(u32x2*)(T + (size_t)row * 1024 + col0 + (c >> 1) * 128 + (c & 1) * 16) = w; }
#pragma unroll
            for (int c = 0; c < 4; ++c) zc[c] = zn[c];
        }
    }
};
struct EpiMerge2 {
    static constexpr bool PERM = false, AFTER_DRAIN = false;
    const bf16_t* zg; const float* gb; const bf16_t* T; bf16_t* merged;
    __device__ __forceinline__ void operator()(const f32x4 (&acc)[2][2][4][2], const pg8::Unit& u, int wr, int wc, int fr, int fq) const {
        const int row0 = u.pm * 256 + wr * 64 + fr, col0 = u.pn * 256 + wc * 32 + 4 * fq;
        f32x4 bv[4];
#pragma unroll
        for (int c = 0; c < 4; ++c) bv[c] = *(const f32x4*)(gb + 1024 + col0 + (c >> 1) * 128 + (c & 1) * 16);
        u32x2 zc[4], zn[4]; u32x2 tc[4], tn[4];
#pragma unroll
        for (int c = 0; c < 4; ++c) { const int co = col0 + (c >> 1) * 128 + (c & 1) * 16; zc[c] = *(const u32x2*)(zg + (size_t)row0 * 2048 + 1024 + co); tc[c] = *(const u32x2*)(T + (size_t)row0 * 1024 + co); }
#pragma unroll
        for (int g = 0; g < 8; ++g) {
            const int ai = g >> 2, m = g & 3, row = row0 + ai * 128 + m * 16;
            if (g < 7) { const int rn = row0 + ((g + 1) >> 2) * 128 + ((g + 1) & 3) * 16;
#pragma unroll
                for (int c = 0; c < 4; ++c) { const int co = col0 + (c >> 1) * 128 + (c & 1) * 16; zn[c] = *(const u32x2*)(zg + (size_t)rn * 2048 + 1024 + co); tn[c] = *(const u32x2*)(T + (size_t)rn * 1024 + co); } }
#pragma unroll
            for (int c = 0; c < 4; ++c) { const f32x4 tf = (f32x4){BLO(tc[c].x), BHI(tc[c].x), BLO(tc[c].y), BHI(tc[c].y)}; const f32x4 o = tf + sig4(zc[c], bv[c]) * acc[ai][c >> 1][m][c & 1];
                u32x2 w; w.x = pg8::cvt_pk_bf16(o[0], o[1]); w.y = pg8::cvt_pk_bf16(o[2], o[3]);
                *(u32x2*)(merged + (size_t)row * 1024 + col0 + (c >> 1) * 128 + (c & 1) * 16) = w; }
#pragma unroll
            for (int c = 0; c < 4; ++c) { zc[c] = zn[c]; tc[c] = tn[c]; }
        }
    }
};
constexpr int MERGE_PM_OFF = (int)((OFF_YML - OFF_Y) / (256 * 512 * 2)), MERGE_PN_OFF = (int)((OFF_PMLT - OFF_PRWT) / (256 * 512 * 2));
static_assert((size_t)MERGE_PM_OFF * 256 * 512 * 2 == OFF_YML - OFF_Y && (size_t)MERGE_PN_OFF * 256 * 512 * 2 == OFF_PMLT - OFF_PRWT, "merge operand panels");
struct MergeOrder : pg8::StaticOrder {
    __device__ __forceinline__ bool next(int i, pg8::Unit& u) const { if (i >= 2 || !pg8::StaticOrder::next(0, u)) return false; if (i == 1) { u.pm += MERGE_PM_OFF; u.pn += MERGE_PN_OFF; } return true; }
};
struct EpiMerge {
    static constexpr bool PERM = false, AFTER_DRAIN = false;
    EpiMerge1 e1; EpiMerge2 e2;
    __device__ __forceinline__ void operator()(const f32x4 (&acc)[2][2][4][2], const pg8::Unit& u, int wr, int wc, int fr, int fq) const {
        if (u.pm >= MERGE_PM_OFF) { pg8::Unit v; v.pm = u.pm - MERGE_PM_OFF; v.pn = u.pn - MERGE_PN_OFF; e2(acc, v, wr, wc, fr, fq); } else e1(acc, u, wr, wc, fr, fq);
    }
};
struct EpiOut {
    static constexpr bool PERM = false, AFTER_DRAIN = false;
    const float* x; float* x1; bf16_t* x1b; float* ss2;
    __device__ __forceinline__ void operator()(const f32x4 (&acc)[2][2][4][2], const pg8::Unit& u, int wr, int wc, int fr, int fq) const {
        const int row0 = u.pm * 256 + wr * 64 + fr, col0 = u.pn * 256 + wc * 32 + 4 * fq;
        f32x4 xc[4], xn[4];
#pragma unroll
        for (int c = 0; c < 4; ++c) xc[c] = *(const f32x4*)(x + (size_t)row0 * 1024 + col0 + (c >> 1) * 128 + (c & 1) * 16);
#pragma unroll
        for (int g = 0; g < 8; ++g) {
            const int ai = g >> 2, m = g & 3, row = row0 + ai * 128 + m * 16; float s = 0.f;
            if (g < 7) { const int rn = row0 + ((g + 1) >> 2) * 128 + ((g + 1) & 3) * 16;
#pragma unroll
                for (int c = 0; c < 4; ++c) xn[c] = *(const f32x4*)(x + (size_t)rn * 1024 + col0 + (c >> 1) * 128 + (c & 1) * 16); }
#pragma unroll
            for (int c = 0; c < 4; ++c) { const int col = col0 + (c >> 1) * 128 + (c & 1) * 16;
                const f32x4 o = xc[c] + acc[ai][c >> 1][m][c & 1];
                u32x2 w; w.x = pg8::cvt_pk_bf16(o[0], o[1]); w.y = pg8::cvt_pk_bf16(o[2], o[3]);
                *(u32x2*)(x1b + (size_t)row * 1024 + col) = w;
                s += (o[0] * o[0] + o[1] * o[1]) + (o[2] * o[2] + o[3] * o[3]); }
            s += __shfl_xor(s, 16); s += __shfl_xor(s, 32);
            if (fq == 0) ss2[(size_t)(u.pn * 4 + wc) * NTOK + row] = s;
#pragma unroll
            for (int c = 0; c < 4; ++c) xc[c] = xn[c];
        }
    }
};
struct EpiQ {
    static constexpr bool PERM = true, AFTER_DRAIN = false;
    bf16_t* q;
    __device__ __forceinline__ void operator()(const f32x4 (&acc)[2][2][4][2], const pg8::Unit& u, int wr, int wc, int fr, int fq) const {
        const int row0 = u.pm * 256 + wr * 64 + fr, col0 = u.pn * 256 + wc * 32 + 8 * fq;
#pragma unroll
        for (int ai = 0; ai < 2; ++ai)
#pragma unroll
            for (int m = 0; m < 4; ++m) {
                const int row = row0 + ai * 128 + m * 16;
                bf16_t* rowp = q + (size_t)row * 2048 + col0;
#pragma unroll
                for (int bj = 0; bj < 2; ++bj) {
                    const f32x4 v0 = acc[ai][bj][m][0], v1 = acc[ai][bj][m][1];
                    u32x4 w; w.x = pg8::cvt_pk_bf16(v0[0], v0[1]); w.y = pg8::cvt_pk_bf16(v0[2], v0[3]); w.z = pg8::cvt_pk_bf16(v1[0], v1[1]); w.w = pg8::cvt_pk_bf16(v1[2], v1[3]);
                    *(u32x4*)(rowp + bj * 128) = w;
                }
            }
    }
};

#define P0_LOAD(dstv, tt) do { if ((tt) < ntiles) { const int kb_ = (tt) / NT, nb_ = (tt) - kb_ * NT; const int n_ = nb_ * 64 + nl, col_ = n_ >= sf ? n_ + sk : n_; \
        _Pragma("unroll") for (int i = 0; i < 8; ++i) { const int k_ = kb_ * 64 + kl0 + 8 * i; float v_ = src[(size_t)k_ * ld + col_]; if (ks) v_ *= ks[k_]; dstv[i] = v_; } } } while (0)
__device__ __forceinline__ void p0_matrix(const float* src, int ld, int K, bf16_t* dst, const float* ks, int sf, int sk, int NT, int ntiles, int start, int step, float* lds, int tid) {
    const int nl = tid & 63, kl0 = tid >> 6;
    float cur[8], n1[8], n2[8];
    int t = start;
    P0_LOAD(cur, t); P0_LOAD(n1, t + step);
    for (; t < ntiles; t += step) {
        P0_LOAD(n2, t + 2 * step);
#pragma unroll
        for (int i = 0; i < 8; ++i) lds[(kl0 + 8 * i) * 65 + nl] = cur[i];
        __syncthreads();
        { const int kb = t / NT, nb = t - kb * NT; const int n = tid & 63, kc = tid >> 6; const float* c0 = lds + (kc * 8) * 65 + n;
          u32x4 w; w.x = pk2(c0[0], c0[65]); w.y = pk2(c0[130], c0[195]); w.z = pk2(c0[260], c0[325]); w.w = pk2(c0[390], c0[455]);
          *(u32x4*)(dst + (size_t)(nb * 64 + n) * K + kb * 64 + kc * 8) = w; }
        __syncthreads();
#pragma unroll
        for (int i = 0; i < 8; ++i) { cur[i] = n1[i]; n1[i] = n2[i]; }
    }
}
#undef P0_LOAD
__device__ __forceinline__ void phase0(const Params& p, float* lds) {
    unsigned char* ws = p.ws;
    const int tid = tid_opaque();
    float* TB = lds;
    float* GW = lds + 4224;
    { const float* w_in = p.in[2]; const float* g1 = p.in[1];
      for (int i = tid; i < 8192; i += 512) { const int c = i >> 10, k = i & 1023; GW[i] = w_in[(size_t)k * 5896 + 3840 + c] * g1[k]; } }
    __syncthreads();
    const int wave = tid >> 6, lane = tid & 63;
    float* rstd1 = (float*)(ws + OFF_RSTD1); float* ifg = (float*)(ws + OFF_IFG); bf16_t* xb = (bf16_t*)(ws + OFF_XB);
    int row = blockIdx.x * 8 + wave; const int rstep = gridDim.x * 8;
    f32x4 v[4], vn[4];
#define P0_ROWLD(dstv, rr) do { if ((rr) < NTOK) { _Pragma("unroll") for (int jx = 0; jx < 4; ++jx) dstv[jx] = ((const f32x4*)(p.in[0] + (size_t)(rr) * 1024))[lane + 64 * jx]; } } while (0)
#define P0_ROWPROC() do { if (row < NTOK) { \
        float d[9]; _Pragma("unroll") for (int c = 0; c < 9; ++c) d[c] = 0.f; \
        _Pragma("unroll") for (int jx = 0; jx < 4; ++jx) { \
            d[8] += (v[jx][0] * v[jx][0] + v[jx][1] * v[jx][1]) + (v[jx][2] * v[jx][2] + v[jx][3] * v[jx][3]); \
            _Pragma("unroll") for (int c = 0; c < 8; ++c) { const f32x4 w = *(const f32x4*)(GW + c * 1024 + (lane + 64 * jx) * 4); d[c] += (v[jx][0] * w[0] + v[jx][1] * w[1]) + (v[jx][2] * w[2] + v[jx][3] * w[3]); } } \
        _Pragma("unroll") for (int o = 1; o < 64; o <<= 1) { _Pragma("unroll") for (int c = 0; c < 9; ++c) d[c] += __shfl_xor(d[c], o); } \
        const float rs = __builtin_amdgcn_rsqf(d[8] * (1.f / 1024.f) + 1e-6f); \
        if (lane == 0) rstd1[row] = rs; \
        _Pragma("unroll") for (int jx = 0; jx < 4; ++jx) { u32x2 o; o.x = pk2(v[jx][0] * rs, v[jx][1] * rs); o.y = pk2(v[jx][2] * rs, v[jx][3] * rs); ((u32x2*)(xb + (size_t)row * 1024))[lane + 64 * jx] = o; } \
        float mine = d[0]; _Pragma("unroll") for (int c = 1; c < 8; ++c) mine = (lane == c) ? d[c] : mine; \
        if (lane < 8) ifg[row * 8 + lane] = mine * rs; \
        _Pragma("unroll") for (int jx = 0; jx < 4; ++jx) v[jx] = vn[jx]; \
        P0_ROWLD(vn, row + 2 * rstep); row += rstep; } } while (0)
    P0_ROWLD(v, row); P0_ROWLD(vn, row + rstep);
    { const float* src = p.in[2]; const float* ks = p.in[1]; bf16_t* dst = (bf16_t*)(ws + OFF_WINT);
      const int ld = 5896, K = 1024, sf = 3840, sk = 8, NT = 92, ntiles = 1472, step = gridDim.x;
      const int nl = tid & 63, kl0 = tid >> 6;
      float cur[8], n1[8];
#define P0_LOAD(dstv, tt) do { if ((tt) < ntiles) { const int kb_ = (tt) / NT, nb_ = (tt) - kb_ * NT; const int n_ = nb_ * 64 + nl, col_ = n_ >= sf ? n_ + sk : n_; \
        _Pragma("unroll") for (int i = 0; i < 8; ++i) { const int k_ = kb_ * 64 + kl0 + 8 * i; dstv[i] = src[(size_t)k_ * ld + col_] * ks[k_]; } } } while (0)
      int t = blockIdx.x;
      P0_LOAD(cur, t);
      for (; t < ntiles; t += step) {
          P0_LOAD(n1, t + step);
#pragma unroll
          for (int i = 0; i < 8; ++i) TB[(kl0 + 8 * i) * 65 + nl] = cur[i];
          __syncthreads();
          { const int kb = t / NT, nb = t - kb * NT; const int n = tid & 63, kc = tid >> 6; const float* c0 = TB + (kc * 8) * 65 + n;
            u32x4 w; w.x = pk2(c0[0], c0[65]); w.y = pk2(c0[130], c0[195]); w.z = pk2(c0[260], c0[325]); w.w = pk2(c0[390], c0[455]);
            *(u32x4*)(dst + (size_t)(nb * 64 + n) * K + kb * 64 + kc * 8) = w; }
          P0_ROWPROC();
          __syncthreads();
          P0_ROWPROC();
#pragma unroll
          for (int i = 0; i < 8; ++i) cur[i] = n1[i];
      }
#undef P0_LOAD
    }
    while (__any(row < NTOK)) P0_ROWPROC();
#undef P0_ROWPROC
#undef P0_ROWLD
    __syncthreads();
    { const int G = gridDim.x, bx = blockIdx.x;
      p0_matrix(p.in[5], 512, 64, (bf16_t*)(ws + OFF_WUPT), nullptr, 1 << 30, 0, 8, 8, (bx + 64) % G, G, TB, tid);
      p0_matrix(p.in[7], 512, 64, (bf16_t*)(ws + OFF_AUPT), nullptr, 1 << 30, 0, 8, 8, (bx + 56) % G, G, TB, tid);
      p0_matrix(p.in[8], 512, 128, (bf16_t*)(ws + OFF_GUPT), nullptr, 1 << 30, 0, 8, 16, (bx + 40) % G, G, TB, tid); }
    { bf16_t* skt = (bf16_t*)(ws + OFF_SKT); const float* sk = p.in[27];
      for (int i = blockIdx.x * 512 + tid; i < 262144; i += gridDim.x * 512) skt[i] = (bf16_t)f2bf(sk[i]); }
}

constexpr int LDT = 72;
constexpr int SLOT = 64 * LDT * 2;
typedef float f32x16 __attribute__((ext_vector_type(16)));
#define MFMA16(a, b, c) __builtin_amdgcn_mfma_f32_16x16x32_bf16((a), (b), (c), 0, 0, 0)
#define MFMA32(a, b, c) __builtin_amdgcn_mfma_f32_32x32x16_bf16((a), (b), (c), 0, 0, 0)
__device__ __forceinline__ bf16x8 lds_frag(const bf16_t* M, int row0, int k0, int lane) { return *(const bf16x8*)(M + (row0 + (lane & 15)) * LDT + k0 + (lane >> 4) * 8); }
__device__ __forceinline__ f32x4 mm64(const bf16_t* P, const bf16_t* Q, int pt, int qt, f32x4 acc, int lane) {
#pragma unroll
    for (int k0 = 0; k0 < 64; k0 += 32) { const bf16x8 a = lds_frag(Q, qt * 16, k0, lane), b = lds_frag(P, pt * 16, k0, lane); acc = MFMA16(a, b, acc); }
    return acc;
}
__device__ __forceinline__ void st_tile(bf16_t* Z, int pt, int qt, const f32x4 v, int lane) {
    u32x2 w; w.x = pk2(v[0], v[1]); w.y = pk2(v[2], v[3]);
    *(u32x2*)(Z + (pt * 16 + (lane & 15)) * LDT + qt * 16 + (lane >> 4) * 4) = w;
}
__device__ __forceinline__ void st_tile_T(bf16_t* ZT, int pt, int qt, const f32x4 v, int lane) {
#pragma unroll
    for (int j = 0; j < 4; ++j) ZT[(qt * 16 + (lane >> 4) * 4 + j) * LDT + pt * 16 + (lane & 15)] = (bf16_t)f2bf(v[j]);
}
__device__ __forceinline__ f32x4 ld4bf(const bf16_t* p) { const u32x2 r = *(const u32x2*)p; f32x4 o; o[0] = __uint_as_float(r.x << 16); o[1] = __uint_as_float(r.x & 0xffff0000u); o[2] = __uint_as_float(r.y << 16); o[3] = __uint_as_float(r.y & 0xffff0000u); return o; }

#ifndef STAMP_SEL
#define STAMP_SEL 0
#endif
#define TSTAMP(k) do { if (STAMP_SEL) { const unsigned long long _t = __builtin_amdgcn_s_memrealtime(); if (STAMP_SEL == (k)) tacc += (unsigned)(_t - tlast); tlast = _t; } } while (0)
__device__ __forceinline__ void phase_rwkv_prep(const Params& p, unsigned char* smem_, unsigned& tacc) {
    unsigned long long tlast = 0;
    int tidv = threadIdx.x;
#define RETID() asm volatile("" : "+v"(tidv))
#define tid tidv
#define lane (tidv & 63)
#define wv (tidv >> 6)
#define fr (tidv & 15)
#define fq ((tidv >> 4) & 3)
#define SL(i) ((bf16_t*)(smem_ + (i) * SLOT))
    float* part = (float*)(smem_ + 17 * SLOT);
    float* gl_s = part + 512;
    bf16_t* RKV = SL(2);
    const bf16_t* zrw = (const bf16_t*)(p.ws + OFF_ZRW);
    bf16_t* Vg = (bf16_t*)(p.ws + OFF_V); bf16_t* Gg = (bf16_t*)(p.ws + OFF_G); float* bonus = (float*)(p.ws + OFF_BONUS);
    const bf16_t* WupT = (const bf16_t*)(p.ws + OFF_WUPT); const bf16_t* AupT = (const bf16_t*)(p.ws + OFF_AUPT); const bf16_t* GupT = (const bf16_t*)(p.ws + OFF_GUPT);
    bf16_t* FR = (bf16_t*)p.out;
    const float* mu = p.in[3];
    u32x4 zc[4], zp[4], zq[4];
#define RW_ISSUE(uu) do { const int h_ = (uu) & 7, bc_ = (uu) >> 3, n0_ = bc_ * 64, t0_ = (bc_ & 63) * 64; \
        _Pragma("unroll") for (int j = 0; j < 4; ++j) { const int task = tid + 512 * j, t = task >> 5, cg = task & 31; \
            if (h_ == 0) { const bf16_t* src = zrw + (size_t)(n0_ + t) * 1792 + 1536 + cg * 8; zc[j] = *(const u32x4*)src; \
                zp[j] = (t0_ + t > 0) ? *(const u32x4*)(src - 1792) : (u32x4){0u, 0u, 0u, 0u}; } \
            else zc[j] = *(const u32x4*)(actin + ((size_t)(bc_ * 64 + t) * 256 + cg * 8)); \
            const int i = task / 24, rem = task - i * 24; \
            zq[j] = (task < 1560 && t0_ + i > 0) ? *(const u32x4*)(zrw + (size_t)(n0_ + i - 1) * 1792 + (rem >> 3) * 512 + h_ * 64 + (rem & 7) * 8) : (u32x4){0u, 0u, 0u, 0u}; } } while (0)
    bf16_t* actin = (bf16_t*)(p.ws + OFF_ACTIN);
    int hcur = -1; bf16x8 wfw[2][2], wfa[2][2], wfg[2][4];
    float w0c = 0.f, a0c = 0.f, kkc = 0.f, kac = 0.f, rkc = 0.f, mur = 0.f, muk = 0.f, muv = 0.f;
    if (blockIdx.x < 256) RW_ISSUE(blockIdx.x * 8);
    for (int kk_ = 0; (int)blockIdx.x + (kk_ >> 3) * (int)gridDim.x < 256; ++kk_) {
        const int u = ((int)blockIdx.x + (kk_ >> 3) * (int)gridDim.x) * 8 + (kk_ & 7);
        const int un = ((int)blockIdx.x + ((kk_ + 1) >> 3) * (int)gridDim.x) * 8 + ((kk_ + 1) & 7);
        const int h = u & 7, bc = u >> 3; const int n0 = bc * 64, t0 = (bc & 63) * 64;
        const int hc = h * 64 + lane;
        if (h != hcur) { hcur = h; w0c = p.in[4][hc]; a0c = p.in[6][hc]; kkc = p.in[9][hc]; kac = p.in[10][hc]; rkc = p.in[11][hc]; mur = mu[hc]; muk = mu[512 + hc]; muv = mu[1024 + hc]; }
#pragma unroll
        for (int q = 0; q < 2; ++q) { const int qt = (wv * 2 + q) & 3;
#pragma unroll
            for (int ks = 0; ks < 2; ++ks) { wfw[q][ks] = *(const bf16x8*)(WupT + (size_t)(h * 64 + qt * 16 + fr) * 64 + ks * 32 + fq * 8); wfa[q][ks] = *(const bf16x8*)(AupT + (size_t)(h * 64 + qt * 16 + fr) * 64 + ks * 32 + fq * 8); }
#pragma unroll
            for (int ks = 0; ks < 4; ++ks) wfg[q][ks] = *(const bf16x8*)(GupT + (size_t)(h * 64 + qt * 16 + fr) * 128 + ks * 32 + fq * 8); }
        TSTAMP(0);
        RETID();
        { bf16_t* INW = SL(8); bf16_t* INA = SL(9); bf16_t* ING = SL(10);
#pragma unroll
          for (int j = 0; j < 4; ++j) { const int task = tid + 512 * j, t = task >> 5, cg = task & 31;
              u32x4 w;
              if (h == 0) {
              const f32x4 m0 = *(const f32x4*)(mu + 1536 + cg * 8), m1 = *(const f32x4*)(mu + 1536 + cg * 8 + 4);
              float z[8];
              z[0] = BLO(zc[j].x) + (BLO(zp[j].x) - BLO(zc[j].x)) * m0[0]; z[1] = BHI(zc[j].x) + (BHI(zp[j].x) - BHI(zc[j].x)) * m0[1];
              z[2] = BLO(zc[j].y) + (BLO(zp[j].y) - BLO(zc[j].y)) * m0[2]; z[3] = BHI(zc[j].y) + (BHI(zp[j].y) - BHI(zc[j].y)) * m0[3];
              z[4] = BLO(zc[j].z) + (BLO(zp[j].z) - BLO(zc[j].z)) * m1[0]; z[5] = BHI(zc[j].z) + (BHI(zp[j].z) - BHI(zc[j].z)) * m1[1];
              z[6] = BLO(zc[j].w) + (BLO(zp[j].w) - BLO(zc[j].w)) * m1[2]; z[7] = BHI(zc[j].w) + (BHI(zp[j].w) - BHI(zc[j].w)) * m1[3];
              if (cg < 8) {
#pragma unroll
                  for (int e = 0; e < 8; ++e) z[e] = 1.f - 2.f * __builtin_amdgcn_rcpf(1.f + __expf(2.f * z[e]));
              } else if (cg >= 16) {
#pragma unroll
                  for (int e = 0; e < 8; ++e) z[e] = __builtin_amdgcn_rcpf(1.f + __expf(-z[e]));
              }
              w.x = pk2(z[0], z[1]); w.y = pk2(z[2], z[3]); w.z = pk2(z[4], z[5]); w.w = pk2(z[6], z[7]);
              *(u32x4*)(actin + ((size_t)(bc * 64 + t) * 256 + cg * 8)) = w;
              } else w = zc[j];
              bf16_t* d = cg < 8 ? INW + t * LDT + cg * 8 : (cg < 16 ? INA + t * LDT + (cg - 8) * 8 : ING + t * 136 + (cg - 16) * 8);
              *(u32x4*)d = w;
              if (task < 1560) { const int i = task / 24, rem = task - i * 24; *(u32x4*)(RKV + i * 200 + (rem >> 3) * 64 + (rem & 7) * 8) = zq[j]; } } }
        if (h == 0) asm volatile("s_waitcnt vmcnt(0)" ::: "memory");
        __syncthreads();
        { float* LW = (float*)SL(12); float* LA = (float*)SL(14); float* LG = (float*)SL(0);
#pragma unroll
          for (int q = 0; q < 2; ++q) { const int pos = wv * 2 + q, pt = pos >> 2, qt = pos & 3;
              f32x4 aw = (f32x4){0.f, 0.f, 0.f, 0.f}, aa = aw, ag = aw;
#pragma unroll
              for (int ks = 0; ks < 2; ++ks) { aw = MFMA16(wfw[q][ks], lds_frag(SL(8), pt * 16, ks * 32, lane), aw); aa = MFMA16(wfa[q][ks], lds_frag(SL(9), pt * 16, ks * 32, lane), aa); }
#pragma unroll
              for (int ks = 0; ks < 4; ++ks) ag = MFMA16(wfg[q][ks], *(const bf16x8*)(SL(10) + (pt * 16 + fr) * 136 + ks * 32 + fq * 8), ag);
              *(f32x4*)(LW + (pt * 16 + fr) * 68 + qt * 16 + fq * 4) = aw; *(f32x4*)(LA + (pt * 16 + fr) * 68 + qt * 16 + fq * 4) = aa; *(f32x4*)(LG + (pt * 16 + fr) * 68 + qt * 16 + fq * 4) = ag; } }
        __syncthreads();
        TSTAMP(1);
        RETID();
        { const float* LW = (const float*)SL(12); const float* LA = (const float*)SL(14); const float* LG = (const float*)SL(0);
          float rr[8], km[8], vv[8], kk[8], bb[8], ld[8], cl[8], gg[8], bn[8], n2[8];
          float run = 0.f;
          { float zrp = bf2f(RKV[(wv * 8) * 200 + lane]), zkp = bf2f(RKV[(wv * 8) * 200 + 64 + lane]), zvp = bf2f(RKV[(wv * 8) * 200 + 128 + lane]);
#pragma unroll
            for (int i = 0; i < 8; ++i) {
                const int t = wv * 8 + i;
                const float zr = bf2f(RKV[(t + 1) * 200 + lane]), zk = bf2f(RKV[(t + 1) * 200 + 64 + lane]), zv = bf2f(RKV[(t + 1) * 200 + 128 + lane]);
                const float r = zr + (zrp - zr) * mur, k = zk + (zkp - zk) * muk, v = zv + (zvp - zv) * muv;
                zrp = zr; zkp = zk; zvp = zv;
                const float lw = w0c + LW[t * 68 + lane];
                const float sp = fmaxf(-lw, 0.f) + __logf(1.f + __expf(-fabsf(lw)));
                const float logdec = -__expf(-sp - 0.5f);
                const float a = __builtin_amdgcn_rcpf(1.f + __expf(-(a0c + LA[t * 68 + lane])));
                const float kx = k * kkc; const float kmod = k * (1.f + (a - 1.f) * kac);
                n2[i] = kx * kx; bn[i] = r * kmod * rkc;
                rr[i] = r; km[i] = kmod; vv[i] = v; kk[i] = kx; bb[i] = a; ld[i] = logdec; run += logdec; cl[i] = run; gg[i] = LG[t * 68 + lane];
            } }
#pragma unroll
          for (int o = 1; o < 64; o <<= 1) {
#pragma unroll
              for (int i = 0; i < 8; ++i) { n2[i] += __shfl_xor(n2[i], o); bn[i] += __shfl_xor(bn[i], o); } }
#pragma unroll
          for (int i = 0; i < 8; ++i) { const int n = n0 + wv * 8 + i;
              kk[i] = kk[i] * __builtin_amdgcn_rcpf(fmaxf(sqrtf(n2[i]), 1e-12f)); bb[i] = kk[i] * bb[i];
              Vg[(size_t)n * 512 + hc] = (bf16_t)f2bf(vv[i]); Gg[(size_t)n * 512 + hc] = (bf16_t)f2bf(gg[i]);
              if (lane == 0) bonus[n * 8 + h] = bn[i]; }
          part[wv * 64 + lane] = run;
          __syncthreads();
          float off = 0.f, tot = 0.f;
#pragma unroll
          for (int g = 0; g < 8; ++g) { const float x = part[g * 64 + lane]; tot += x; off += (g < wv) ? x : 0.f; }
          if (wv == 0) gl_s[lane] = __expf(tot);
          unsigned pkT[4][4];
          float prevv[4];
#pragma unroll
          for (int i = 0; i < 8; ++i) {
              const int t = wv * 8 + i; const float cum = off + cl[i];
              const float ein = __expf(cum), eout = __expf(-cum), eex = __expf(cum - ld[i]), erem = __expf(tot - cum);
              const float kap = kk[i] * eex, bet = bb[i] * eout, kt = km[i] * eout, rt = rr[i] * ein, betp = bb[i] * erem, ktp = km[i] * erem;
              SL(0)[t * LDT + lane] = (bf16_t)f2bf(kap); SL(1)[t * LDT + lane] = (bf16_t)f2bf(bet); SL(2)[t * LDT + lane] = (bf16_t)f2bf(kt); SL(3)[t * LDT + lane] = (bf16_t)f2bf(rt);
              if (i & 1) { pkT[0][i >> 1] = pk2(prevv[0], kap); pkT[1][i >> 1] = pk2(prevv[1], betp); pkT[2][i >> 1] = pk2(prevv[2], ktp); pkT[3][i >> 1] = pk2(prevv[3], vv[i]); }
              else { prevv[0] = kap; prevv[1] = betp; prevv[2] = ktp; prevv[3] = vv[i]; }
          }
#pragma unroll
          for (int a = 0; a < 4; ++a) { u32x4 w; w.x = pkT[a][0]; w.y = pkT[a][1]; w.z = pkT[a][2]; w.w = pkT[a][3]; *(u32x4*)(SL(4 + a) + lane * LDT + wv * 8) = w; }
        }
        __syncthreads();
        TSTAMP(2);
        RETID();
        if (un < 2048) RW_ISSUE(un);
        f32x4 Tacc[2];
#pragma unroll
        for (int q = 0; q < 2; ++q) {
            const int pos = wv * 2 + q, pt = pos >> 2, qt = pos & 3;
            const int t = pt * 16 + fr, s0 = qt * 16 + fq * 4;
            const f32x4 z = (f32x4){0.f, 0.f, 0.f, 0.f};
            f32x4 abk = mm64(SL(0), SL(1), pt, qt, z, lane), akk = mm64(SL(0), SL(2), pt, qt, z, lane), akr = mm64(SL(3), SL(2), pt, qt, z, lane), abr = mm64(SL(3), SL(1), pt, qt, z, lane);
            f32x4 t0v;
#pragma unroll
            for (int j = 0; j < 4; ++j) { const int s = s0 + j; const bool lo = s < t, le = s <= t;
                abk[j] = lo ? -abk[j] : 0.f; akk[j] = lo ? akk[j] : 0.f; akr[j] = le ? akr[j] : 0.f; abr[j] = le ? abr[j] : 0.f; t0v[j] = abk[j] + (s == t ? 1.f : 0.f); }
            st_tile(SL(8), pt, qt, akk, lane); st_tile(SL(9), pt, qt, akr, lane); st_tile(SL(10), pt, qt, abr, lane);
            st_tile(SL(11), pt, qt, abk, lane); st_tile_T(SL(12), pt, qt, abk, lane); st_tile(SL(13), pt, qt, t0v, lane);
            Tacc[q] = t0v;
        }
        __syncthreads();
        TSTAMP(3);
        RETID();
#pragma unroll 1
        for (int lv = 0; lv < 5; ++lv) {
            const int ib = (lv & 1) ? 0 : 11, ob = (lv & 1) ? 11 : 0;
            const bf16_t* Pc = SL(ib); const bf16_t* Pt = SL(ib + 1); const bf16_t* Tin = SL(ib + 2);
            bf16_t* Pco = SL(ob); bf16_t* Pto = SL(ob + 1); bf16_t* Tout = SL(ob + 2);
#pragma unroll
            for (int q = 0; q < 2; ++q) { const int pos = wv * 2 + q, pt = pos >> 2, qt = pos & 3;
                const f32x4 pn = mm64(Pc, Pt, pt, qt, (f32x4){0.f, 0.f, 0.f, 0.f}, lane);
                st_tile(Pco, pt, qt, pn, lane); st_tile_T(Pto, pt, qt, pn, lane); }
            __syncthreads();
#pragma unroll
            for (int q = 0; q < 2; ++q) { const int pos = wv * 2 + q, pt = pos >> 2, qt = pos & 3;
                Tacc[q] = mm64(Tin, Pto, pt, qt, Tacc[q], lane);
                st_tile(Tout, pt, qt, Tacc[q], lane); }
            __syncthreads();
        }
        TSTAMP(4);
        RETID();
#pragma unroll
        for (int q = 0; q < 2; ++q) { const int pos = wv * 2 + q, pt = pos >> 2, qt = pos & 3; const f32x4 z = (f32x4){0.f, 0.f, 0.f, 0.f};
            st_tile(SL(14), pt, qt, mm64(SL(7), SL(8), pt, qt, z, lane), lane);
            st_tile(SL(15), pt, qt, mm64(SL(4), SL(2), pt, qt, z, lane), lane); }
        __syncthreads();
#pragma unroll
        for (int q = 0; q < 2; ++q) { const int pos = wv * 2 + q, pt = pos >> 2, qt = pos & 3;
            const f32x4 r = mm64(SL(14), SL(2), pt, qt, (f32x4){0.f, 0.f, 0.f, 0.f}, lane);
            st_tile(SL(16), pt, qt, -r, lane); }
        __syncthreads();
#pragma unroll
        for (int q = 0; q < 2; ++q) { const int pos = wv * 2 + q, pt = pos >> 2, qt = pos & 3; const f32x4 z = (f32x4){0.f, 0.f, 0.f, 0.f};
            f32x4 y0 = mm64(SL(7), SL(9), pt, qt, z, lane); y0 = mm64(SL(16), SL(10), pt, qt, y0, lane);
            st_tile(SL(0), pt, qt, y0, lane);
            const f32x4 rt = ld4bf(SL(3) + (pt * 16 + fr) * LDT + qt * 16 + fq * 4);
            const f32x4 aw = mm64(SL(10), SL(15), pt, qt, z, lane);
            st_tile(SL(1), pt, qt, rt - aw, lane);
            f32x4 m = -mm64(SL(5), SL(15), pt, qt, z, lane);
#pragma unroll
            for (int j = 0; j < 4; ++j) if (qt * 16 + fq * 4 + j == pt * 16 + fr) m[j] += gl_s[pt * 16 + fr];
            st_tile(SL(11), pt, qt, m, lane);
            f32x4 nn = mm64(SL(7), SL(6), pt, qt, z, lane); nn = mm64(SL(16), SL(5), pt, qt, nn, lane);
            st_tile(SL(12), pt, qt, nn, lane);
        }
        __syncthreads();
        TSTAMP(5);
        RETID();
        { bf16_t* dst = FR + (size_t)u * 16384;
          { const int which = tid >> 8, it = (tid >> 6) & 3, l = tid & 63, r = l & 31, hh = l >> 5;
            const int k0 = 32 * (it >> 1) + 16 * (it & 1) + 4 * hh;
            { const bf16_t* src = SL(1) + (32 * which + r) * LDT + k0; u32x2 a = *(const u32x2*)src, b = *(const u32x2*)(src + 8); u32x4 w; w.x = a.x; w.y = a.y; w.z = b.x; w.w = b.y;
              *(u32x4*)(dst + ((which * 4 + it) * 64 + l) * 8) = w; }
            { const bf16_t* src = SL(11) + (32 * which + r) * LDT + k0; u32x2 a = *(const u32x2*)src, b = *(const u32x2*)(src + 8); u32x4 w; w.x = a.x; w.y = a.y; w.z = b.x; w.w = b.y;
              *(u32x4*)(dst + 4096 + ((which * 4 + it) * 64 + l) * 8) = w; }
          }
          {
            const int sel = tid >> 8, x = (tid >> 7) & 1, vb = (tid >> 6) & 1, l = tid & 63, r = l & 31, hh = l >> 5;
            const bf16_t* src = (sel == 0 ? SL(12) : SL(0)) + (32 * vb + r) * LDT + 32 * x + 4 * hh;
            const u32x2 g0 = *(const u32x2*)src, g1 = *(const u32x2*)(src + 8), g2 = *(const u32x2*)(src + 16), g3 = *(const u32x2*)(src + 24);
            u32x4 w0, w1; w0.x = g0.x; w0.y = g0.y; w0.z = g1.x; w0.w = g1.y; w1.x = g2.x; w1.y = g2.y; w1.z = g3.x; w1.w = g3.y;
            bf16_t* d2 = dst + 8192 + sel * 4096 + ((x * 2 + vb) * 64 + l) * 16;
            *(u32x4*)d2 = w0; *(u32x4*)(d2 + 8) = w1;
          }
        }
        __syncthreads();
        TSTAMP(6);
    }
#undef RW_ISSUE
#undef SL
#undef RETID
#undef tid
#undef lane
#undef wv
#undef fr
#undef fq
}

__device__ __forceinline__ bf16x8 pack8(const f32x16& x, int s8) {
    u32x4 w; w.x = pk2(x[s8], x[s8 + 1]); w.y = pk2(x[s8 + 2], x[s8 + 3]); w.z = pk2(x[s8 + 4], x[s8 + 5]); w.w = pk2(x[s8 + 6], x[s8 + 7]);
    return __builtin_bit_cast(bf16x8, w);
}
__device__ __forceinline__ f32x16 unpack16(const u32x4 a, const u32x4 b) {
    f32x16 o;
    o[0] = BLO(a.x); o[1] = BHI(a.x); o[2] = BLO(a.y); o[3] = BHI(a.y); o[4] = BLO(a.z); o[5] = BHI(a.z); o[6] = BLO(a.w); o[7] = BHI(a.w);
    o[8] = BLO(b.x); o[9] = BHI(b.x); o[10] = BLO(b.y); o[11] = BHI(b.y); o[12] = BLO(b.z); o[13] = BHI(b.z); o[14] = BLO(b.w); o[15] = BHI(b.w);
    return o;
}


__device__ __forceinline__ void phase_rwkv_scan4(const Params& p, unsigned char* smem_, int bh) {
    int tidv = threadIdx.x; asm volatile("" : "+v"(tidv));
    const int lane = tidv & 63, wv = __builtin_amdgcn_readfirstlane(tidv >> 6);
    const int b = bh >> 3, h = bh & 7;
    const bf16_t* FR = (const bf16_t*)p.out; bf16_t* Y = (bf16_t*)(p.ws + OFF_Y);
    constexpr int PD = 4; constexpr int SFB = 98304;
    if (wv >= 2 && wv < 6) {
        const int pc0 = (wv - 2) * 512 + lane;
        u32x4 buf[PD][8];
#define SC_LOAD(k, c) do { const bf16_t* src = FR + (size_t)(((b * 64 + (c)) * 8 + h)) * 16384; _Pragma("unroll") for (int i = 0; i < 8; ++i) buf[k][i] = *(const u32x4*)(src + (size_t)(pc0 + 64 * i) * 8); } while (0)
#define SC_PUT(k, c) do { bf16_t* dst = (bf16_t*)(smem_ + ((c) % 3) * 32768); _Pragma("unroll") for (int i = 0; i < 8; ++i) *(u32x4*)(dst + (pc0 + 64 * i) * 8) = buf[k][i]; } while (0)
#pragma unroll
        for (int k = 0; k < PD; ++k) SC_LOAD(k, k);
        SC_PUT(0, 0); SC_LOAD(0, PD);
        __syncthreads();
#pragma unroll 1
        for (int c0 = 0; c0 < 64; c0 += PD) {
#pragma unroll
            for (int kk = 0; kk < PD; ++kk) {
                const int c = c0 + kk, k = (kk + 1) % PD;
                if (c + 1 < 64) { SC_PUT(k, c + 1); if (c + 1 + PD < 64) SC_LOAD(k, c + 1 + PD); }
                __syncthreads();
            }
        }
        __syncthreads();
#undef SC_LOAD
#undef SC_PUT
    } else if (wv < 2) {
        const int vb = wv;
        f32x16 S0, S1;
#pragma unroll
        for (int i = 0; i < 16; ++i) { S0[i] = 0.f; S1[i] = 0.f; }
        __syncthreads();
#pragma unroll 1
        for (int c = 0; c < 64; ++c) {
            const bf16_t* src = (const bf16_t*)(smem_ + (c % 3) * 32768);
            u32x4 mf[8], nf[4];
#pragma unroll
            for (int i = 0; i < 8; ++i) mf[i] = *(const u32x4*)(src + 4096 + (i * 64 + lane) * 8);
#pragma unroll
            for (int x = 0; x < 2; ++x) { const bf16_t* s2 = src + 8192 + ((x * 2 + vb) * 64 + lane) * 16; nf[2 * x] = *(const u32x4*)s2; nf[2 * x + 1] = *(const u32x4*)(s2 + 8); }
            bf16x8 sf[4];
            sf[0] = pack8(S0, 0); sf[1] = pack8(S0, 8); sf[2] = pack8(S1, 0); sf[3] = pack8(S1, 8);
            { unsigned char* sb = smem_ + SFB + (c & 1) * 8192 + vb * 4096;
#pragma unroll
              for (int s = 0; s < 4; ++s) *(bf16x8*)(sb + (s * 64 + lane) * 16) = sf[s]; }
            f32x16 n0 = unpack16(nf[0], nf[1]), n1 = unpack16(nf[2], nf[3]);
#pragma unroll
            for (int s = 0; s < 4; ++s) { n0 = MFMA32(__builtin_bit_cast(bf16x8, mf[s]), sf[s], n0); n1 = MFMA32(__builtin_bit_cast(bf16x8, mf[4 + s]), sf[s], n1); }
            S0 = n0; S1 = n1;
            __syncthreads();
        }
        __syncthreads();
    } else {
        const int vb = wv - 6, r = lane & 31, hh = lane >> 5;
        __syncthreads();
#pragma unroll 1
        for (int c = 0; c <= 64; ++c) {
            if (c >= 1) {
                const int cc = c - 1;
                const bf16_t* src = (const bf16_t*)(smem_ + (cc % 3) * 32768);
                u32x4 qf[8], yf[4]; bf16x8 sf[4];
#pragma unroll
                for (int i = 0; i < 8; ++i) qf[i] = *(const u32x4*)(src + (i * 64 + lane) * 8);
#pragma unroll
                for (int x = 0; x < 2; ++x) { const bf16_t* s3 = src + 12288 + ((x * 2 + vb) * 64 + lane) * 16; yf[2 * x] = *(const u32x4*)s3; yf[2 * x + 1] = *(const u32x4*)(s3 + 8); }
                { const unsigned char* sb = smem_ + SFB + (cc & 1) * 8192 + vb * 4096;
#pragma unroll
                  for (int s = 0; s < 4; ++s) sf[s] = *(const bf16x8*)(sb + (s * 64 + lane) * 16); }
                f32x16 y0 = unpack16(yf[0], yf[1]), y1 = unpack16(yf[2], yf[3]);
#pragma unroll
                for (int s = 0; s < 4; ++s) { y0 = MFMA32(__builtin_bit_cast(bf16x8, qf[s]), sf[s], y0); y1 = MFMA32(__builtin_bit_cast(bf16x8, qf[4 + s]), sf[s], y1); }
                bf16_t* yp = Y + ((size_t)(b * 4096 + cc * 64)) * 512 + h * 64 + vb * 32 + r;
#pragma unroll
                for (int i = 0; i < 16; ++i) { const int row = (i & 3) + 8 * (i >> 2) + 4 * hh; yp[(size_t)row * 512] = (bf16_t)f2bf(y0[i]); yp[(size_t)(32 + row) * 512] = (bf16_t)f2bf(y1[i]); }
            }
            __syncthreads();
        }
    }
}

__device__ __forceinline__ void ml_gates(const Params& p, int n0, int h, float* bcum_s, float* ig_s) {
    if (threadIdx.x < 64) {
        const int lane = threadIdx.x; const float* ifg = (const float*)(p.ws + OFF_IFG);
        const float ig = ifg[(n0 + lane) * 8 + h] + p.in[18][h];
        const float fp = ifg[(n0 + lane) * 8 + 4 + h] + p.in[19][h];
        float c = -softplusf_(-fp);
#pragma unroll
        for (int o = 1; o < 64; o <<= 1) { const float t = __shfl_up(c, o); if (lane >= o) c += t; }
        bcum_s[lane] = c; ig_s[lane] = ig;
    }
}
__device__ __forceinline__ float siluf_(float x) { return x * sigmoidf_(x); }


template <int K> __device__ __forceinline__ f32x4 mmk(const bf16_t* P, int ldp, const bf16_t* Q, int ldq, int pt, int qt, f32x4 acc, int lane_) {
#pragma unroll
    for (int k0 = 0; k0 < K; k0 += 32) {
        const bf16x8 a = *(const bf16x8*)(Q + (qt * 16 + (lane_ & 15)) * ldq + k0 + (lane_ >> 4) * 8);
        const bf16x8 b = *(const bf16x8*)(P + (pt * 16 + (lane_ & 15)) * ldp + k0 + (lane_ >> 4) * 8);
        acc = MFMA16(a, b, acc);
    }
    return acc;
}
__device__ __forceinline__ float fast_silu(float x) { return x * __builtin_amdgcn_rcpf(1.f + __expf(-x)); }

__device__ __forceinline__ void phase_ml_cloc2(const Params& p, unsigned char* smem_, int first, int stride) {
    int tidv = threadIdx.x;
#define RETID() asm volatile("" : "+v"(tidv))
    bf16_t* RAWK = (bf16_t*)smem_;
    bf16_t* RAWV = (bf16_t*)(smem_ + 18432);
    bf16_t* KT = (bf16_t*)(smem_ + 36864);
    bf16_t* VT = (bf16_t*)(smem_ + 55296);
    float* bcum_s = (float*)(smem_ + 73728); float* ig_s = bcum_s + 64;
    const bf16_t* zml = (const bf16_t*)(p.ws + OFF_ZML);
    bf16_t* CLOC = (bf16_t*)(p.ws + OFF_CLOC); float* nloc = (float*)(p.ws + OFF_NLOC); float* gend = (float*)(p.ws + OFF_GEND);
    for (int u = first; u < 1024; u += stride) {
        RETID();
        const int tid = tidv, h = u & 3, bc = u >> 2; const int n0 = bc * 64, t0 = (bc & 63) * 64;
        u32x4 kr[3], vr[2];
#pragma unroll
        for (int j = 0; j < 3; ++j) { const int task = tid + 512 * j, i = task >> 4, c8 = task & 15;
            kr[j] = (task < 1072 && t0 + i - 3 >= 0) ? *(const u32x4*)(zml + (size_t)(n0 + i - 3) * 2048 + 512 + h * 128 + c8 * 8) : (u32x4){0u, 0u, 0u, 0u}; }
#pragma unroll
        for (int j = 0; j < 2; ++j) { const int task = tid + 512 * j, i = task >> 4, c8 = task & 15; vr[j] = *(const u32x4*)(zml + (size_t)(n0 + i) * 2048 + 1024 + h * 128 + c8 * 8); }
        float tt[8]; bf16_t* tdst; int tK, tkb, tnb;
        { const int nl = tid & 63, kl0 = tid >> 6;
          if (u < 512) { tkb = u >> 5; tnb = u & 31; tK = 1024; tdst = (bf16_t*)(p.ws + OFF_WQT);
#pragma unroll
              for (int i = 0; i < 8; ++i) { const int k = tkb * 64 + kl0 + 8 * i; tt[i] = p.in[26][(size_t)k * 2048 + tnb * 64 + nl] * p.in[25][k]; } }
          else if (u < 768) { const int r = u - 512; tkb = r >> 4; tnb = r & 15; tK = 1024; tdst = (bf16_t*)(p.ws + OFF_WOUTT);
#pragma unroll
              for (int i = 0; i < 8; ++i) { const int k = tkb * 64 + kl0 + 8 * i; tt[i] = p.in[24][(size_t)k * 1024 + tnb * 64 + nl]; } }
          else if (u < 896) { const int r = u - 768; tkb = r >> 4; tnb = r & 15; tK = 512; tdst = (bf16_t*)(p.ws + OFF_PRWT);
#pragma unroll
              for (int i = 0; i < 8; ++i) { const int k = tkb * 64 + kl0 + 8 * i; tt[i] = p.in[22][(size_t)k * 1024 + tnb * 64 + nl]; } }
          else { const int r = u - 896; tkb = r >> 4; tnb = r & 15; tK = 512; tdst = (bf16_t*)(p.ws + OFF_PMLT);
#pragma unroll
              for (int i = 0; i < 8; ++i) { const int k = tkb * 64 + kl0 + 8 * i; tt[i] = p.in[23][(size_t)k * 1024 + tnb * 64 + nl]; } } }
        ml_gates(p, n0, h, bcum_s, ig_s);
        { float* TB = (float*)(smem_ + 81920); const int nl = tid & 63, kl0 = tid >> 6;
#pragma unroll
          for (int i = 0; i < 8; ++i) TB[(kl0 + 8 * i) * 65 + nl] = tt[i]; }
#pragma unroll
        for (int j = 0; j < 3; ++j) { const int task = tid + 512 * j, i = task >> 4, c8 = task & 15; if (task < 1072) *(u32x4*)(RAWK + i * 136 + c8 * 8) = kr[j]; }
#pragma unroll
        for (int j = 0; j < 2; ++j) { const int task = tid + 512 * j, i = task >> 4, c8 = task & 15; *(u32x4*)(RAWV + i * 136 + c8 * 8) = vr[j]; }
        __syncthreads();
        RETID();
        { const float* TB = (const float*)(smem_ + 81920); const int n = tidv & 63, kc = tidv >> 6; const float* c0 = TB + (kc * 8) * 65 + n;
          u32x4 w; w.x = pk2(c0[0], c0[65]); w.y = pk2(c0[130], c0[195]); w.z = pk2(c0[260], c0[325]); w.w = pk2(c0[390], c0[455]);
          *(u32x4*)(tdst + (size_t)(tnb * 64 + n) * tK + tkb * 64 + kc * 8) = w; }
        { const int c = tidv & 127, sg = tidv >> 7, s0 = sg * 16, hc = h * 128 + c;
          const float w0 = p.in[16][0 * 512 + hc], w1 = p.in[16][1 * 512 + hc], w2 = p.in[16][2 * 512 + hc], w3 = p.in[16][3 * 512 + hc], bk = p.in[17][hc];
          const float ge = bcum_s[63];
          if (tidv == 0) gend[u] = ge;
          float xm3 = bf2f(RAWK[(s0 + 0) * 136 + c]), xm2 = bf2f(RAWK[(s0 + 1) * 136 + c]), xm1 = bf2f(RAWK[(s0 + 2) * 136 + c]);
          unsigned kp[8], vp[8]; float kprev = 0.f, vprev = 0.f;
#pragma unroll
          for (int i = 0; i < 16; ++i) {
              const int s = s0 + i; const float xc = bf2f(RAWK[(s + 3) * 136 + c]);
              const float kv = fast_silu(bk + w0 * xm3 + w1 * xm2 + w2 * xm1 + w3 * xc) * 0.08838834764831845f;
              xm3 = xm2; xm2 = xm1; xm1 = xc;
              const float vv = __expf(ge - bcum_s[s] + ig_s[s]) * bf2f(RAWV[s * 136 + c]);
              if (i & 1) { kp[i >> 1] = pk2(kprev, kv); vp[i >> 1] = pk2(vprev, vv); } else { kprev = kv; vprev = vv; }
          }
          u32x4 w; w.x = kp[0]; w.y = kp[1]; w.z = kp[2]; w.w = kp[3]; *(u32x4*)(KT + c * 72 + s0) = w; w.x = kp[4]; w.y = kp[5]; w.z = kp[6]; w.w = kp[7]; *(u32x4*)(KT + c * 72 + s0 + 8) = w;
          w.x = vp[0]; w.y = vp[1]; w.z = vp[2]; w.w = vp[3]; *(u32x4*)(VT + c * 72 + s0) = w; w.x = vp[4]; w.y = vp[5]; w.z = vp[6]; w.w = vp[7]; *(u32x4*)(VT + c * 72 + s0 + 8) = w;
        }
        __syncthreads();
        RETID();
        { const int lane_ = tidv & 63, wv_ = tidv >> 6, fr_ = lane_ & 15, fq_ = lane_ >> 4;
#pragma unroll
          for (int qt = 0; qt < 8; ++qt) {
              const f32x4 z = mmk<64>(VT, 72, KT, 72, wv_, qt, (f32x4){0.f, 0.f, 0.f, 0.f}, lane_);
              u32x2 w; w.x = pk2(z[0], z[1]); w.y = pk2(z[2], z[3]);
              *(u32x2*)(CLOC + ((size_t)u * 128 + wv_ * 16 + fr_) * 128 + qt * 16 + fq_ * 4) = w;
          }
          if (tidv < 128) { const int k = tidv; float a = 0.f;
#pragma unroll
              for (int s8 = 0; s8 < 64; s8 += 8) { const u32x4 r = *(const u32x4*)(KT + k * 72 + s8);
                  const float ge = bcum_s[63];
                  a += __expf(ge - bcum_s[s8 + 0] + ig_s[s8 + 0]) * BLO(r.x) + __expf(ge - bcum_s[s8 + 1] + ig_s[s8 + 1]) * BHI(r.x)
                     + __expf(ge - bcum_s[s8 + 2] + ig_s[s8 + 2]) * BLO(r.y) + __expf(ge - bcum_s[s8 + 3] + ig_s[s8 + 3]) * BHI(r.y)
                     + __expf(ge - bcum_s[s8 + 4] + ig_s[s8 + 4]) * BLO(r.z) + __expf(ge - bcum_s[s8 + 5] + ig_s[s8 + 5]) * BHI(r.z)
                     + __expf(ge - bcum_s[s8 + 6] + ig_s[s8 + 6]) * BLO(r.w) + __expf(ge - bcum_s[s8 + 7] + ig_s[s8 + 7]) * BHI(r.w); }
              nloc[u * 128 + k] = a; }
        }
        __syncthreads();
    }
#undef RETID
}

__device__ __forceinline__ void phase_ml_out2(const Params& p, unsigned char* smem_) {
    int tidv = threadIdx.x;
#define RETID() asm volatile("" : "+v"(tidv))
    bf16_t* RAWQ = (bf16_t*)smem_;
    bf16_t* RAWK = (bf16_t*)(smem_ + 18432);
    bf16_t* RAWV = (bf16_t*)(smem_ + 36864);
    bf16_t* Qm = (bf16_t*)(smem_ + 55296);
    bf16_t* Km = (bf16_t*)(smem_ + 73728);
    bf16_t* VT = (bf16_t*)(smem_ + 92160);
    bf16_t* Cin = (bf16_t*)(smem_ + 110592);
    float* bcum_s = (float*)(smem_ + 145408); float* ig_s = bcum_s + 64; float* nin_s = ig_s + 64; float* den_s = nin_s + 128; float* st_s = den_s + 64;
    bf16_t* PM = RAWQ; bf16_t* QE = RAWK;
    const bf16_t* zml = (const bf16_t*)(p.ws + OFF_ZML); const bf16_t* CLOC = (const bf16_t*)(p.ws + OFF_CLOC); const float* nloc = (const float*)(p.ws + OFF_NLOC);
    bf16_t* YML = (bf16_t*)(p.ws + OFF_YML);
    for (int u = blockIdx.x; u < 1024; u += gridDim.x) {
        RETID();
        const int tid = tidv, h = u & 3, bc = u >> 2; const int n0 = bc * 64, t0 = (bc & 63) * 64;
        { u32x4 qr[3], kr[3], vr[2], cr[4];
#pragma unroll
          for (int j = 0; j < 3; ++j) { const int task = tid + 512 * j, i = task >> 4, c8 = task & 15; const bool ok = task < 1072 && t0 + i - 3 >= 0;
              const bf16_t* src = zml + (size_t)(n0 + i - 3) * 2048 + h * 128 + c8 * 8;
              qr[j] = ok ? *(const u32x4*)src : (u32x4){0u, 0u, 0u, 0u}; kr[j] = ok ? *(const u32x4*)(src + 512) : (u32x4){0u, 0u, 0u, 0u}; }
#pragma unroll
          for (int j = 0; j < 2; ++j) { const int task = tid + 512 * j, i = task >> 4, c8 = task & 15; vr[j] = *(const u32x4*)(zml + (size_t)(n0 + i) * 2048 + 1024 + h * 128 + c8 * 8); }
#pragma unroll
          for (int j = 0; j < 4; ++j) { const int task = tid + 512 * j, v = task >> 4, c8 = task & 15; cr[j] = *(const u32x4*)(CLOC + ((size_t)u * 128 + v) * 128 + c8 * 8); }
          ml_gates(p, n0, h, bcum_s, ig_s);
          if (tid < 128) nin_s[tid] = nloc[u * 128 + tid];
#pragma unroll
          for (int j = 0; j < 3; ++j) { const int task = tid + 512 * j, i = task >> 4, c8 = task & 15; if (task < 1072) { *(u32x4*)(RAWQ + i * 136 + c8 * 8) = qr[j]; *(u32x4*)(RAWK + i * 136 + c8 * 8) = kr[j]; } }
#pragma unroll
          for (int j = 0; j < 2; ++j) { const int task = tid + 512 * j, i = task >> 4, c8 = task & 15; *(u32x4*)(RAWV + i * 136 + c8 * 8) = vr[j]; }
#pragma unroll
          for (int j = 0; j < 4; ++j) { const int task = tid + 512 * j, v = task >> 4, c8 = task & 15; *(u32x4*)(Cin + v * 136 + c8 * 8) = cr[j]; }
        }
        __syncthreads();
        RETID();
        float qe[16];
        { const int c = tidv & 127, sg = tidv >> 7, s0 = sg * 16, hc = h * 128 + c;
          const float q0 = p.in[14][0 * 512 + hc], q1 = p.in[14][1 * 512 + hc], q2 = p.in[14][2 * 512 + hc], q3 = p.in[14][3 * 512 + hc], bq = p.in[15][hc];
          const float w0 = p.in[16][0 * 512 + hc], w1 = p.in[16][1 * 512 + hc], w2 = p.in[16][2 * 512 + hc], w3 = p.in[16][3 * 512 + hc], bk = p.in[17][hc];
          float xm3 = bf2f(RAWK[(s0 + 0) * 136 + c]), xm2 = bf2f(RAWK[(s0 + 1) * 136 + c]), xm1 = bf2f(RAWK[(s0 + 2) * 136 + c]);
          float ym3 = bf2f(RAWQ[(s0 + 0) * 136 + c]), ym2 = bf2f(RAWQ[(s0 + 1) * 136 + c]), ym1 = bf2f(RAWQ[(s0 + 2) * 136 + c]);
          unsigned vp[8]; float vprev = 0.f;
#pragma unroll
          for (int i = 0; i < 16; ++i) {
              const int s = s0 + i; const float xc = bf2f(RAWK[(s + 3) * 136 + c]), yc = bf2f(RAWQ[(s + 3) * 136 + c]);
              const float kv = fast_silu(bk + w0 * xm3 + w1 * xm2 + w2 * xm1 + w3 * xc) * 0.08838834764831845f;
              const float qv = fast_silu(bq + q0 * ym3 + q1 * ym2 + q2 * ym1 + q3 * yc);
              xm3 = xm2; xm2 = xm1; xm1 = xc; ym3 = ym2; ym2 = ym1; ym1 = yc;
              Km[s * 136 + c] = (bf16_t)f2bf(kv); Qm[s * 136 + c] = (bf16_t)f2bf(qv); qe[i] = qv * __expf(bcum_s[s]);
              const float vv = bf2f(RAWV[s * 136 + c]);
              if (i & 1) vp[i >> 1] = pk2(vprev, vv); else vprev = vv;
          }
          u32x4 w; w.x = vp[0]; w.y = vp[1]; w.z = vp[2]; w.w = vp[3]; *(u32x4*)(VT + c * 72 + s0) = w; w.x = vp[4]; w.y = vp[5]; w.z = vp[6]; w.w = vp[7]; *(u32x4*)(VT + c * 72 + s0 + 8) = w;
        }
        __syncthreads();
        RETID();
        { const int c = tidv & 127, s0 = (tidv >> 7) * 16;
#pragma unroll
          for (int i = 0; i < 16; ++i) QE[(s0 + i) * 136 + c] = (bf16_t)f2bf(qe[i]); }
        { const int lane_ = tidv & 63, wv_ = tidv >> 6, fr_ = lane_ & 15, fq_ = lane_ >> 4;
#pragma unroll
          for (int q = 0; q < 2; ++q) { const int pos = wv_ * 2 + q, pt = pos >> 2, qt = pos & 3;
              f32x4 sc = mmk<128>(Qm, 136, Km, 136, pt, qt, (f32x4){0.f, 0.f, 0.f, 0.f}, lane_);
              const int l = pt * 16 + fr_; const float bl = bcum_s[l];
#pragma unroll
              for (int j = 0; j < 4; ++j) { const int s = qt * 16 + fq_ * 4 + j; sc[j] = (s <= l) ? sc[j] * __expf(bl - bcum_s[s] + ig_s[s]) : 0.f; }
              u32x2 w; w.x = pk2(sc[0], sc[1]); w.y = pk2(sc[2], sc[3]);
              *(u32x2*)(PM + l * 72 + qt * 16 + fq_ * 4) = w; }
        }
        __syncthreads();
        RETID();
        {
          const int l = tidv >> 3, sq = tidv & 7;
          const u32x4 pr = *(const u32x4*)(PM + l * 72 + sq * 8);
          float ds = ((BLO(pr.x) + BHI(pr.x)) + (BLO(pr.y) + BHI(pr.y))) + ((BLO(pr.z) + BHI(pr.z)) + (BLO(pr.w) + BHI(pr.w)));
          const u32x4 qa = *(const u32x4*)(QE + l * 136 + sq * 16), qb = *(const u32x4*)(QE + l * 136 + sq * 16 + 8);
          const float* nn = nin_s + sq * 16;
          float qn = BLO(qa.x) * nn[0] + BHI(qa.x) * nn[1] + BLO(qa.y) * nn[2] + BHI(qa.y) * nn[3] + BLO(qa.z) * nn[4] + BHI(qa.z) * nn[5] + BLO(qa.w) * nn[6] + BHI(qa.w) * nn[7]
                   + BLO(qb.x) * nn[8] + BHI(qb.x) * nn[9] + BLO(qb.y) * nn[10] + BHI(qb.y) * nn[11] + BLO(qb.z) * nn[12] + BHI(qb.z) * nn[13] + BLO(qb.w) * nn[14] + BHI(qb.w) * nn[15];
          ds = sum8(ds + qn);
          if (sq == 0) den_s[l] = ds;
        }
        __syncthreads();
        RETID();
        { const int lane_ = tidv & 63, wv_ = tidv >> 6, fr_ = lane_ & 15, fq_ = lane_ >> 4;
          const int pt = wv_ >> 1, vh = wv_ & 1, l = pt * 16 + fr_;
          const float dn = __builtin_amdgcn_rcpf(fmaxf(fabsf(den_s[l]), 1.f));
          f32x4 hv[4]; float sm = 0.f, sq2 = 0.f;
#pragma unroll
          for (int q = 0; q < 4; ++q) { const int qt = vh * 4 + q;
              f32x4 a = mmk<64>(PM, 72, VT, 72, pt, qt, (f32x4){0.f, 0.f, 0.f, 0.f}, lane_);
              a = mmk<128>(QE, 136, Cin, 136, pt, qt, a, lane_);
              hv[q] = a * dn;
              sm += (hv[q][0] + hv[q][1]) + (hv[q][2] + hv[q][3]); sq2 += (hv[q][0] * hv[q][0] + hv[q][1] * hv[q][1]) + (hv[q][2] * hv[q][2] + hv[q][3] * hv[q][3]); }
          sm += __shfl_xor(sm, 16); sm += __shfl_xor(sm, 32); sq2 += __shfl_xor(sq2, 16); sq2 += __shfl_xor(sq2, 32);
          if (fq_ == 0) { st_s[(vh * 64 + l) * 2] = sm; st_s[(vh * 64 + l) * 2 + 1] = sq2; }
          __syncthreads();
          const float s1 = st_s[l * 2] + st_s[(64 + l) * 2], s2 = st_s[l * 2 + 1] + st_s[(64 + l) * 2 + 1];
          const float mean = s1 * (1.f / 128.f); const float var = fmaxf(s2 * (1.f / 128.f) - mean * mean, 0.f); const float rs = __builtin_amdgcn_rsqf(var + 1e-5f);
#pragma unroll
          for (int q = 0; q < 4; ++q) { const int hc = h * 128 + (vh * 4 + q) * 16 + fq_ * 4;
              const f32x4 nw = *(const f32x4*)(p.in[20] + hc);
              const u32x2 op = *(const u32x2*)(zml + (size_t)(n0 + l) * 2048 + 1536 + hc);
              const float o0 = (hv[q][0] - mean) * rs * nw[0] * sigmoidf_(BLO(op.x)), o1 = (hv[q][1] - mean) * rs * nw[1] * sigmoidf_(BHI(op.x));
              const float o2 = (hv[q][2] - mean) * rs * nw[2] * sigmoidf_(BLO(op.y)), o3 = (hv[q][3] - mean) * rs * nw[3] * sigmoidf_(BHI(op.y));
              u32x2 w; w.x = pk2(o0, o1); w.y = pk2(o2, o3);
              *(u32x2*)(YML + (size_t)(n0 + l) * 512 + hc) = w; }
        }
        __syncthreads();
    }
#undef RETID
}

__device__ __forceinline__ void phase_ml_scan(const Params& p) {
    bf16_t* CLOC = (bf16_t*)(p.ws + OFF_CLOC); float* nloc = (float*)(p.ws + OFF_NLOC); const float* gend = (const float*)(p.ws + OFF_GEND);
    const int gt = blockIdx.x * 512 + threadIdx.x, nt = gridDim.x * 512;
    for (int task = gt; task < 32768 + 2048; task += nt) {
        if (task < 32768) {
            const int bh = task >> 11, rem = task & 2047; const int b = bh >> 2, h = bh & 3;
            float run[8];
#pragma unroll
            for (int j = 0; j < 8; ++j) run[j] = 0.f;
            for (int c0 = 0; c0 < 64; c0 += 8) {
                u32x4 raw[8]; float g[8];
#pragma unroll
                for (int i = 0; i < 8; ++i) { const int unit = (b * 64 + c0 + i) * 4 + h; raw[i] = *(const u32x4*)(CLOC + (size_t)unit * 16384 + rem * 8); g[i] = __expf(gend[unit]); }
#pragma unroll
                for (int i = 0; i < 8; ++i) { const int unit = (b * 64 + c0 + i) * 4 + h;
                    u32x4 w; w.x = pk2(run[0], run[1]); w.y = pk2(run[2], run[3]); w.z = pk2(run[4], run[5]); w.w = pk2(run[6], run[7]);
                    *(u32x4*)(CLOC + (size_t)unit * 16384 + rem * 8) = w;
                    run[0] = g[i] * run[0] + __uint_as_float(raw[i].x << 16); run[1] = g[i] * run[1] + __uint_as_float(raw[i].x & 0xffff0000u);
                    run[2] = g[i] * run[2] + __uint_as_float(raw[i].y << 16); run[3] = g[i] * run[3] + __uint_as_float(raw[i].y & 0xffff0000u);
                    run[4] = g[i] * run[4] + __uint_as_float(raw[i].z << 16); run[5] = g[i] * run[5] + __uint_as_float(raw[i].z & 0xffff0000u);
                    run[6] = g[i] * run[6] + __uint_as_float(raw[i].w << 16); run[7] = g[i] * run[7] + __uint_as_float(raw[i].w & 0xffff0000u); }
            }
        } else {
            const int t2 = task - 32768; const int bh = t2 >> 7, k = t2 & 127; const int b = bh >> 2, h = bh & 3;
            float run = 0.f;
            for (int c = 0; c < 64; ++c) { const int unit = (b * 64 + c) * 4 + h; const float x = nloc[unit * 128 + k]; nloc[unit * 128 + k] = run; run = __expf(gend[unit]) * run + x; }
        }
    }
}
__device__ __forceinline__ void phase_rwkv_post(const Params& p) {
    bf16_t* Y = (bf16_t*)(p.ws + OFF_Y); const bf16_t* V = (const bf16_t*)(p.ws + OFF_V); const bf16_t* G = (const bf16_t*)(p.ws + OFF_G);
    const float* bonus = (const float*)(p.ws + OFF_BONUS);
    const int tid = tid_opaque(), lane = tid & 63; const int gw = blockIdx.x * 8 + (tid >> 6), nw = gridDim.x * 8;
    const f32x4 gwa = *(const f32x4*)(p.in[12] + lane * 8), gwb = *(const f32x4*)(p.in[12] + lane * 8 + 4), gba = *(const f32x4*)(p.in[13] + lane * 8), gbb = *(const f32x4*)(p.in[13] + lane * 8 + 4);
    for (int n = gw; n < NTOK; n += nw) {
        const size_t o = (size_t)n * 512 + lane * 8;
        const u32x4 yr = *(const u32x4*)(Y + o), vr = *(const u32x4*)(V + o), gr = *(const u32x4*)(G + o);
        const float bon = bonus[n * 8 + (lane >> 3)];
        float y[8] = {BLO(yr.x), BHI(yr.x), BLO(yr.y), BHI(yr.y), BLO(yr.z), BHI(yr.z), BLO(yr.w), BHI(yr.w)};
        const float v[8] = {BLO(vr.x), BHI(vr.x), BLO(vr.y), BHI(vr.y), BLO(vr.z), BHI(vr.z), BLO(vr.w), BHI(vr.w)};
        const float g[8] = {BLO(gr.x), BHI(gr.x), BLO(gr.y), BHI(gr.y), BLO(gr.z), BHI(gr.z), BLO(gr.w), BHI(gr.w)};
        float s = ((y[0] + y[1]) + (y[2] + y[3])) + ((y[4] + y[5]) + (y[6] + y[7]));
        const float mean = sum8(s) * (1.f / 64.f);
        float q = 0.f;
#pragma unroll
        for (int i = 0; i < 8; ++i) { y[i] -= mean; q += y[i] * y[i]; }
        const float rs = __builtin_amdgcn_rsqf(sum8(q) * (1.f / 64.f) + 64e-5f);
        float r[8];
#pragma unroll
        for (int i = 0; i < 8; ++i) { const float gw_ = i < 4 ? gwa[i & 3] : gwb[i & 3], gb_ = i < 4 ? gba[i & 3] : gbb[i & 3]; r[i] = (y[i] * rs * gw_ + gb_ + bon * v[i]) * g[i]; }
        u32x4 w; w.x = pk2(r[0], r[1]); w.y = pk2(r[2], r[3]); w.z = pk2(r[4], r[5]); w.w = pk2(r[6], r[7]);
        *(u32x4*)(Y + o) = w;
    }
}


__device__ __forceinline__ void phase_peer_keys(const Params& p, unsigned char* smem_) {
    int tidv = threadIdx.x;
#define RETID() asm volatile("" : "+v"(tidv))
    bf16_t* SK = (bf16_t*)smem_;
    bf16_t* Qs = (bf16_t*)(smem_ + 34816);
    const bf16_t* q = (const bf16_t*)(p.ws + OFF_Q); const bf16_t* skt = (const bf16_t*)(p.ws + OFF_SKT); float* keys = (float*)(p.ws + OFF_KEYS);
    const int nb = gridDim.x;
    int gcur = -1;
    u32x4 qr[4];
#define PK_ISSUE(uu) do { const int g_ = (uu) & 15, n0_ = ((uu) >> 4) * 128; \
        _Pragma("unroll") for (int j = 0; j < 4; ++j) { const int idx = tidv + 512 * j, row = idx >> 4, pc = idx & 15; qr[j] = *(const u32x4*)(q + (size_t)(n0_ + row) * 2048 + g_ * 128 + pc * 8); } } while (0)
    if ((int)blockIdx.x < 2048) PK_ISSUE(blockIdx.x);
    for (int u = blockIdx.x; u < 2048; u += nb) {
        RETID();
        const int g = u & 15, n0 = (u >> 4) * 128;
        if (g != gcur) { gcur = g;
#pragma unroll
            for (int j = 0; j < 4; ++j) { const int idx = tidv + 512 * j, row = idx >> 4, pc = idx & 15; *(u32x4*)(SK + row * 136 + pc * 8) = *(const u32x4*)(skt + (size_t)(g * 128 + row) * 128 + pc * 8); } }
#pragma unroll
        for (int j = 0; j < 4; ++j) { const int idx = tidv + 512 * j, row = idx >> 4, pc = idx & 15; *(u32x4*)(Qs + row * 136 + pc * 8) = qr[j]; }
        __syncthreads();
        RETID();
        if (u + nb < 2048) PK_ISSUE(u + nb);
        const int lane_ = tidv & 63, wv_ = tidv >> 6, fr_ = lane_ & 15, fq_ = lane_ >> 4;
        const int wu = u * 8 + wv_;
        f32x4 tu[4], tv[4];
#pragma unroll
        for (int i = 0; i < 4; ++i) { tu[i] = __builtin_nontemporal_load((const f32x4*)(p.in[28] + (size_t)wu * 1024) + lane_ * 4 + i); tv[i] = __builtin_nontemporal_load((const f32x4*)(p.in[29] + (size_t)wu * 1024) + lane_ * 4 + i); }
        f32x4 acc[8];
#pragma unroll
        for (int kj = 0; kj < 8; ++kj) acc[kj] = (f32x4){0.f, 0.f, 0.f, 0.f};
#pragma unroll
        for (int ksp = 0; ksp < 4; ++ksp) {
            const bf16x8 a = *(const bf16x8*)(Qs + (wv_ * 16 + fr_) * 136 + ksp * 32 + fq_ * 8);
#pragma unroll
            for (int kj = 0; kj < 8; ++kj) { const bf16x8 b = *(const bf16x8*)(SK + (kj * 16 + fr_) * 136 + ksp * 32 + fq_ * 8); acc[kj] = MFMA16(a, b, acc[kj]); }
        }
#define KEY(kj, r) f2key(__uint_as_float((__float_as_uint(acc[kj][r]) & ~127u) | (unsigned)(127 - ((kj) * 16 + fr_))))
#define CEX(a, b) do { const int hi_ = max(a, b), lo_ = min(a, b); a = hi_; b = lo_; } while (0)
#define ROW_INIT(r) int a0##r = KEY(0, r), a1##r = KEY(1, r), a2##r = KEY(2, r), a3##r = KEY(3, r), a4##r = KEY(4, r), a5##r = KEY(5, r), a6##r = KEY(6, r), a7##r = KEY(7, r), rs##r = 0; \
        CEX(a0##r, a1##r); CEX(a2##r, a3##r); CEX(a4##r, a5##r); CEX(a6##r, a7##r); CEX(a0##r, a2##r); CEX(a1##r, a3##r); CEX(a4##r, a6##r); CEX(a5##r, a7##r); \
        CEX(a1##r, a2##r); CEX(a5##r, a6##r); CEX(a0##r, a4##r); CEX(a3##r, a7##r); CEX(a1##r, a5##r); CEX(a2##r, a6##r); CEX(a1##r, a4##r); CEX(a3##r, a6##r); \
        CEX(a2##r, a4##r); CEX(a3##r, a5##r); CEX(a3##r, a4##r);
#define ROW_STEP(r) do { const int m_ = imax16(a0##r); const bool w_ = a0##r == m_; \
        a0##r = w_ ? a1##r : a0##r; a1##r = w_ ? a2##r : a1##r; a2##r = w_ ? a3##r : a2##r; a3##r = w_ ? a4##r : a3##r; a4##r = w_ ? a5##r : a4##r; a5##r = w_ ? a6##r : a5##r; a6##r = w_ ? a7##r : a6##r; a7##r = w_ ? (int)0x80000000 : a7##r; \
        rs##r = (fr_ == it) ? m_ : rs##r; } while (0)
        ROW_INIT(0) ROW_INIT(1) ROW_INIT(2) ROW_INIT(3)
#pragma unroll 1
        for (int it = 0; it < 16; ++it) { ROW_STEP(0); ROW_STEP(1); ROW_STEP(2); ROW_STEP(3); }
        float res[4]; res[0] = key2f(rs0); res[1] = key2f(rs1); res[2] = key2f(rs2); res[3] = key2f(rs3);
#undef KEY
#undef CEX
#undef ROW_INIT
#undef ROW_STEP
#pragma unroll
        for (int r = 0; r < 4; ++r) keys[((size_t)(n0 + wv_ * 16 + fq_ * 4 + r) * 16 + g) * 16 + fr_] = res[r];
        { float mu_ = 0.f, mv_ = 0.f;
#pragma unroll
          for (int i = 0; i < 4; ++i) { mu_ = fmaxf(mu_, fmaxf(fmaxf(fabsf(tu[i][0]), fabsf(tu[i][1])), fmaxf(fabsf(tu[i][2]), fabsf(tu[i][3])))); mv_ = fmaxf(mv_, fmaxf(fmaxf(fabsf(tv[i][0]), fabsf(tv[i][1])), fmaxf(fabsf(tv[i][2]), fabsf(tv[i][3])))); }
#pragma unroll
          for (int o = 1; o < 64; o <<= 1) { mu_ = fmaxf(mu_, __shfl_xor(mu_, o)); mv_ = fmaxf(mv_, __shfl_xor(mv_, o)); }
#pragma unroll
          for (int tb = 0; tb < 2; ++tb) {
            const float mx_ = tb ? mv_ : mu_; const float s6 = mx_ > 0.f ? 7.5f / mx_ : 1.f;
            v16f x0, x1;
#pragma unroll
            for (int i = 0; i < 16; ++i) { const float own = (tb ? tv[i >> 2][i & 3] : tu[i >> 2][i & 3]) * s6; x0[i] = own; x1[i] = dpp_mov<0xF5>(own); }
            const v6u pk6 = __builtin_amdgcn_cvt_scalef32_2xpk16_fp6_f32(x0, x1, 1.0f);
            if ((lane_ & 1) == 0) { unsigned char* d6 = p.ws + (tb ? OFF_V8 : OFF_U8) + (size_t)wu * 768 + (lane_ >> 1) * 24;
                u32x2 w0, w1, w2; w0.x = pk6[0]; w0.y = pk6[1]; w1.x = pk6[2]; w1.y = pk6[3]; w2.x = pk6[4]; w2.y = pk6[5];
                *(u32x2*)d6 = w0; *(u32x2*)(d6 + 8) = w1; *(u32x2*)(d6 + 16) = w2; } }
          if (lane_ == 0) { float* uinv_ = (float*)(p.ws + OFF_UINV); uinv_[wu] = mu_ > 0.f ? mu_ * (1.f / 7.5f) : 1.f; uinv_[16384 + wu] = mv_ > 0.f ? mv_ * (1.f / 7.5f) : 1.f; } }
        __syncthreads();
    }
#undef PK_ISSUE
#undef RETID
}

typedef float f32x2v __attribute__((ext_vector_type(2)));
#define F8LO(x) __builtin_amdgcn_cvt_pk_f32_fp8((int)(x), false)
#define F8HI(x) __builtin_amdgcn_cvt_pk_f32_fp8((int)(x), true)
__device__ __forceinline__ f32x2v fma2(f32x2v a, f32x2v b, f32x2v c) { return __builtin_elementwise_fma(a, b, c); }
__device__ __forceinline__ float dot16f8(const u32x4 r, const f32x2v (&t)[8]) {
    f32x2v d = F8LO(r.x) * t[0];
    d = fma2(F8HI(r.x), t[1], d); d = fma2(F8LO(r.y), t[2], d); d = fma2(F8HI(r.y), t[3], d);
    d = fma2(F8LO(r.z), t[4], d); d = fma2(F8HI(r.z), t[5], d); d = fma2(F8LO(r.w), t[6], d); d = fma2(F8HI(r.w), t[7], d);
    return d.x + d.y;
}
__device__ const unsigned PK_PAIRS[16] = {0xe0331000u, 0xf0401101u, 0xff411202u, 0xff421303u, 0xff501404u, 0xff511505u, 0xff601606u, 0xff611707u, 0xff702008u, 0xff712109u, 0xff80220au, 0xff90230bu, 0xffa0240cu, 0xffb0300du, 0xffc0310eu, 0xffd0320fu};
__device__ __forceinline__ float fp6_mag(int k) { return k < 16 ? 0.125f * (float)k : (k < 24 ? 2.f + 0.25f * (float)(k - 16) : 4.f + 0.5f * (float)(k - 24)); }
__device__ __forceinline__ int fp6_idx(float v) { return v < 2.f ? (int)(v * 8.f + 0.5f) : (v < 4.f ? 16 + (int)((v - 2.f) * 4.f + 0.5f) : 24 + (int)((v - 4.f) * 2.f + 0.5f)); }
__device__ __forceinline__ void phase_peer_u6(const Params& p, unsigned char* smem_) {
    const int tid = tid_opaque(), lane = tid & 63, wv = __builtin_amdgcn_readfirstlane(tid >> 6), hf = lane >> 5, sl = lane & 31;
    unsigned char* wbase = smem_ + wv * 6400;
    int* wl_e = (int*)wbase; float* wl_g = (float*)(wl_e + 128); float* wl_us = wl_g + 128; float* wl_vs = wl_us + 128; float* TOKL = wl_vs + 128; int* PI = (int*)(TOKL + 1024);
    const float* keys = (const float*)(p.ws + OFF_KEYS); const float* ss2 = (const float*)(p.ws + OFF_SS2P);
    const unsigned char* U6 = p.ws + OFF_U8; const float* uinv = (const float*)(p.ws + OFF_UINV); const float* vinv = uinv + 16384;
    const float* g2 = p.in[25]; const bf16_t* x1b = (const bf16_t*)(p.ws + OFF_X1B); float* ACT = (float*)(p.ws + OFF_ACT); int* EID = (int*)(p.ws + OFF_EID);
    { v16f c0, c1;
#pragma unroll
      for (int i = 0; i < 16; ++i) { c0[i] = fp6_mag(i); c1[i] = fp6_mag(16 + i); }
      const v6u pc = __builtin_amdgcn_cvt_scalef32_2xpk16_fp6_f32(c0, c1, 1.0f);
      const v32f yc = __builtin_amdgcn_cvt_scalef32_pk32_f32_fp6(pc, 1.0f);
#pragma unroll
      for (int j = 0; j < 32; ++j) if (lane == 0) PI[j] = fp6_idx(yc[j]) & 31; }
    for (int n = blockIdx.x * 8 + wv; n < NTOK; n += gridDim.x * 8) {
        const float rs2 = __builtin_amdgcn_rsqf(sum16(ss2[(size_t)(lane & 15) * NTOK + n]) * (1.f / 1024.f) + 1e-6f);
#pragma unroll 1
        for (int rr = 0; rr < 2; ++rr) {
            const int h = rr * 4 + (lane >> 4), jj = lane & 15;
            const float* kp = keys + ((size_t)n * 16 + h * 2) * 16;
            const float k0 = kp[jj], k1own = kp[16 + jj];
            const unsigned pt4 = PK_PAIRS[jj];
            int cand[4];
#pragma unroll
            for (int i = 0; i < 4; ++i) { const unsigned cd = (pt4 >> (8 * i)) & 255u;
                const float sum = kp[cd >> 4] + kp[16 + (cd & 15u)];
                cand[i] = (cd == 255u) ? (int)0x80000000 : f2key(__uint_as_float((__float_as_uint(sum) & ~255u) | cd)); }
            int resi = 0;
#pragma unroll 1
            for (int it = 0; it < 16; ++it) {
                const int m = imax16(max(max(cand[0], cand[1]), max(cand[2], cand[3])));
#pragma unroll
                for (int i = 0; i < 4; ++i) cand[i] = (cand[i] == m) ? (int)0x80000000 : cand[i];
                resi = (jj == it) ? m : resi;
            }
            const float res = key2f(resi);
            const unsigned code = __float_as_uint(res) & 255u; const int p0 = code >> 4, p1 = code & 15;
            const int i0 = 127 - (int)(__float_as_uint(k0) & 127u), i1 = 127 - (int)(__float_as_uint(k1own) & 127u);
            const int gi0 = __shfl(i0, (lane & 48) + p0), gi1 = __shfl(i1, (lane & 48) + p1);
            const float mx = max16(res); const float ex = __expf((res - mx) * rs2); const float sm = sum16(ex);
            const int e = gi0 * 128 + gi1;
            wl_e[h * 16 + jj] = e; wl_g[h * 16 + jj] = ex / sm; wl_us[h * 16 + jj] = uinv[e]; wl_vs[h * 16 + jj] = vinv[e];
        }
#pragma unroll
        for (int i = 0; i < 4; ++i) *(f32x4*)(TOKL + i * 256 + lane * 4) = ld4bf(x1b + (size_t)n * 1024 + i * 256 + lane * 4) * rs2 * ((const f32x4*)g2)[lane + 64 * i];
        f32x2v tp[16];
#pragma unroll
        for (int j = 0; j < 16; ++j) tp[j] = (f32x2v){TOKL[32 * sl + PI[2 * j]], TOKL[32 * sl + PI[2 * j + 1]]};
        float act0 = 0.f, act1 = 0.f;
        {
            float rj[8]; u32x2 ra[2][4][3];
#pragma unroll
            for (int i = 0; i < 8; ++i) rj[i] = 0.f;
#define U6_LOAD(bufi, bb_) do { _Pragma("unroll") for (int k = 0; k < 4; ++k) { const int e = wl_e[(bb_) * 8 + 2 * k + hf]; const unsigned char* src = U6 + (size_t)e * 768 + sl * 24; \
                ra[bufi][k][0] = *(const u32x2*)src; ra[bufi][k][1] = *(const u32x2*)(src + 8); ra[bufi][k][2] = *(const u32x2*)(src + 16); } } while (0)
#define U6_BATCH(bufi, bb_) do { float d[4]; float chain = 0.f; \
                _Pragma("unroll") for (int k = 0; k < 4; ++k) { \
                    v6u pk; pk[0] = ra[bufi][k][0].x; pk[1] = ra[bufi][k][0].y; pk[2] = ra[bufi][k][1].x; pk[3] = ra[bufi][k][1].y; pk[4] = ra[bufi][k][2].x; pk[5] = ra[bufi][k][2].y; \
                    { unsigned p0_ = pk[0]; asm volatile("" : "+v"(p0_) : "v"(chain)); pk[0] = p0_; }     \
                    const v32f y = __builtin_amdgcn_cvt_scalef32_pk32_f32_fp6(pk, 1.0f); \
                    f32x2v d2 = (f32x2v){y[0], y[1]} * tp[0]; \
                    _Pragma("unroll") for (int j = 1; j < 16; ++j) d2 = fma2((f32x2v){y[2 * j], y[2 * j + 1]}, tp[j], d2); \
                    d[k] = d2.x + d2.y; chain = d[k]; } \
                  \
                { const bool up = (lane & 16) != 0; const float s0 = up ? d[0] : d[2], k0_ = up ? d[2] : d[0], s1 = up ? d[1] : d[3], k1_ = up ? d[3] : d[1]; \
                  d[0] = k0_ + __shfl_xor(s0, 16); d[1] = k1_ + __shfl_xor(s1, 16); } \
                { const bool up = (lane & 8) != 0; const float s0 = up ? d[0] : d[1], k0_ = up ? d[1] : d[0]; d[0] = k0_ + __shfl_xor(s0, 8); } \
                const float dv = sum8(d[0]);                   \
                _Pragma("unroll") for (int i = 0; i < 8; ++i) rj[i] = (((bb_) & 7) == i) ? dv : rj[i]; \
                if (((bb_) & 7) == 7) { \
                    const int grp = (bb_) >> 3; \
                    float tot = rj[0]; \
                    _Pragma("unroll") for (int i = 1; i < 8; ++i) tot = ((lane & 7) == i) ? rj[i] : tot; \
                    const int j = (grp * 8 + (lane & 7)) * 8 + 4 * ((lane >> 4) & 1) + 2 * ((lane >> 3) & 1) + hf;     \
                    tot *= wl_us[j]; \
                    const float a = 0.5f * tot * (1.f + erff(tot * 0.70710678118f)) * wl_g[j] * wl_vs[j]; \
                    if (grp == 0) act0 = a; else act1 = a; } } while (0)
            U6_LOAD(0, 0);
#pragma unroll 1
            for (int bb = 0; bb < 16; bb += 2) {
                U6_LOAD(1, bb + 1);
                asm volatile("" ::: "memory");
                U6_BATCH(0, bb);
                if (bb + 2 < 16) U6_LOAD(0, bb + 2);
                asm volatile("" ::: "memory");
                U6_BATCH(1, bb + 1);
            }
#undef U6_LOAD
#undef U6_BATCH
        }
        { const int jl0 = (0 * 8 + (lane & 7)) * 8 + 4 * ((lane >> 4) & 1) + 2 * ((lane >> 3) & 1) + hf;
          ACT[(size_t)n * 128 + jl0] = act0; ACT[(size_t)n * 128 + 64 + jl0] = act1; }
        EID[(size_t)n * 128 + lane] = wl_e[lane]; EID[(size_t)n * 128 + 64 + lane] = wl_e[64 + lane];
    }
}

#ifndef V2_NRB
#define V2_NRB 3
#endif
__device__ __forceinline__ void phase_peer_v2(const Params& p, unsigned char* smem_) {
    constexpr int NRB = V2_NRB, NR = 1 << NRB, NB = NR * 8, BPL = NB >= 64 ? NB / 64 : 1, ESH = 14 - NRB;
    const int tid = tid_opaque(), lane = tid & 63, wv = tid >> 6;
    unsigned long long* SP = (unsigned long long*)(smem_ + wv * (8192 + 12 * NB));
    int* cnt = (int*)(SP + 1024);
    const unsigned char* V8 = p.ws + OFF_V8; const float* ACT = (const float*)(p.ws + OFF_ACT); const int* EID = (const int*)(p.ws + OFF_EID);
    const float* fg = p.in[30]; float* out = p.out; const bf16_t* x1b = (const bf16_t*)(p.ws + OFF_X1B);
    const int gw = blockIdx.x * 8 + wv, nw = gridDim.x * 8;
    for (int g0 = gw; g0 < NTOK; g0 += 8 * nw) {
#pragma unroll
        for (int i = 0; i < BPL; ++i) if (lane + 64 * i < NB) cnt[lane + 64 * i] = 0;
        int ev[16]; float av[16];
#pragma unroll
        for (int i = 0; i < 16; ++i) { const int t = i >> 1, j = (i & 1) * 64 + lane, n = g0 + t * nw;
            const bool ok = n < NTOK;
            ev[i] = ok ? EID[(size_t)n * 128 + j] : 0;
            av[i] = ok ? ACT[(size_t)n * 128 + (j & 64) + (((j & 7) << 3) | ((j >> 3) & 7))] : 0.f; }
#pragma unroll
        for (int i = 0; i < 16; ++i) atomicAdd(&cnt[(ev[i] >> ESH) * 8 + (i >> 1)], 1);
        {
          int c[BPL]; int sc = 0;
#pragma unroll
          for (int i = 0; i < BPL; ++i) { c[i] = (BPL * lane + i < NB) ? cnt[BPL * lane + i] : 0; sc += c[i]; }
          const int tot = sc;
#pragma unroll
          for (int o = 1; o < 64; o <<= 1) { const int tt = __shfl_up(sc, o); if (lane >= o) sc += tt; }
          int ex = sc - tot;
#pragma unroll
          for (int i = 0; i < BPL; ++i) { if (BPL * lane + i < NB) { cnt[NB + BPL * lane + i] = ex; cnt[2 * NB + BPL * lane + i] = ex; } ex += c[i]; } }
#pragma unroll
        for (int i = 0; i < 16; ++i) { const int pos = atomicAdd(&cnt[2 * NB + (ev[i] >> ESH) * 8 + (i >> 1)], 1);
            SP[pos] = ((unsigned long long)(unsigned)ev[i] << 32) | (unsigned long long)__float_as_uint(av[i]); }
        f32x2v ac[8][8];
#pragma unroll
        for (int t = 0; t < 8; ++t)
#pragma unroll
            for (int k = 0; k < 8; ++k) ac[t][k] = (f32x2v){0.f, 0.f};
#pragma unroll 1
        for (int r = 0; r < NR; ++r) {
#pragma unroll
            for (int t = 0; t < 8; ++t) {
                const int beg = __builtin_amdgcn_readfirstlane(cnt[NB + r * 8 + t]), end = beg + __builtin_amdgcn_readfirstlane(cnt[r * 8 + t]);
#pragma unroll 1
                for (int b0 = beg; b0 < end; b0 += 8) {
                    u32x4 ra[8]; float aq[8];
#pragma unroll
                    for (int q = 0; q < 8; ++q) { ra[q] = (u32x4){0u, 0u, 0u, 0u}; aq[q] = 0.f;
                        if (b0 + q < end) { const unsigned long long pr = SP[b0 + q];
                            const unsigned e = (unsigned)__builtin_amdgcn_readfirstlane((int)(pr >> 32)); aq[q] = __uint_as_float((unsigned)__builtin_amdgcn_readfirstlane((int)(unsigned)pr));
                            ra[q] = *(const u32x4*)(V8 + (size_t)e * 1024 + lane * 16); } }
#pragma unroll
                    for (int q = 0; q < 8; ++q) {
                        if (b0 + q < end) {
                            const f32x2v a2 = (f32x2v){aq[q], aq[q]};
                            ac[t][0] = fma2(F8LO(ra[q].x), a2, ac[t][0]); ac[t][1] = fma2(F8HI(ra[q].x), a2, ac[t][1]); ac[t][2] = fma2(F8LO(ra[q].y), a2, ac[t][2]); ac[t][3] = fma2(F8HI(ra[q].y), a2, ac[t][3]);
                            ac[t][4] = fma2(F8LO(ra[q].z), a2, ac[t][4]); ac[t][5] = fma2(F8HI(ra[q].z), a2, ac[t][5]); ac[t][6] = fma2(F8LO(ra[q].w), a2, ac[t][6]); ac[t][7] = fma2(F8HI(ra[q].w), a2, ac[t][7]);
                        } }
                }
            }
        }
#pragma unroll
        for (int t = 0; t < 8; ++t) { const int n = g0 + t * nw;
            if (n < NTOK) {
                f32x4 acc[4]; float ss = 0.f;
#pragma unroll
                for (int i = 0; i < 4; ++i) { acc[i] = (f32x4){ac[t][2 * i].x, ac[t][2 * i].y, ac[t][2 * i + 1].x, ac[t][2 * i + 1].y} + ld4bf(x1b + (size_t)n * 1024 + i * 256 + lane * 4);
                    ss += (acc[i][0] * acc[i][0] + acc[i][1] * acc[i][1]) + (acc[i][2] * acc[i][2] + acc[i][3] * acc[i][3]); }
                ss = wave_sum(ss); const float rs = __builtin_amdgcn_rsqf(ss * (1.f / 1024.f) + 1e-6f);
#pragma unroll
                for (int i = 0; i < 4; ++i) ((f32x4*)(out + (size_t)n * 1024))[lane + 64 * i] = acc[i] * rs * ((const f32x4*)fg)[lane + 64 * i];
            } }
    }
}

#define XB_TMO      128
#define XB_XCNT(j)  (256  + 64 * (j))
#define XB_XSUB(j)  (1280 + 64 * (j))
#define XB_XGEN(j)  (2304 + 64 * (j))
#define XB_TOP      3328
#define XB_TOPGEN   3392
#define XCD_BAR_WORDS 3456
#define XB_SPIN_CAP (1u << 18)

__device__ __forceinline__ unsigned xb_ld(unsigned* p)              { return __hip_atomic_load(p, __ATOMIC_RELAXED, __HIP_MEMORY_SCOPE_AGENT); }
__device__ __forceinline__ unsigned xb_add(unsigned* p, unsigned v) { return __hip_atomic_fetch_add(p, v, __ATOMIC_RELAXED, __HIP_MEMORY_SCOPE_AGENT); }
__device__ __forceinline__ unsigned xb_xcc_id() { return (unsigned)__builtin_amdgcn_s_getreg((3 << 11) | 20) & 0xFu; }
#define XB_SPIN(cond, bar) do { unsigned _sp = 0; while (cond) { __builtin_amdgcn_s_sleep(1); \
    if ((++_sp & 255u) == 0u) { if (xb_ld(&(bar)[XB_TMO])) break; if (_sp > XB_SPIN_CAP) { atomicAdd(&(bar)[XB_TMO], 1u); break; } } } } while (0)

struct XcdBarrier {
    unsigned* bar; unsigned x;
    volatile LAS unsigned* st;
};

__device__ __forceinline__ XcdBarrier xcd_barrier_post(unsigned* bar, volatile LAS unsigned* st) {
    XcdBarrier b; b.bar = bar; b.x = xb_xcc_id(); b.st = st;
    if (threadIdx.x == 0) (void)xb_add(&bar[XB_XCNT(b.x)], 1u);
    return b;
}
__device__ __forceinline__ void xcd_barrier_complete(unsigned* bar, unsigned x, unsigned& nloc, unsigned& nx) {
    const unsigned G = gridDim.x * gridDim.y * gridDim.z;
    unsigned sum, cnt, mine, sp = 0u;
    for (;;) {
        sum = 0u; cnt = 0u; mine = 0u;
#pragma unroll
        for (unsigned j = 0; j < 16; ++j) { const unsigned c = xb_ld(&bar[XB_XCNT(j)]); sum += c; cnt += (c > 0u) ? 1u : 0u; mine = (j == x) ? c : mine; }
        if (sum == G) break;
        __builtin_amdgcn_s_sleep(1);
        if ((++sp & 255u) == 0u) { if (xb_ld(&bar[XB_TMO])) break; if (sp > XB_SPIN_CAP) { atomicAdd(&bar[XB_TMO], 1u); break; } }
    }
    nloc = mine > 0u ? mine : 1u; nx = cnt > 0u ? cnt : 1u;
}

__device__ __forceinline__ void xcd_barrier(const XcdBarrier& b) {
    asm volatile("s_waitcnt vmcnt(0)" ::: "memory");
    __syncthreads();
    if (threadIdx.x == 0) {
        unsigned* bar = b.bar;
        __builtin_amdgcn_s_waitcnt(0);
        unsigned nloc = b.st[0], nx = b.st[1];
        if (nloc == 0u) { xcd_barrier_complete(bar, b.x, nloc, nx); b.st[0] = nloc; b.st[1] = nx; }
        const unsigned old = xb_add(&bar[XB_XSUB(b.x)], 1u);
        const unsigned gen = old / nloc;
        if (old + 1u == (gen + 1u) * nloc) {
            __builtin_amdgcn_fence(__ATOMIC_RELEASE, "agent");
            asm volatile("s_waitcnt vmcnt(0)" ::: "memory");
            const unsigned og = xb_add(&bar[XB_TOP], 1u);
            const unsigned tg = og / nx;
            if (og + 1u == (tg + 1u) * nx) xb_add(&bar[XB_TOPGEN], 1u);
            else XB_SPIN(xb_ld(&bar[XB_TOPGEN]) == tg, bar);
            __builtin_amdgcn_fence(__ATOMIC_ACQUIRE, "agent");
            xb_add(&bar[XB_XGEN(b.x)], 1u);
            asm volatile("s_waitcnt vmcnt(0)" ::: "memory");
        } else {
            XB_SPIN(xb_ld(&bar[XB_XGEN(b.x)]) == gen, bar);
            __builtin_amdgcn_fence(__ATOMIC_ACQUIRE, "agent");
            asm volatile("s_waitcnt vmcnt(0)" ::: "memory");
        }
    }
    __syncthreads();
}


__device__ __forceinline__ void phase_peer_v3(const Params& p, unsigned char* smem_) {
    const int tid = tid_opaque(), lane = tid & 63, wv = __builtin_amdgcn_readfirstlane(tid >> 6), hf = lane >> 5, sl = lane & 31;
    unsigned char* wbase = smem_ + wv * 13312;
    int* SPE = (int*)wbase; float* SPA = (float*)(wbase + 4096); float* OUT = (float*)(wbase + 8192); int* cnt = (int*)(wbase + 12288); int* PI = cnt + 192;
    const unsigned char* V6 = p.ws + OFF_V8; const float* ACT = (const float*)(p.ws + OFF_ACT); const int* EID = (const int*)(p.ws + OFF_EID);
    const float* fg = p.in[30]; float* out = p.out; const bf16_t* x1b = (const bf16_t*)(p.ws + OFF_X1B);
    { v16f c0, c1;
#pragma unroll
      for (int i = 0; i < 16; ++i) { c0[i] = fp6_mag(i); c1[i] = fp6_mag(16 + i); }
      const v6u pc = __builtin_amdgcn_cvt_scalef32_2xpk16_fp6_f32(c0, c1, 1.0f);
      const v32f yc = __builtin_amdgcn_cvt_scalef32_pk32_f32_fp6(pc, 1.0f);
#pragma unroll
      for (int j = 0; j < 32; ++j) if (lane == 0) PI[j] = fp6_idx(yc[j]) & 31; }
    const int gw = blockIdx.x * 8 + wv, nw = gridDim.x * 8;
    for (int g0 = gw; g0 < NTOK; g0 += 8 * nw) {
        cnt[lane] = 0;
        int ev[16]; float av[16];
#pragma unroll
        for (int i = 0; i < 16; ++i) { const int t = i >> 1, j = (i & 1) * 64 + lane, n = g0 + t * nw;
            const bool ok = n < NTOK;
            ev[i] = ok ? EID[(size_t)n * 128 + j] : 0;
            av[i] = ok ? ACT[(size_t)n * 128 + j] : 0.f; }
#pragma unroll
        for (int i = 0; i < 16; ++i) atomicAdd(&cnt[(ev[i] >> 11) * 8 + (i >> 1)], 1);
        { const int c = cnt[lane]; int sc = c;
#pragma unroll
          for (int o = 1; o < 64; o <<= 1) { const int tt = __shfl_up(sc, o); if (lane >= o) sc += tt; }
          cnt[64 + lane] = sc - c; cnt[128 + lane] = sc - c; }
#pragma unroll
        for (int i = 0; i < 16; ++i) { const int pos = atomicAdd(&cnt[128 + (ev[i] >> 11) * 8 + (i >> 1)], 1); SPE[pos] = ev[i]; SPA[pos] = av[i]; }
#pragma unroll 1
        for (int sw = 0; sw < 2; ++sw) {
            f32x2v ac[4][16];
#pragma unroll
            for (int t = 0; t < 4; ++t)
#pragma unroll
                for (int j = 0; j < 16; ++j) ac[t][j] = (f32x2v){0.f, 0.f};
#pragma unroll 1
            for (int r = 0; r < 8; ++r) {
#pragma unroll
                for (int t = 0; t < 4; ++t) {
                    const int bk = r * 8 + sw * 4 + t;
                    const int beg = __builtin_amdgcn_readfirstlane(cnt[64 + bk]), end = beg + __builtin_amdgcn_readfirstlane(cnt[bk]);
#pragma unroll 1
                    for (int b0 = beg; b0 < end; b0 += 8) {
                        u32x2 ra[4][3]; float aq[4];
#pragma unroll
                        for (int k = 0; k < 4; ++k) { const int idx = b0 + 2 * k + hf; const bool ok = idx < end; const int ii = ok ? idx : beg;
                            const int e = SPE[ii]; aq[k] = ok ? SPA[ii] : 0.f;
                            const unsigned char* src = V6 + (size_t)e * 768 + sl * 24;
                            ra[k][0] = *(const u32x2*)src; ra[k][1] = *(const u32x2*)(src + 8); ra[k][2] = *(const u32x2*)(src + 16); }
#pragma unroll
                        for (int k = 0; k < 4; ++k) {
                            if (b0 + 2 * k < end) {
                                v6u pk; pk[0] = ra[k][0].x; pk[1] = ra[k][0].y; pk[2] = ra[k][1].x; pk[3] = ra[k][1].y; pk[4] = ra[k][2].x; pk[5] = ra[k][2].y;
                                const v32f y = __builtin_amdgcn_cvt_scalef32_pk32_f32_fp6(pk, 1.0f);
#pragma unroll
                                for (int j = 0; j < 16; ++j) ac[t][j] = fma2((f32x2v){y[2 * j], y[2 * j + 1]}, (f32x2v){aq[k], aq[k]}, ac[t][j]);
                            } }
                    }
                }
            }
#pragma unroll
            for (int t = 0; t < 4; ++t) { const int n = g0 + (sw * 4 + t) * nw;
#pragma unroll
                for (int j = 0; j < 32; ++j) { const float own = (j & 1) ? ac[t][j >> 1].y : ac[t][j >> 1].x; const float v = own + __shfl_xor(own, 32); if (hf == 0) OUT[32 * sl + PI[j]] = v; }
                if (n < NTOK) {
                    f32x4 acc[4]; float ss = 0.f;
#pragma unroll
                    for (int i = 0; i < 4; ++i) { acc[i] = *(const f32x4*)(OUT + i * 256 + lane * 4) + ld4bf(x1b + (size_t)n * 1024 + i * 256 + lane * 4);
                        ss += (acc[i][0] * acc[i][0] + acc[i][1] * acc[i][1]) + (acc[i][2] * acc[i][2] + acc[i][3] * acc[i][3]); }
                    ss = wave_sum(ss); const float rs = __builtin_amdgcn_rsqf(ss * (1.f / 1024.f) + 1e-6f);
#pragma unroll
                    for (int i = 0; i < 4; ++i) ((f32x4*)(out + (size_t)n * 1024))[lane + 64 * i] = acc[i] * rs * ((const f32x4*)fg)[lane + 64 * i];
                } }
        }
    }
}

extern __shared__ __attribute__((aligned(16))) unsigned char smem[];
__global__ void __launch_bounds__(512, 2) mega_kernel(Params p) {
    cg::grid_group grid = cg::this_grid();
    float* lds = (float*)smem;
    PG8_LAS unsigned char* ldsa = (PG8_LAS unsigned char*)smem;
    unsigned char* ws = p.ws;
    const int G = gridDim.x;
    unsigned tacc = 0; unsigned long long klast = 0;
#define KSTAMP(k) do { if (STAMP_SEL >= 100) { const unsigned long long _t = __builtin_amdgcn_s_memrealtime(); if (STAMP_SEL == 100 + (k) || (STAMP_SEL == 999 && (k) != 99)) tacc += (unsigned)(_t - klast); klast = _t; } } while (0)
    KSTAMP(99);
    volatile LAS unsigned* xst = (volatile LAS unsigned*)((PG8_LAS unsigned char*)smem + 163840 - 16);
    if (threadIdx.x == 0) { xst[0] = 0u; xst[1] = 0u; }
    __syncthreads();
    const XcdBarrier xbar = xcd_barrier_post((unsigned*)(ws + OFF_BAR), xst);
#if PHMASK & 1
    phase0(p, lds);
    KSTAMP(21);
#endif
    xcd_barrier(xbar);
    KSTAMP(0);
#if PHMASK & 2
    { pg8::Gemm g{(const bf16_t*)(ws + OFF_XB), (const bf16_t*)(ws + OFF_WINT), NTOK, 5888, 1024}; pg8::StaticOrder S; S.init(NTOK, 5888, G, (int)blockIdx.x);
      EpiZ E{(bf16_t*)(ws + OFF_ZRW), (bf16_t*)(ws + OFF_ZML), (bf16_t*)(ws + OFF_ZG)};
      pg8::gemm_phase<EpiZ, pg8::StaticOrder>(ldsa, g, S, E, nullptr); }
#endif
    xcd_barrier(xbar);
    KSTAMP(1);
#if PHMASK & 4
    phase_rwkv_prep(p, smem, tacc);
#endif
    xcd_barrier(xbar);
    KSTAMP(2);
#if PHMASK & 8
    if (blockIdx.x < 32) phase_rwkv_scan4(p, smem, blockIdx.x);
#endif
#if PHMASK & 16
    if (blockIdx.x >= 32) phase_ml_cloc2(p, smem, blockIdx.x - 32, G - 32);
#endif
    if (p.cg_sync) grid.sync(); else xcd_barrier(xbar);
    KSTAMP(3);
#if PHMASK & 32
    phase_ml_scan(p);
    phase_rwkv_post(p);
#endif
    xcd_barrier(xbar);
    KSTAMP(4);
#if PHMASK & 64
    phase_ml_out2(p, smem);
#endif
    xcd_barrier(xbar);
    KSTAMP(5);
#if PHMASK & 128
    { MergeOrder S; S.init(NTOK, 1024, G, (int)blockIdx.x);
      pg8::Gemm g{(const bf16_t*)(ws + OFF_Y), (const bf16_t*)(ws + OFF_PRWT), NTOK, 1024, 512};
      EpiMerge E{EpiMerge1{(const bf16_t*)(ws + OFF_ZG), p.in[21], (bf16_t*)(ws + OFF_T)}, EpiMerge2{(const bf16_t*)(ws + OFF_ZG), p.in[21], (const bf16_t*)(ws + OFF_T), (bf16_t*)(ws + OFF_MERGED)}};
      if (G == 256) pg8::gemm_phase<EpiMerge, MergeOrder>(ldsa, g, S, E, nullptr);
      else { pg8::StaticOrder S1; S1.init(NTOK, 1024, G, (int)blockIdx.x);
        { pg8::gemm_phase<EpiMerge1, pg8::StaticOrder>(ldsa, g, S1, E.e1, nullptr); }
        { pg8::Gemm g2{(const bf16_t*)(ws + OFF_YML), (const bf16_t*)(ws + OFF_PMLT), NTOK, 1024, 512}; pg8::gemm_phase<EpiMerge2, pg8::StaticOrder>(ldsa, g2, S1, E.e2, nullptr); } } }
#endif
    xcd_barrier(xbar);
    KSTAMP(6);
#if PHMASK & 256
    { pg8::Gemm g{(const bf16_t*)(ws + OFF_MERGED), (const bf16_t*)(ws + OFF_WOUTT), NTOK, 1024, 1024}; pg8::StaticOrder S; S.init(NTOK, 1024, G, (int)blockIdx.x);
      EpiOut E{p.in[0], p.out, (bf16_t*)(ws + OFF_X1B), (float*)(ws + OFF_SS2P)};
      pg8::gemm_phase<EpiOut, pg8::StaticOrder>(ldsa, g, S, E, nullptr); }
#endif
    xcd_barrier(xbar);
    KSTAMP(7);
#if PHMASK & 512
    { pg8::Gemm g{(const bf16_t*)(ws + OFF_X1B), (const bf16_t*)(ws + OFF_WQT), NTOK, 2048, 1024}; pg8::StaticOrder S; S.init(NTOK, 2048, G, (int)blockIdx.x);
      EpiQ E{(bf16_t*)(ws + OFF_Q)};
      pg8::gemm_phase<EpiQ, pg8::StaticOrder>(ldsa, g, S, E, nullptr); }
#endif
    xcd_barrier(xbar);
    KSTAMP(8);
#if PHMASK & 1024
    phase_peer_keys(p, smem);
#endif
    xcd_barrier(xbar);
    KSTAMP(9);
#if PHMASK & 2048
    phase_peer_u6(p, smem);
    xcd_barrier(xbar);
    KSTAMP(11);
    phase_peer_v3(p, smem);
#endif
    KSTAMP(10);
#if STAMP_SEL
    if (blockIdx.x == 0 && threadIdx.x < 64) { const unsigned long long t0 = __builtin_amdgcn_s_memrealtime(); const unsigned long long want = (unsigned long long)__builtin_amdgcn_readfirstlane(tacc) * (STAMP_SEL == 999 ? 1ull : 10ull); while (__builtin_amdgcn_s_memrealtime() - t0 < want) __builtin_amdgcn_s_sleep(8); }
#endif
}

extern "C" void kernel_launch(void* const* d_in, const int* in_sizes, int n_in, void* d_out, int out_size, void* d_ws, size_t ws_size, hipStream_t stream) {
    constexpr size_t kDynLds = 163840;
    static int grid_blocks = 0;
    if (!grid_blocks) {
        int dev = 0, cus = 0, per_cu = 0;
        (void)hipGetDevice(&dev);
        (void)hipDeviceGetAttribute(&cus, hipDeviceAttributeMultiprocessorCount, dev);
        (void)hipFuncSetAttribute((const void*)mega_kernel, hipFuncAttributeMaxDynamicSharedMemorySize, (int)kDynLds);
        (void)hipOccupancyMaxActiveBlocksPerMultiprocessor(&per_cu, mega_kernel, 512, kDynLds);
        if (per_cu < 1) { fprintf(stderr, "occupancy query says %d blocks per CU\n", per_cu); per_cu = 1; }
        if (per_cu > 1) per_cu = 1;
        grid_blocks = cus * per_cu;
        if (ws_size < 256 * MiB) fprintf(stderr, "workspace too small: %zu\n", ws_size);
    }
    (void)hipMemsetAsync((unsigned char*)d_ws + OFF_BAR, 0, XCD_BAR_WORDS * 4, stream);
    Params p{};
    for (int i = 0; i < 31; ++i) p.in[i] = (const float*)d_in[i];
    p.out = (float*)d_out; p.ws = (unsigned char*)d_ws; p.cg_sync = 0; p.pad = 0;
    void* args[] = {&p};
    hipError_t e = hipLaunchCooperativeKernel((void*)mega_kernel, dim3(grid_blocks), dim3(512), args, kDynLds, stream);
    if (e != hipSuccess) fprintf(stderr, "cooperative launch failed: %s (grid %d)\n", hipGetErrorString(e), grid_blocks);
}
```
